# Optimizing an MI355X kernel written in HIP

```python
import math
import jax, jax.numpy as jnp
from jax import lax
import numpy as np

D_MODEL = 1024
BATCH = 8
SEQ = 2048
DEPTH = 2
DEC_BATCH = 16
DEC_SEQ = 4096
PAST_LEN = 128

EPS = 1e-6
ROPE_THETA = 500000.0
HY_WIDTH = 1024
HY_SHORT = 3
HY_EMB = 33
HY_BANDS = (HY_EMB - 1) // 2
HY_FILT_HIDDEN = 64
HY_TARGET = 1e-2
HY_FAST_PCT = 0.3
HY_SLOW_PCT = 1.5
GDN_HEADS = 8
GDN_HEAD_DIM = 128
GDN_WIDTH = GDN_HEADS * GDN_HEAD_DIM
GDN_SHORT = 5
GDN_CHUNK = 64
DIL_PATTERNS = ((128, 1), (512, 4), (2048, 16))
N_DIL = len(DIL_PATTERNS)
DIL_HEADS = 4
DIL_HEAD_DIM = 128
DIL_WIDTH = DIL_HEADS * DIL_HEAD_DIM
DIL_BLOCK = 64
SWA_Q_HEADS = 16
SWA_KV_HEADS = 2
SWA_HEAD_DIM = 64
SWA_WIDTH = SWA_Q_HEADS * SWA_HEAD_DIM
SWA_HALF_WINDOW = 128
SWA_BLOCK = 128
MEM_TOKENS = 256
X_HEADS = 4
X_HEAD_DIM = 128
X_WIDTH = X_HEADS * X_HEAD_DIM

EVEN_IN_WIDTHS = (3 * HY_WIDTH, HY_WIDTH, 3 * GDN_WIDTH, GDN_WIDTH, 2 * GDN_HEADS, 2 * GDN_HEADS, X_WIDTH, X_WIDTH)
EVEN_IN = sum(EVEN_IN_WIDTHS)
EVEN_OUT = HY_WIDTH + GDN_WIDTH + X_WIDTH
ODD_IN_WIDTHS = (3 * N_DIL * DIL_WIDTH, DIL_WIDTH, SWA_WIDTH, 2 * SWA_KV_HEADS * SWA_HEAD_DIM, SWA_WIDTH, X_WIDTH, X_WIDTH)
ODD_IN = sum(ODD_IN_WIDTHS)
ODD_OUT = DIL_WIDTH + SWA_WIDTH + X_WIDTH

kernel_name = 'bidir_hybrid_encoder'


def rms_norm(x, g):
    xf = x.astype(jnp.float32)
    y = xf * lax.rsqrt(jnp.mean(xf * xf, axis=-1, keepdims=True) + EPS)
    return (y * g.astype(jnp.float32)).astype(x.dtype)


def l2_normalize(x):
    return x * lax.rsqrt(jnp.sum(x * x, axis=-1, keepdims=True) + EPS)


def split_cols(z, widths):
    cuts = [int(c) for c in np.cumsum(widths)[:-1]]
    return jnp.split(z, cuts, axis=-1)


def centred_depthwise_conv(x, w):
    k_width, seq = w.shape[0], x.shape[1]
    pad = k_width // 2
    xp = jnp.pad(x, ((0, 0), (pad, pad), (0, 0)))
    y = xp[:, 0:seq] * w[0]
    for j in range(1, k_width):
        y = y + xp[:, j:j + seq] * w[j]
    return y


def partial_rope(x):
    seq, dh = x.shape[1], x.shape[-1]
    rd = dh // 4
    half = rd // 2
    inv = ROPE_THETA ** (-jnp.arange(half, dtype=jnp.float32) / half)
    ang = jnp.arange(seq, dtype=jnp.float32)[:, None] * inv[None, :]
    shape = (1, seq) + (1,) * (x.ndim - 3) + (half,)
    cos = jnp.cos(ang).reshape(shape)
    sin = jnp.sin(ang).reshape(shape)
    xf = x.astype(jnp.float32)
    x1, x2, rest = xf[..., :half], xf[..., half:rd], xf[..., rd:]
    return jnp.concatenate([x1 * cos - x2 * sin, x2 * cos + x1 * sin, rest], axis=-1).astype(x.dtype)


def hyena_filters(seq, w1, b1, w2, b2, w3, freq):
    t = jnp.linspace(0.0, 1.0, seq, dtype=jnp.float32)[:, None]
    w = (2.0 * math.pi / seq) * jnp.arange(seq, dtype=jnp.float32)[:, None]
    f = jnp.linspace(1e-4, HY_BANDS - 1, HY_BANDS, dtype=jnp.float32)[None, :]
    emb = jnp.concatenate([t, jnp.cos(f * w), -jnp.sin(f * w)], axis=-1)
    freq = freq.astype(jnp.float32)
    hid = jnp.sin(freq * (emb @ w1.astype(jnp.float32) + b1.astype(jnp.float32)))
    hid = jnp.sin(freq * (hid @ w2.astype(jnp.float32) + b2.astype(jnp.float32)))
    filt = hid @ w3.astype(jnp.float32)
    deltas = jnp.abs(jnp.linspace(math.log(HY_TARGET) / HY_SLOW_PCT, math.log(HY_TARGET) / HY_FAST_PCT, HY_WIDTH, dtype=jnp.float32))
    decay = jnp.exp(-t * jnp.tile(deltas, 2)[None, :])
    filt = filt * decay
    return filt[:, :HY_WIDTH], filt[:, HY_WIDTH:]


def bidir_long_conv(u, h_fwd, h_bwd, skip):
    seq, ch = u.shape[1], u.shape[2]
    n_fft = 2 * seq
    filt = jnp.concatenate([h_fwd, jnp.zeros((1, ch), jnp.float32), h_bwd[1:][::-1]], axis=0)
    filt_f = jnp.fft.rfft(filt, n=n_fft, axis=0)
    u_f = jnp.fft.rfft(u.astype(jnp.float32), n=n_fft, axis=1)
    y = jnp.fft.irfft(u_f * filt_f[None], n=n_fft, axis=1)[:, :seq]
    return (y + u.astype(jnp.float32) * skip.astype(jnp.float32)).astype(u.dtype)


def gated_delta_chunked(q, k, v, g, beta):
    bsz, heads, seq, dk = k.shape
    dv = v.shape[-1]
    c = GDN_CHUNK
    n = seq // c
    q = q.reshape(bsz, heads, n, c, dk)
    k = k.reshape(bsz, heads, n, c, dk)
    v = v.reshape(bsz, heads, n, c, dv)
    g = jnp.cumsum(g.reshape(bsz, heads, n, c), axis=-1)
    beta = beta.reshape(bsz, heads, n, c)
    kb = k * beta[..., None]
    vb = v * beta[..., None]
    lower = jnp.tril(jnp.ones((c, c), dtype=bool))
    strict = jnp.tril(jnp.ones((c, c), dtype=bool), -1)
    decay = jnp.exp(jnp.where(lower, g[..., :, None] - g[..., None, :], -jnp.inf))
    a = jnp.where(strict, jnp.einsum('bhnid,bhnjd->bhnij', kb, k) * decay, 0.0)
    eye = jnp.eye(c, dtype=jnp.float32)
    t_inv = lax.linalg.triangular_solve(a + eye, jnp.broadcast_to(eye, a.shape), left_side=True, lower=True, unit_diagonal=True)
    u = jnp.einsum('bhnij,bhnjd->bhnid', t_inv, vb)
    w = jnp.einsum('bhnij,bhnjd->bhnid', t_inv, kb * jnp.exp(g)[..., None])
    qk = jnp.where(lower, jnp.einsum('bhnid,bhnjd->bhnij', q, k) * decay, 0.0)
    qg = q * jnp.exp(g)[..., None]
    kd = k * jnp.exp(g[..., -1:] - g)[..., None]
    g_last = jnp.exp(g[..., -1])

    def step(state, xs):
        qk_i, qg_i, kd_i, u_i, w_i, gl_i = xs
        v_new = u_i - jnp.einsum('bhik,bhkv->bhiv', w_i, state)
        o_i = jnp.einsum('bhik,bhkv->bhiv', qg_i, state) + jnp.einsum('bhij,bhjv->bhiv', qk_i, v_new)
        state = state * gl_i[..., None, None] + jnp.einsum('bhik,bhiv->bhkv', kd_i, v_new)
        return state, o_i

    xs = tuple(jnp.moveaxis(z, 2, 0) for z in (qk, qg, kd, u, w, g_last))
    s0 = jnp.zeros((bsz, heads, dk, dv), jnp.float32)
    _, o = lax.scan(step, s0, xs)
    return jnp.moveaxis(o, 0, 2).reshape(bsz, heads, seq, dv)


def banded_attention(q, k, v, half_window, block, sink=None):
    nbat, seq, hk, grp, dh = q.shape
    nb = -(-seq // block)
    lp = nb * block
    width = block + 2 * half_window
    qb = jnp.pad(q, ((0, 0), (0, lp - seq), (0, 0), (0, 0), (0, 0))).reshape(nbat, nb, block, hk, grp, dh)
    pad_kv = ((0, 0), (half_window, lp - seq + half_window), (0, 0), (0, 0))
    kp = jnp.pad(k, pad_kv)
    vp = jnp.pad(v, pad_kv)
    idx = jnp.arange(nb)[:, None] * block + jnp.arange(width)[None, :]
    kb = kp[:, idx]
    vb = vp[:, idx]
    q_pos = jnp.arange(lp).reshape(nb, block)
    k_pos = (idx - half_window)[:, None, :]
    valid = (jnp.abs(q_pos[:, :, None] - k_pos) <= half_window) & (k_pos >= 0) & (k_pos < seq)
    s = jnp.einsum('nbqhgd,nbkhd->nbhgqk', qb, kb, preferred_element_type=jnp.float32) * (dh ** -0.5)
    s = jnp.where(valid[None, :, None, None], s, -jnp.inf)
    m = jnp.max(s, axis=-1)
    if sink is not None:
        sk = sink.astype(jnp.float32)[None, None, :, :, None]
        m = jnp.maximum(m, sk)
    p = jnp.exp(s - m[..., None])
    den = jnp.sum(p, axis=-1)
    if sink is not None:
        den = den + jnp.exp(sk - m)
    o = jnp.einsum('nbhgqk,nbkhd->nbqhgd', p, vb.astype(jnp.float32)) / jnp.moveaxis(den, -1, 2)[..., None]
    o = o.reshape(nbat, lp, hk, grp, dh)[:, :seq].astype(q.dtype)
    lse = jnp.moveaxis(m + jnp.log(den), -1, 2).reshape(nbat, lp, hk, grp)[:, :seq]
    return o, lse


def dilated_attention(q, k, v, dilation, half_span):
    bsz, seq, heads, dh = q.shape
    d = dilation
    ls = seq // d

    def to_res(t):
        return jnp.swapaxes(t.reshape(bsz, ls, d, heads, dh), 1, 2).reshape(bsz * d, ls, heads, dh)

    o, lse = banded_attention(to_res(q)[:, :, :, None], to_res(k), to_res(v), half_span, DIL_BLOCK)
    o = jnp.swapaxes(o[:, :, :, 0].reshape(bsz, d, ls, heads, dh), 1, 2).reshape(bsz, seq, heads, dh)
    lse = jnp.swapaxes(lse[..., 0].reshape(bsz, d, ls, heads), 1, 2).reshape(bsz, seq, heads)
    return o, lse


def memory_cross_attention(z_q, mem, mem_g, w_mem_kv):
    bsz, seq = z_q.shape[0], z_q.shape[1]
    n_mem = mem.shape[1]
    q = z_q.reshape(bsz, seq, X_HEADS, X_HEAD_DIM)
    kv = (rms_norm(mem, mem_g) @ w_mem_kv).reshape(bsz, n_mem, 2, X_HEADS, X_HEAD_DIM)
    s = jnp.einsum('blhd,bmhd->bhlm', q, kv[:, :, 0], preferred_element_type=jnp.float32) * (X_HEAD_DIM ** -0.5)
    p = jax.nn.softmax(s, axis=-1)
    o = jnp.einsum('bhlm,bmhd->blhd', p, kv[:, :, 1].astype(jnp.float32))
    return o.reshape(bsz, seq, X_WIDTH).astype(z_q.dtype)


def even_layer_mixer(h, mem, w_in, w_out, hy_conv_w, hy_conv_b, hy_filt_w1, hy_filt_b1, hy_filt_w2, hy_filt_b2,
                     hy_filt_w3, hy_freq, hy_skip, gdn_conv_w, gdn_A_log, gdn_dt_bias, gdn_norm_g, mem_g, w_mem_kv):
    bsz, seq, _ = h.shape
    z = h @ w_in
    z_hy, g_hy, z_qkv, g_gdn, z_beta, z_a, z_xq, g_x = split_cols(z, EVEN_IN_WIDTHS)
    uc = centred_depthwise_conv(z_hy, hy_conv_w) + hy_conv_b
    x0, x1, v_hy = jnp.split(uc, 3, axis=-1)
    h_fwd, h_bwd = hyena_filters(seq, hy_filt_w1, hy_filt_b1, hy_filt_w2, hy_filt_b2, hy_filt_w3, hy_freq)
    y_a = x0 * bidir_long_conv(v_hy * x1, h_fwd, h_bwd, hy_skip)
    y_a = y_a * jax.nn.silu(g_hy)
    qkv = jax.nn.silu(centred_depthwise_conv(z_qkv, gdn_conv_w)).astype(jnp.float32)
    qkv = qkv.reshape(bsz, seq, 3, GDN_HEADS, GDN_HEAD_DIM)
    q = l2_normalize(qkv[:, :, 0]) * (GDN_HEAD_DIM ** -0.5)
    k = l2_normalize(qkv[:, :, 1])
    v = qkv[:, :, 2]
    beta = jax.nn.sigmoid(z_beta.astype(jnp.float32)).reshape(bsz, seq, 2, GDN_HEADS)
    g = -jnp.exp(gdn_A_log.astype(jnp.float32)) * jax.nn.softplus(
        z_a.astype(jnp.float32).reshape(bsz, seq, 2, GDN_HEADS) + gdn_dt_bias.astype(jnp.float32))
    qh, kh, vh = jnp.moveaxis(q, 1, 2), jnp.moveaxis(k, 1, 2), jnp.moveaxis(v, 1, 2)
    gh, bh = jnp.moveaxis(g, 1, 3), jnp.moveaxis(beta, 1, 3)
    o_f = gated_delta_chunked(qh, kh, vh, gh[:, 0], bh[:, 0])
    o_b = jnp.flip(gated_delta_chunked(jnp.flip(qh, 2), jnp.flip(kh, 2), jnp.flip(vh, 2),
                                       jnp.flip(gh[:, 1], 2), jnp.flip(bh[:, 1], 2)), 2)
    o = jnp.moveaxis(o_f + o_b, 1, 2)
    y_b = rms_norm(o, gdn_norm_g).reshape(bsz, seq, GDN_WIDTH).astype(h.dtype) * jax.nn.silu(g_gdn)
    y_x = memory_cross_attention(z_xq, mem, mem_g, w_mem_kv) * jax.nn.silu(g_x)
    return jnp.concatenate([y_a, y_b, y_x], axis=-1) @ w_out


def odd_layer_mixer(h, mem, w_in, w_out, swa_sink, mem_g, w_mem_kv):
    bsz, seq, _ = h.shape
    z = h @ w_in
    z_cqkv, g_c, z_dq, z_dkv, g_d, z_xq, g_x = split_cols(z, ODD_IN_WIDTHS)
    cqkv = z_cqkv.reshape(bsz, seq, 3, N_DIL, DIL_HEADS, DIL_HEAD_DIM)
    cq = partial_rope(cqkv[:, :, 0])
    ck = partial_rope(cqkv[:, :, 1])
    cv = cqkv[:, :, 2]
    outs, lses = [], []
    for gi, (window, dilation) in enumerate(DIL_PATTERNS):
        o_g, lse_g = dilated_attention(cq[:, :, gi], ck[:, :, gi], cv[:, :, gi], dilation, window // (2 * dilation))
        outs.append(o_g)
        lses.append(lse_g)
    wts = jax.nn.softmax(jnp.stack(lses, axis=0), axis=0)
    y_c = jnp.sum(wts[..., None] * jnp.stack(outs, axis=0).astype(jnp.float32), axis=0)
    y_c = y_c.reshape(bsz, seq, DIL_WIDTH).astype(h.dtype) * jax.nn.silu(g_c)
    dq = partial_rope(z_dq.reshape(bsz, seq, SWA_Q_HEADS, SWA_HEAD_DIM))
    dq = dq.reshape(bsz, seq, SWA_KV_HEADS, SWA_Q_HEADS // SWA_KV_HEADS, SWA_HEAD_DIM)
    dkv = z_dkv.reshape(bsz, seq, 2, SWA_KV_HEADS, SWA_HEAD_DIM)
    dk = partial_rope(dkv[:, :, 0])
    dv = dkv[:, :, 1]
    y_d, _ = banded_attention(dq, dk, dv, SWA_HALF_WINDOW, SWA_BLOCK,
                              sink=swa_sink.reshape(SWA_KV_HEADS, SWA_Q_HEADS // SWA_KV_HEADS))
    y_d = y_d.reshape(bsz, seq, SWA_WIDTH) * jax.nn.silu(g_d)
    y_x = memory_cross_attention(z_xq, mem, mem_g, w_mem_kv) * jax.nn.silu(g_x)
    return jnp.concatenate([y_c, y_d, y_x], axis=-1) @ w_out


def encoder_trunk(x, mem, even_params, odd_params):
    for layer in range(DEPTH):
        i = layer // 2
        if layer % 2 == 0:
            pre_g, post_g, *mix = [p[i] for p in even_params]
            out = even_layer_mixer(rms_norm(x, pre_g), mem, *mix)
        else:
            pre_g, post_g, *mix = [p[i] for p in odd_params]
            out = odd_layer_mixer(rms_norm(x, pre_g), mem, *mix)
        x = x + rms_norm(out, post_g)
    return x


def setup_inputs(seed: int = 0) -> dict:
    key = jax.random.key(seed)
    keys = list(jax.random.split(key, 32))
    nk = keys.pop
    n_even = (DEPTH + 1) // 2
    n_odd = DEPTH // 2
    d = D_MODEL

    def normal(shape, scale=1.0):
        return scale * jax.random.normal(nk(), shape, jnp.float32)

    def gain(shape):
        return 1.0 + normal(shape, 0.02)

    dt = jnp.exp(jax.random.uniform(nk(), (n_even, 2, GDN_HEADS), jnp.float32, math.log(1e-3), math.log(1e-1)))
    a_log = jnp.log(jax.random.uniform(nk(), (n_even, 2, GDN_HEADS), jnp.float32, 1.0, 16.0))
    return {
        'x_prompt': normal((BATCH, SEQ, d)),
        'x_sample': normal((DEC_BATCH, DEC_SEQ, d)),
        'mem_prompt': normal((BATCH, MEM_TOKENS, d)),
        'mem_sample': normal((DEC_BATCH, MEM_TOKENS, d)),
        'e_pre_g': gain((n_even, d)),
        'e_post_g': gain((n_even, d)),
        'e_w_in': normal((n_even, d, EVEN_IN), d ** -0.5),
        'e_w_out': normal((n_even, EVEN_OUT, d), EVEN_OUT ** -0.5),
        'hy_conv_w': normal((n_even, HY_SHORT, 3 * HY_WIDTH), HY_SHORT ** -0.5),
        'hy_conv_b': normal((n_even, 3 * HY_WIDTH), 0.02),
        'hy_filt_w1': normal((n_even, HY_EMB, HY_FILT_HIDDEN), HY_EMB ** -0.5),
        'hy_filt_b1': normal((n_even, HY_FILT_HIDDEN), 0.1),
        'hy_filt_w2': normal((n_even, HY_FILT_HIDDEN, HY_FILT_HIDDEN), HY_FILT_HIDDEN ** -0.5),
        'hy_filt_b2': normal((n_even, HY_FILT_HIDDEN), 0.1),
        'hy_filt_w3': normal((n_even, HY_FILT_HIDDEN, 2 * HY_WIDTH), HY_FILT_HIDDEN ** -0.5),
        'hy_freq': gain((n_even, HY_FILT_HIDDEN)),
        'hy_skip': normal((n_even, HY_WIDTH)),
        'gdn_conv_w': normal((n_even, GDN_SHORT, 3 * GDN_WIDTH), GDN_SHORT ** -0.5),
        'gdn_A_log': a_log,
        'gdn_dt_bias': dt + jnp.log(-jnp.expm1(-dt)),
        'gdn_norm_g': gain((n_even, GDN_HEAD_DIM)),
        'e_mem_g': gain((n_even, d)),
        'e_w_mem_kv': normal((n_even, d, 2 * X_WIDTH), d ** -0.5),
        'o_pre_g': gain((n_odd, d)),
        'o_post_g': gain((n_odd, d)),
        'o_w_in': normal((n_odd, d, ODD_IN), d ** -0.5),
        'o_w_out': normal((n_odd, ODD_OUT, d), ODD_OUT ** -0.5),
        'swa_sink': normal((n_odd, SWA_Q_HEADS), 0.5),
        'o_mem_g': gain((n_odd, d)),
        'o_w_mem_kv': normal((n_odd, d, 2 * X_WIDTH), d ** -0.5),
    }


def reference(x_prompt, x_sample, mem_prompt, mem_sample, e_pre_g, e_post_g, e_w_in, e_w_out, hy_conv_w, hy_conv_b,
              hy_filt_w1, hy_filt_b1, hy_filt_w2, hy_filt_b2, hy_filt_w3, hy_freq, hy_skip, gdn_conv_w, gdn_A_log,
              gdn_dt_bias, gdn_norm_g, e_mem_g, e_w_mem_kv, o_pre_g, o_post_g, o_w_in, o_w_out, swa_sink, o_mem_g,
              o_w_mem_kv):
    even_params = (e_pre_g, e_post_g, e_w_in, e_w_out, hy_conv_w, hy_conv_b, hy_filt_w1, hy_filt_b1, hy_filt_w2,
                   hy_filt_b2, hy_filt_w3, hy_freq, hy_skip, gdn_conv_w, gdn_A_log, gdn_dt_bias, gdn_norm_g,
                   e_mem_g, e_w_mem_kv)
    odd_params = (o_pre_g, o_post_g, o_w_in, o_w_out, swa_sink, o_mem_g, o_w_mem_kv)
    y_prompt = encoder_trunk(x_prompt, mem_prompt, even_params, odd_params)
    y_sample = encoder_trunk(x_sample, mem_sample, even_params, odd_params)
    return (y_prompt, y_sample)
```

```cpp
#include <hip/hip_runtime.h>
#include <hip/hip_cooperative_groups.h>
#include <cstdio>
namespace cg = cooperative_groups;

typedef unsigned short u16;
typedef __attribute__((ext_vector_type(8))) short bf16x8;
typedef __attribute__((ext_vector_type(4))) float f32x4;

#define DEVI __device__ __forceinline__
#define EPSF 1e-6f

#ifndef DUPMASK
#define DUPMASK 0
#endif
#define REP(k) for (int rep_ = 0; rep_ < 1 + ((DUPMASK >> (k)) & 1); ++rep_)
constexpr int GT = 16384;
constexpr int NGROUP = 5;
constexpr int ZSE = 9344;
constexpr int ZSO = 8448;
constexpr int CATW = 2560;
constexpr int E_HY = 0, E_GHY = 3072, E_QKV = 4096, E_GG = 7168, E_XQ = 8192, E_GX = 8704, E_BETA = 9216, E_A = 9232;
constexpr int O_CQ = 0, O_CK = 1536, O_CV = 3072, O_GC = 4608, O_DQ = 5120, O_DK = 6144, O_DV = 6272, O_GD = 6400, O_XQ = 7424, O_GX = 7936;

constexpr size_t OFF_WT_E_IN  = 0;
constexpr size_t OFF_WT_O_IN  = OFF_WT_E_IN  + (size_t)ZSE * 1024 * 2;
constexpr size_t OFF_WT_E_OUT = OFF_WT_O_IN  + (size_t)ZSO * 1024 * 2;
constexpr size_t OFF_WT_O_OUT = OFF_WT_E_OUT + (size_t)1024 * 2560 * 2;
constexpr size_t OFF_WT_E_MKV = OFF_WT_O_OUT + (size_t)1024 * 2048 * 2;
constexpr size_t OFF_WT_O_MKV = OFF_WT_E_MKV + (size_t)1024 * 1024 * 2;
constexpr size_t OFF_MKV_E    = OFF_WT_O_MKV + (size_t)1024 * 1024 * 2;
constexpr size_t OFF_MKV_O    = OFF_MKV_E    + (size_t)6144 * 1024 * 2;
constexpr size_t OFF_HR_A     = OFF_MKV_O    + (size_t)6144 * 1024 * 2;
constexpr size_t OFF_HR_B     = OFF_HR_A     + (size_t)1024 * 4096 * 2;
constexpr size_t OFF_Z        = OFF_HR_B     + (size_t)1024 * 8192 * 2;
constexpr size_t OFF_CAT      = OFF_Z        + (size_t)GT * ZSE * 2;
constexpr size_t OFF_OUT      = OFF_CAT      + (size_t)GT * CATW * 2;
constexpr size_t OFF_RSP      = OFF_OUT      + (size_t)GT * 1024 * 4;
constexpr size_t OFF_UT       = OFF_RSP      + (size_t)GT * 16 * 4;
constexpr size_t OFF_YT       = OFF_UT       + (size_t)1024 * GT * 2;
constexpr size_t OFF_QKVN     = OFF_YT       + (size_t)1024 * GT * 2;
constexpr size_t OFF_GBA      = OFF_QKVN     + (size_t)GT * 3072 * 4;
constexpr size_t OFF_OF       = OFF_GBA      + (size_t)GT * 32 * 4;
constexpr size_t OFF_OB       = OFF_OF       + (size_t)GT * 1024 * 4;
constexpr size_t OFF_END      = OFF_OB       + (size_t)GT * 1024 * 4;
constexpr size_t OFF_OG       = OFF_QKVN;
constexpr size_t OFF_LSE      = OFF_OG + (size_t)GT * 1536 * 2;
constexpr size_t OFF_BAR      = OFF_END;
constexpr size_t OFF_XB       = OFF_BAR + 16384;
constexpr size_t OFF_RINVB    = OFF_XB + (size_t)GT * 1024 * 2;
constexpr size_t OFF_MEMB     = OFF_RINVB + (size_t)GT * 4;
constexpr size_t OFF_RINVM    = OFF_MEMB + (size_t)6144 * 1024 * 2;
static_assert(OFF_RINVM + 6144 * 4 <= (size_t)1 << 30, "workspace too large");

struct P {
  const float *xp, *xs, *memp, *mems;
  const float *e_pre_g, *e_post_g, *e_w_in, *e_w_out, *hy_conv_w, *hy_conv_b, *hy_w1, *hy_b1, *hy_w2, *hy_b2, *hy_w3,
      *hy_freq, *hy_skip, *gdn_conv_w, *gdn_A_log, *gdn_dt_bias, *gdn_norm_g, *e_mem_g, *e_w_mkv;
  const float *o_pre_g, *o_post_g, *o_w_in, *o_w_out, *swa_sink, *o_mem_g, *o_w_mkv;
  float* out;
  char* ws;
};

DEVI int tidx() { int t = __builtin_amdgcn_workitem_id_x(); asm volatile("" : "+v"(t)); return t; }
DEVI u16 f2bf(float f) {
  unsigned u = __float_as_uint(f);
  u += 0x7fffu + ((u >> 16) & 1u);
  return (u16)(u >> 16);
}
DEVI float bf2f(u16 h) { return __uint_as_float(((unsigned)h) << 16); }
DEVI unsigned pack2(float a, float b) { return (unsigned)f2bf(a) | ((unsigned)f2bf(b) << 16); }
DEVI float lo2f(unsigned u) { return __uint_as_float(u << 16); }
DEVI float hi2f(unsigned u) { return __uint_as_float(u & 0xffff0000u); }
DEVI float silu(float x) { return x / (1.f + __expf(-x)); }
DEVI void fsincos(float x, float* sn, float* cs) {
  const float k = rintf(x * 0.15915494309189535f);
  float r = fmaf(-k, 6.28125f, x);
  r = fmaf(-k, 0.0019353071795864769f, r);
  *sn = __sinf(r);
  *cs = __cosf(r);
}
#define DPP_ADD(v, ctrl) ((v) + __int_as_float(__builtin_amdgcn_mov_dpp(__float_as_int(v), (ctrl), 0xf, 0xf, true)))
DEVI float wave_sum(float v) {
  v = DPP_ADD(v, 0xB1);
  v = DPP_ADD(v, 0x4E);
  v = DPP_ADD(v, 0x141);
  v = DPP_ADD(v, 0x140);
  const float r0 = __int_as_float(__builtin_amdgcn_readlane(__float_as_int(v), 0));
  const float r1 = __int_as_float(__builtin_amdgcn_readlane(__float_as_int(v), 16));
  const float r2 = __int_as_float(__builtin_amdgcn_readlane(__float_as_int(v), 32));
  const float r3 = __int_as_float(__builtin_amdgcn_readlane(__float_as_int(v), 48));
  return (r0 + r1) + (r2 + r3);
}


DEVI float xmax16(float v) { auto r = __builtin_amdgcn_permlane16_swap(__float_as_uint(v), __float_as_uint(v), false, false); return fmaxf(__uint_as_float(r[0]), __uint_as_float(r[1])); }
DEVI float xmax32(float v) { auto r = __builtin_amdgcn_permlane32_swap(__float_as_uint(v), __float_as_uint(v), false, false); return fmaxf(__uint_as_float(r[0]), __uint_as_float(r[1])); }
DEVI float xsum16(float v) { auto r = __builtin_amdgcn_permlane16_swap(__float_as_uint(v), __float_as_uint(v), false, false); return __uint_as_float(r[0]) + __uint_as_float(r[1]); }
DEVI float xsum32(float v) { auto r = __builtin_amdgcn_permlane32_swap(__float_as_uint(v), __float_as_uint(v), false, false); return __uint_as_float(r[0]) + __uint_as_float(r[1]); }
DEVI float row_sum16(float v) {
  v = DPP_ADD(v, 0xB1); v = DPP_ADD(v, 0x4E); v = DPP_ADD(v, 0x141); v = DPP_ADD(v, 0x140);
  return v;
}

#define XB_TMO      128
#define XB_XCNT(j)  (256  + 64 * (j))
#define XB_XSUB(j)  (1280 + 64 * (j))
#define XB_XGEN(j)  (2304 + 64 * (j))
#define XB_TOP      3328
#define XB_TOPGEN   3392
#define XCD_BAR_WORDS 3456
#define XB_SPIN_CAP (1u << 22)
DEVI unsigned xb_ld(unsigned* p) { return __hip_atomic_load(p, __ATOMIC_RELAXED, __HIP_MEMORY_SCOPE_AGENT); }
DEVI unsigned xb_add(unsigned* p, unsigned v) { return __hip_atomic_fetch_add(p, v, __ATOMIC_RELAXED, __HIP_MEMORY_SCOPE_AGENT); }
DEVI unsigned xb_xcc_id() { return (unsigned)__builtin_amdgcn_s_getreg((3 << 11) | 20) & 0xFu; }
#define XB_SPIN(cond, bar) do { unsigned _sp = 0; while (cond) { __builtin_amdgcn_s_sleep(1); \
    if ((++_sp & 255u) == 0u) { if (xb_ld(&(bar)[XB_TMO])) break; if (_sp > XB_SPIN_CAP) { atomicAdd(&(bar)[XB_TMO], 1u); break; } } } } while (0)
struct XcdBarrier { unsigned* bar; unsigned x; unsigned nloc; unsigned nx; };
DEVI void xcd_barrier_complete(unsigned* bar, unsigned x, unsigned& nloc, unsigned& nx) {
  const unsigned G = gridDim.x;
  unsigned sum, cnt, mine, sp = 0u;
  for (;;) {
    sum = 0u; cnt = 0u; mine = 0u;
#pragma unroll
    for (unsigned j = 0; j < 16; ++j) { const unsigned c = xb_ld(&bar[XB_XCNT(j)]); sum += c; cnt += (c > 0u) ? 1u : 0u; mine = (j == x) ? c : mine; }
    if (sum == G) break;
    __builtin_amdgcn_s_sleep(1);
    if ((++sp & 255u) == 0u) { if (xb_ld(&bar[XB_TMO])) break; if (sp > XB_SPIN_CAP) { atomicAdd(&bar[XB_TMO], 1u); break; } }
  }
  nloc = mine > 0u ? mine : 1u; nx = cnt > 0u ? cnt : 1u;
}
DEVI void xcd_barrier(XcdBarrier& b) {
  asm volatile("s_waitcnt vmcnt(0)" ::: "memory");
  __syncthreads();
  if (__builtin_amdgcn_workitem_id_x() == 0) {
    unsigned* bar = b.bar;
    __builtin_amdgcn_s_waitcnt(0);
    if (b.nloc == 0u) xcd_barrier_complete(bar, b.x, b.nloc, b.nx);
    const unsigned nloc = b.nloc, nx = b.nx;
    const unsigned old = xb_add(&bar[XB_XSUB(b.x)], 1u);
    const unsigned gen = old / nloc;
    if (old + 1u == (gen + 1u) * nloc) {
      __builtin_amdgcn_fence(__ATOMIC_RELEASE, "agent");
      asm volatile("s_waitcnt vmcnt(0)" ::: "memory");
      const unsigned og = xb_add(&bar[XB_TOP], 1u);
      const unsigned tg = og / nx;
      if (og + 1u == (tg + 1u) * nx) xb_add(&bar[XB_TOPGEN], 1u);
      else XB_SPIN(xb_ld(&bar[XB_TOPGEN]) == tg, bar);
      __builtin_amdgcn_fence(__ATOMIC_ACQUIRE, "agent");
      xb_add(&bar[XB_XGEN(b.x)], 1u);
      asm volatile("s_waitcnt vmcnt(0)" ::: "memory");
    } else {
      XB_SPIN(xb_ld(&bar[XB_XGEN(b.x)]) == gen, bar);
      __builtin_amdgcn_fence(__ATOMIC_ACQUIRE, "agent");
      asm volatile("s_waitcnt vmcnt(0)" ::: "memory");
    }
  }
  __syncthreads();
}

struct Epi { void* out; int ldo; float* rsp; int L; const float* rinv; };

template <int EPI>
__device__ __forceinline__ void gemm_phase(int first, int stride, int ntiles, int tmc, const u16* Abase, int lda, const u16* Wbase, int K, const Epi& e, char* smem) {
  const int tid = tidx(), lane = tid & 63, w = tid >> 6, wr = w >> 1, wc = w & 1, fr = lane & 15, fq = lane >> 4;
  const int gr = tid >> 2, gp = tid & 3;
  int it = first;
  if (it >= ntiles) return;
  const u16* Ab = Abase + (size_t)((it % tmc) * 256 + gr) * lda + gp * 8;
  const u16* Wp = Wbase + (size_t)((it / tmc) * 128 + gr) * K + gp * 8;
  const size_t a64 = (size_t)64 * lda, w64 = (size_t)64 * K;
  char* stA = smem + gr * 64 + ((gp ^ (((gr >> 3) & 1) * 3)) * 16);
  char* stB = stA + 16384;
  const int cho = (fq ^ ((fr >> 3) * 3)) * 16;
  const char* rdA = smem + (wr * 128 + fr) * 64 + cho;
  const char* rdB = smem + 16384 + (wc * 64 + fr) * 64 + cho;
  uint4 ra0_0, ra0_1, ra0_2, ra0_3, rb0_0, rb0_1, ra1_0, ra1_1, ra1_2, ra1_3, rb1_0, rb1_1;
  const int nk = K / 32;
#define G_LOAD(u, k0) ra##u##_0 = *(const uint4*)(Ab + (k0)); ra##u##_1 = *(const uint4*)(Ab + a64 + (k0)); ra##u##_2 = *(const uint4*)(Ab + 2 * a64 + (k0)); ra##u##_3 = *(const uint4*)(Ab + 3 * a64 + (k0)); \
                      rb##u##_0 = *(const uint4*)(Wp + (k0)); rb##u##_1 = *(const uint4*)(Wp + w64 + (k0));
#define G_STORE(u, stg) { char* pa_ = stA + (stg) * 24576; char* pb_ = stB + (stg) * 24576; \
    *(uint4*)pa_ = ra##u##_0; *(uint4*)(pa_ + 4096) = ra##u##_1; *(uint4*)(pa_ + 8192) = ra##u##_2; *(uint4*)(pa_ + 12288) = ra##u##_3; \
    *(uint4*)pb_ = rb##u##_0; *(uint4*)(pb_ + 4096) = rb##u##_1; }
#define G_COMPUTE(stg) { const char* qa_ = rdA + (stg) * 24576; const char* qb_ = rdB + (stg) * 24576; bf16x8 fb_[4]; \
    _Pragma("unroll") for (int ni = 0; ni < 4; ++ni) fb_[ni] = *(const bf16x8*)(qb_ + ni * 1024); \
    _Pragma("unroll") for (int mh = 0; mh < 2; ++mh) { bf16x8 fa_[4]; \
      _Pragma("unroll") for (int mi = 0; mi < 4; ++mi) fa_[mi] = *(const bf16x8*)(qa_ + (mh * 4 + mi) * 1024); \
      __builtin_amdgcn_s_setprio(1); \
      _Pragma("unroll") for (int mi = 0; mi < 4; ++mi) _Pragma("unroll") for (int ni = 0; ni < 4; ++ni) \
        acc[mh * 4 + mi][ni] = __builtin_amdgcn_mfma_f32_16x16x32_bf16(fb_[ni], fa_[mi], acc[mh * 4 + mi][ni], 0, 0, 0); \
      __builtin_amdgcn_s_setprio(0); } }
  G_LOAD(0, 0) G_LOAD(1, 32)
#pragma unroll 1
  for (;;) {
  const int m0 = (it % tmc) * 256, n0 = (it / tmc) * 128;
  f32x4 acc[8][4];
#pragma unroll
  for (int i = 0; i < 8; ++i)
#pragma unroll
    for (int j = 0; j < 4; ++j) acc[i][j] = (f32x4){0.f, 0.f, 0.f, 0.f};
  G_STORE(0, 0)
  G_LOAD(0, 64)
  __syncthreads();
#pragma unroll 1
  for (int kt0 = 0; kt0 < nk; kt0 += 2) {
    G_STORE(1, 1)
    if (kt0 + 3 < nk) { const int k0 = (kt0 + 3) * 32; G_LOAD(1, k0) }
    G_COMPUTE(0)
    __syncthreads();
    if (kt0 + 2 < nk) G_STORE(0, 0)
    if (kt0 + 4 < nk) { const int k0 = (kt0 + 4) * 32; G_LOAD(0, k0) }
    G_COMPUTE(1)
    __syncthreads();
  }
  const int itn = it + stride;
  if (itn < ntiles) {
    Ab = Abase + (size_t)((itn % tmc) * 256 + gr) * lda + gp * 8;
    Wp = Wbase + (size_t)((itn / tmc) * 128 + gr) * K + gp * 8;
    G_LOAD(0, 0) G_LOAD(1, 32)
  }
  if (EPI == 0 || EPI == 1) {
    u16* out = (u16*)e.out;
    const int cb = n0 + wc * 64;
    int ropemode = 0;
    if (EPI == 1) {
      if (cb < 3072 && (cb & 127) == 0) ropemode = 1;
      else if (cb >= O_DQ && cb < O_DV) ropemode = 2;
    }
#pragma unroll
    for (int mi = 0; mi < 8; ++mi) {
      const int rl = wr * 128 + mi * 16 + fr;
      const int row = m0 + rl;
      const float rv = e.rinv[row];
      f32x4 v[4];
#pragma unroll
      for (int ni = 0; ni < 4; ++ni) v[ni] = acc[mi][ni] * rv;
      if (EPI == 1 && ropemode != 0) {
        const float pos = (float)(row % e.L);
        if (ropemode == 1) {
#pragma unroll
          for (int j = 0; j < 4; ++j) {
            const int i = fq * 4 + j;
            const float inv = __expf(-13.122363377404328f * (float)i * (1.f / 16.f));
            float sn, cs;
            fsincos(pos * inv, &sn, &cs);
            const float x1 = v[0][j], x2 = v[1][j];
            v[0][j] = x1 * cs - x2 * sn;
            v[1][j] = x2 * cs + x1 * sn;
          }
        } else {
#pragma unroll
          for (int j = 0; j < 4; ++j) {
            const int i = (fq & 1) * 4 + j;
            const float inv = __expf(-13.122363377404328f * (float)i * (1.f / 8.f));
            float sn, cs;
            fsincos(pos * inv, &sn, &cs);
            const float mine = v[0][j];
            const float other = __shfl_xor(mine, 32);
            v[0][j] = (fq < 2) ? (mine * cs - other * sn) : (mine * cs + other * sn);
          }
        }
      }
#pragma unroll
      for (int ni = 0; ni < 4; ++ni) {
        const int col = cb + ni * 16 + fq * 4;
        uint2 pk = make_uint2(pack2(v[ni][0], v[ni][1]), pack2(v[ni][2], v[ni][3]));
        *(uint2*)(out + (size_t)row * e.ldo + col) = pk;
      }
    }
  } else {
    float* out = (float*)e.out;
    const int slot = (n0 >> 7) * 2 + wc;
#pragma unroll
    for (int mi = 0; mi < 8; ++mi) {
      const int row = m0 + wr * 128 + mi * 16 + fr;
      float sq = 0.f;
#pragma unroll
      for (int ni = 0; ni < 4; ++ni) {
        const int col = n0 + wc * 64 + ni * 16 + fq * 4;
        f32x4 v = acc[mi][ni];
        sq += v[0] * v[0] + v[1] * v[1] + v[2] * v[2] + v[3] * v[3];
        *(float4*)(out + (size_t)row * e.ldo + col) = make_float4(v[0], v[1], v[2], v[3]);
      }
      sq = xsum16(sq);
      sq = xsum32(sq);
      if (fq == 0) e.rsp[(size_t)row * 16 + slot] = sq;
    }
  }
  if (itn >= ntiles) break;
  it = itn;
  }
#undef G_COMPUTE
#undef G_STORE
#undef G_LOAD
}

__device__ __forceinline__ void rowprep_item(int item, const float* src, u16* dst, float* rinv) {
  const int tid = tidx(), lane = tid & 63, w = tid >> 6;
  const int row = item * 4 + w;
  float sq = 0.f;
#pragma unroll
  for (int i = 0; i < 4; ++i) {
    const int col = i * 256 + lane * 4;
    const float4 x = *(const float4*)(src + (size_t)row * 1024 + col);
    sq += x.x * x.x + x.y * x.y + x.z * x.z + x.w * x.w;
    *(uint2*)(dst + (size_t)row * 1024 + col) = make_uint2(pack2(x.x, x.y), pack2(x.z, x.w));
  }
  sq = wave_sum(sq);
  if (lane == 0) rinv[row] = rsqrtf(sq * (1.f / 1024.f) + EPSF);
}

DEVI int srccol_even(int n) {
  if (n < 8192) return n;
  if (n < 9216) return n + 32;
  if (n < 9248) return n - 1024;
  return -1;
}
__device__ __forceinline__ void wt_tile(const float* src, int Nsrc, const float* gain, u16* dst, int K, int kt, int nt, int evenmap, char* smem) {
  float (*tile)[65] = (float (*)[65])smem;
  const int tid = tidx(), r = tid >> 6, c = tid & 63;
  const int n = nt * 64 + c;
  const int sc = evenmap ? srccol_even(n) : n;
#pragma unroll
  for (int rr = r; rr < 64; rr += 4) {
    const int k = kt * 64 + rr;
    float v = 0.f;
    if (sc >= 0) v = src[(size_t)k * Nsrc + sc] * (gain ? gain[k] : 1.f);
    tile[rr][c] = v;
  }
  __syncthreads();
  for (int rr = r; rr < 64; rr += 4) {
    const int nn = nt * 64 + rr;
    const int k = kt * 64 + c;
    dst[(size_t)nn * K + k] = f2bf(tile[c][rr]);
  }
  __syncthreads();
}

__device__ __forceinline__ void filt_item(const P& p, int L, int pc, int cc, u16* Hr, char* smem) {
  float (*semb)[33] = (float (*)[33])smem;
  float (*sh1)[65] = (float (*)[65])(smem + 64 * 33 * 4);
  float (*sh2)[65] = (float (*)[65])(smem + 64 * 33 * 4 + 64 * 65 * 4);
  const int tid = tidx();
  for (int idx = tid; idx < 64 * 17; idx += 256) {
    const int i = idx / 17, b = idx % 17;
    const int t = pc * 64 + i;
    if (b == 16) {
      semb[i][0] = (float)t / (float)(L - 1);
    } else {
      const float f = 1e-4f + (float)b * ((15.f - 1e-4f) / 15.f);
      const float wv = (6.283185307179586f / (float)L) * (float)t;
      float sn, cs;
      fsincos(f * wv, &sn, &cs);
      semb[i][1 + b] = cs;
      semb[i][17 + b] = -sn;
    }
  }
  __syncthreads();
  {
    const int hh = tid & 63, ig = tid >> 6;
    const float fr_ = p.hy_freq[hh], b1 = p.hy_b1[hh];
    float a16[16];
#pragma unroll
    for (int r = 0; r < 16; ++r) a16[r] = b1;
    const float* wp = p.hy_w1 + hh;
#pragma unroll 1
    for (int e0 = 0; e0 < 33; e0 += 11) {
      float wv[11];
#pragma unroll
      for (int q = 0; q < 11; ++q) wv[q] = wp[(e0 + q) * 64];
#pragma unroll
      for (int q = 0; q < 11; ++q)
#pragma unroll
        for (int r = 0; r < 16; ++r) a16[r] += semb[ig * 16 + r][e0 + q] * wv[q];
    }
#pragma unroll
    for (int r = 0; r < 16; ++r) { float sn_, cs_; fsincos(fr_ * a16[r], &sn_, &cs_); sh1[ig * 16 + r][hh] = sn_; }
  }
  __syncthreads();
  {
    const int hh = tid & 63, ig = tid >> 6;
    const float fr_ = p.hy_freq[hh], b2 = p.hy_b2[hh];
    float a16[16];
#pragma unroll
    for (int r = 0; r < 16; ++r) a16[r] = b2;
    const float* wp = p.hy_w2 + hh;
#pragma unroll 1
    for (int k0 = 0; k0 < 64; k0 += 8) {
      float wv[8];
#pragma unroll
      for (int q = 0; q < 8; ++q) wv[q] = wp[(k0 + q) * 64];
#pragma unroll
      for (int q = 0; q < 8; ++q)
#pragma unroll
        for (int r = 0; r < 16; ++r) a16[r] += sh1[ig * 16 + r][k0 + q] * wv[q];
    }
#pragma unroll
    for (int r = 0; r < 16; ++r) { float sn_, cs_; fsincos(fr_ * a16[r], &sn_, &cs_); sh2[ig * 16 + r][hh] = sn_; }
  }
  __syncthreads();
  {
    const int c = cc * 256 + tid;
    const int ch = c & 1023;
    const bool bwd = c >= 1024;
    const float delta = 3.0701134573253946f + (float)ch * ((15.350567286626973f - 3.0701134573253946f) / 1023.f);
    const float skip = p.hy_skip[ch];
    u16* hr = Hr + (size_t)ch * (2 * L);
#pragma unroll 1
    for (int i0 = 0; i0 < 64; i0 += 8) {
      float acc8[8];
#pragma unroll
      for (int ii = 0; ii < 8; ++ii) acc8[ii] = 0.f;
      const float* wp = p.hy_w3 + c;
#pragma unroll 1
      for (int k0 = 0; k0 < 64; k0 += 8) {
        float wv[8];
#pragma unroll
        for (int q = 0; q < 8; ++q) wv[q] = wp[(size_t)(k0 + q) * 2048];
#pragma unroll
        for (int q = 0; q < 8; ++q)
#pragma unroll
          for (int ii = 0; ii < 8; ++ii) acc8[ii] += sh2[i0 + ii][k0 + q] * wv[q];
      }
#pragma unroll
      for (int ii = 0; ii < 8; ++ii) {
        const int t = pc * 64 + i0 + ii;
        float s = acc8[ii];
        const float tt = (float)t / (float)(L - 1);
        s *= __expf(-tt * delta);
        if (!bwd) {
          if (t == 0) s += skip;
          hr[L - 1 - t] = f2bf(s);
        } else if (t > 0) {
          hr[L - 1 + t] = f2bf(s);
        }
      }
    }
    if (bwd && pc == 0) hr[2 * L - 1] = 0;
  }
  __syncthreads();
}

__device__ __forceinline__ void hy_pre_item(const P& p, int L, int tt, int cq, const u16* z, u16* cat, u16* ut) {
  const int tid = tidx(), cg = tid & 31, tr = tid >> 5;
  const int c0 = cq * 128 + cg * 4;
  const int t0 = tt * 64 + tr * 8;
  float w[3][3][4], b[3][4];
#pragma unroll
  for (int s = 0; s < 3; ++s) {
#pragma unroll
    for (int j = 0; j < 3; ++j) {
      const float4 a = *(const float4*)(p.hy_conv_w + j * 3072 + s * 1024 + c0);
      w[s][j][0] = a.x; w[s][j][1] = a.y; w[s][j][2] = a.z; w[s][j][3] = a.w;
    }
    const float4 a = *(const float4*)(p.hy_conv_b + s * 1024 + c0);
    b[s][0] = a.x; b[s][1] = a.y; b[s][2] = a.z; b[s][3] = a.w;
  }
  uint2 prev[3], cur[3], nxt[3];
#pragma unroll
  for (int s = 0; s < 3; ++s) {
    prev[s] = ((t0 % L) > 0) ? *(const uint2*)(z + (size_t)(t0 - 1) * ZSE + E_HY + s * 1024 + c0) : make_uint2(0, 0);
    cur[s] = *(const uint2*)(z + (size_t)t0 * ZSE + E_HY + s * 1024 + c0);
  }
  unsigned up[4][4];
#pragma unroll
  for (int r = 0; r < 8; ++r) {
    const int t = t0 + r;
    const bool hasn = (t % L) < L - 1;
    float uc[3][4];
#pragma unroll
    for (int s = 0; s < 3; ++s) {
      nxt[s] = hasn ? *(const uint2*)(z + (size_t)(t + 1) * ZSE + E_HY + s * 1024 + c0) : make_uint2(0, 0);
      uc[s][0] = w[s][0][0] * lo2f(prev[s].x) + w[s][1][0] * lo2f(cur[s].x) + w[s][2][0] * lo2f(nxt[s].x) + b[s][0];
      uc[s][1] = w[s][0][1] * hi2f(prev[s].x) + w[s][1][1] * hi2f(cur[s].x) + w[s][2][1] * hi2f(nxt[s].x) + b[s][1];
      uc[s][2] = w[s][0][2] * lo2f(prev[s].y) + w[s][1][2] * lo2f(cur[s].y) + w[s][2][2] * lo2f(nxt[s].y) + b[s][2];
      uc[s][3] = w[s][0][3] * hi2f(prev[s].y) + w[s][1][3] * hi2f(cur[s].y) + w[s][2][3] * hi2f(nxt[s].y) + b[s][3];
      prev[s] = cur[s];
      cur[s] = nxt[s];
    }
    const uint2 g2 = *(const uint2*)(z + (size_t)t * ZSE + E_GHY + c0);
    *(uint2*)(cat + (size_t)t * 1024 + c0) = make_uint2(pack2(uc[0][0] * silu(lo2f(g2.x)), uc[0][1] * silu(hi2f(g2.x))),
                                                        pack2(uc[0][2] * silu(lo2f(g2.y)), uc[0][3] * silu(hi2f(g2.y))));
#pragma unroll
    for (int e2 = 0; e2 < 4; ++e2) {
      const unsigned hb = (unsigned)f2bf(uc[2][e2] * uc[1][e2]);
      if (r & 1) up[e2][r >> 1] |= hb << 16; else up[e2][r >> 1] = hb;
    }
  }
#pragma unroll
  for (int e2 = 0; e2 < 4; ++e2)
    *(uint4*)(ut + (size_t)(c0 + e2) * GT + t0) = make_uint4(up[e2][0], up[e2][1], up[e2][2], up[e2][3]);
}

__device__ __forceinline__ void hy_post_item(int tt, int cq, const u16* yt, const u16* gateA, u16* cat) {
  const int tid = tidx(), cg = tid & 31, tr = tid >> 5;
  const int c0 = cq * 128 + cg * 4;
  const int t0 = tt * 64 + tr * 8;
  unsigned yw[4][4];
#pragma unroll
  for (int e2 = 0; e2 < 4; ++e2) {
    const uint4 v = *(const uint4*)(yt + (size_t)(c0 + e2) * GT + t0);
    yw[e2][0] = v.x; yw[e2][1] = v.y; yw[e2][2] = v.z; yw[e2][3] = v.w;
  }
#pragma unroll
  for (int r = 0; r < 8; ++r) {
    u16* q = cat + (size_t)(t0 + r) * CATW + c0;
    const uint2 g = *(const uint2*)(gateA + (size_t)(t0 + r) * 1024 + c0);
    float y[4];
#pragma unroll
    for (int e2 = 0; e2 < 4; ++e2) y[e2] = (r & 1) ? hi2f(yw[e2][r >> 1]) : lo2f(yw[e2][r >> 1]);
    *(uint2*)q = make_uint2(pack2(lo2f(g.x) * y[0], hi2f(g.x) * y[1]), pack2(lo2f(g.y) * y[2], hi2f(g.y) * y[3]));
  }
}

__device__ __forceinline__ void hy_conv_item(int L, int nb, int ch, const u16* Hr, const u16* ut, u16* yt, char* smem) {
  unsigned* w0 = (unsigned*)smem;
  unsigned* w1 = w0 + L;
  u16* sU = (u16*)(w1 + L);
  constexpr int DL = 1024;
  const int S = 16 / nb;
  const int tid = tidx(), lane = tid & 63, w = tid >> 6, fr = lane & 15, fq = lane >> 4;
  {
    const u16* hr = Hr + (size_t)ch * 2 * L;
    const unsigned* hw = (const unsigned*)hr;
#pragma unroll 8
    for (int i = tid; i < L; i += 256) {
      const unsigned a = hw[i];
      const unsigned nx = (i + 1 < L) ? hw[i + 1] : 0u;
      w0[i] = a;
      if (i + 1 < L) w1[i] = (a >> 16) | (nx << 16);
    }
    const uint4* src = (const uint4*)(ut + (size_t)ch * GT);
    const int cpr = L / 8;
#pragma unroll
    for (int idx = tid; idx < GT / 8; idx += 256) {
      const int b = idx / cpr, q = idx % cpr;
      const int key = (b * S + ((q * 8) >> 10)) & 15;
      ((uint4*)sU)[b * cpr + (q ^ key)] = src[idx];
    }
  }
  __syncthreads();
  const int cs = fr / nb, cb = fr % nb;
  const int xl = L - 1 - fr + 8 * fq;
  const unsigned* wb = (xl & 1) ? (w1 + ((xl - 1) >> 1)) : (w0 + (xl >> 1));
  const uint4* urow = (const uint4*)sU + cb * (L / 8);
  const int mstart = -(S - 1) * DL;
#pragma unroll 1
  for (int pass = 0; pass < 2; ++pass) {
    const int n0 = (pass * 4 + w) * 128;
    f32x4 acc[8];
#pragma unroll
    for (int i = 0; i < 8; ++i) acc[i] = (f32x4){0.f, 0.f, 0.f, 0.f};
    union AF { unsigned u[4]; bf16x8 v; };
    AF ring[8];
#pragma unroll
    for (int i = 0; i < 8; ++i) {
      const unsigned* src = wb - ((n0 - mstart + 16 * i) >> 1);
      ring[i].u[0] = src[0]; ring[i].u[1] = src[1]; ring[i].u[2] = src[2]; ring[i].u[3] = src[3];
    }
#pragma unroll 1
    for (int m0 = mstart; m0 < L; m0 += 128) {
#pragma unroll
      for (int j = 0; j < 4; ++j) {
        const int mm = m0 + 32 * j;
        const int mb = mm + cs * DL;
        bf16x8 bfrag = {0, 0, 0, 0, 0, 0, 0, 0};
        if (mb >= 0 && mb < L) {
          const int mp = mb + 8 * fq;
          const int q = mp >> 3;
          const int key = (cb * S + (mp >> 10)) & 15;
          union { uint4 q4; bf16x8 v; } t;
          t.q4 = urow[q ^ key];
          bfrag = t.v;
        }
#pragma unroll
        for (int i = 0; i < 8; ++i)
          acc[i] = __builtin_amdgcn_mfma_f32_16x16x32_bf16(ring[(i - 2 * j) & 7].v, bfrag, acc[i], 0, 0, 0);
        if (mm + 32 < L) {
          const unsigned* s0 = wb - ((n0 - mm - 32) >> 1);
          AF& r0 = ring[(0 - 2 * (j + 1)) & 7];
          AF& r1 = ring[(1 - 2 * (j + 1)) & 7];
          r0.u[0] = s0[0]; r0.u[1] = s0[1]; r0.u[2] = s0[2]; r0.u[3] = s0[3];
          r1.u[0] = s0[-8]; r1.u[1] = s0[-7]; r1.u[2] = s0[-6]; r1.u[3] = s0[-5];
        }
      }
    }
#pragma unroll
    for (int i = 0; i < 8; ++i) {
      const int n = cs * DL + n0 + 16 * i + fq * 4;
      *(uint2*)(yt + (size_t)ch * GT + cb * L + n) = make_uint2(pack2(acc[i][0], acc[i][1]), pack2(acc[i][2], acc[i][3]));
    }
  }
  __syncthreads();
}

__device__ __forceinline__ void gdn_pre_item(const P& p, int L, int tt, int h, const u16* z, u16* qkvn, float* gba, u16* cat) {
  const int tid = tidx(), lane = tid & 63, w = tid >> 6;
  float cw[3][5][2];
#pragma unroll
  for (int s = 0; s < 3; ++s)
#pragma unroll
    for (int j = 0; j < 5; ++j) {
      cw[s][j][0] = p.gdn_conv_w[j * 3072 + s * 1024 + h * 128 + 2 * lane];
      cw[s][j][1] = p.gdn_conv_w[j * 3072 + s * 1024 + h * 128 + 2 * lane + 1];
    }
  const int t0 = tt * 64 + w * 16;
  const int seq0 = (t0 / L) * L;
  auto ld = [&](int t, int s) -> unsigned {
    if (t < seq0 || t >= seq0 + L) return 0u;
    return *(const unsigned*)(z + (size_t)t * ZSE + E_QKV + s * 1024 + h * 128 + 2 * lane);
  };
  unsigned win[3][5];
#pragma unroll
  for (int s = 0; s < 3; ++s) {
    win[s][0] = ld(t0 - 2, s);
    win[s][1] = ld(t0 - 1, s);
    win[s][2] = ld(t0, s);
    win[s][3] = ld(t0 + 1, s);
    win[s][4] = 0;
  }
#pragma unroll
  for (int r = 0; r < 16; ++r) {
    const int t = t0 + r;
    float y[3][2];
#pragma unroll
    for (int s = 0; s < 3; ++s) {
      win[s][4] = ld(t + 2, s);
      float a0 = 0.f, a1 = 0.f;
#pragma unroll
      for (int j = 0; j < 5; ++j) {
        a0 += lo2f(win[s][j]) * cw[s][j][0];
        a1 += hi2f(win[s][j]) * cw[s][j][1];
      }
      y[s][0] = silu(a0);
      y[s][1] = silu(a1);
#pragma unroll
      for (int j = 0; j < 4; ++j) win[s][j] = win[s][j + 1];
    }
    const float ssq = wave_sum(y[0][0] * y[0][0] + y[0][1] * y[0][1]);
    const float ssk = wave_sum(y[1][0] * y[1][0] + y[1][1] * y[1][1]);
    const float rq = rsqrtf(ssq + EPSF) * 0.08838834764831845f;
    const float rk = rsqrtf(ssk + EPSF);
    u16* dst = qkvn + ((size_t)t * 8 + h) * 384 + 2 * lane;
    *(unsigned*)dst = pack2(y[0][0] * rq, y[0][1] * rq);
    *(unsigned*)(dst + 128) = pack2(y[1][0] * rk, y[1][1] * rk);
    *(unsigned*)(dst + 256) = pack2(y[2][0], y[2][1]);
    {
      const unsigned gg = *(const unsigned*)(z + (size_t)t * ZSE + E_GG + h * 128 + 2 * lane);
      *(unsigned*)(cat + (size_t)t * 1024 + h * 128 + 2 * lane) = pack2(silu(lo2f(gg)), silu(hi2f(gg)));
    }
  }
  if (tid < 128) {
    const int t = tt * 64 + (tid >> 1), dir = tid & 1;
    const float zb = bf2f(z[(size_t)t * ZSE + E_BETA + dir * 8 + h]);
    const float za = bf2f(z[(size_t)t * ZSE + E_A + dir * 8 + h]);
    const float beta = 1.f / (1.f + __expf(-zb));
    const float xx = za + p.gdn_dt_bias[dir * 8 + h];
    const float sp = (xx > 20.f) ? xx : log1pf(__expf(xx));
    const float gl = -__expf(p.gdn_A_log[dir * 8 + h]) * sp;
    float* d = gba + (((size_t)t * 8 + h) * 2 + dir) * 2;
    d[0] = beta;
    d[1] = gl;
  }
}

constexpr int REC_ELEMS = 36864;
constexpr size_t OFF_GL = OFF_Z + (size_t)4096 * REC_ELEMS * 2;
static_assert(OFF_GL + 4096 * 4 <= OFF_CAT, "chunk records overflow z region");

__device__ __forceinline__ void gdn_chunk_item(int L, int r, const u16* qkvn, const float* gba, u16* rec_base, float* GL, char* smem) {
  const int NC = L / 64;
  const int n = r % NC, ci = r / NC;
  const int dir = ci & 1, h = (ci >> 1) & 7, bl = ci >> 4;
  u16* rec = rec_base + (size_t)r * REC_ELEMS;
  u16* sKb = (u16*)smem;
  u16* sQb = sKb + 64 * 136;
  float* sA = (float*)(smem + 2 * 17408);
  float* sG = (float*)(smem + 3 * 17408);
  float* sBeta = sG + 64;
  float* sg = sBeta + 64;
  const int tid = tidx(), lane = tid & 63, w = tid >> 6, fr = lane & 15, fq = lane >> 4;
  auto tok = [&](int c) -> int { const int pos = n * 64 + c; return bl * L + (dir ? (L - 1 - pos) : pos); };
  if (tid < 64) {
    const size_t o = (((size_t)tok(tid) * 8 + h) * 2 + dir) * 2;
    sBeta[tid] = gba[o];
    sg[tid] = gba[o + 1];
  }
  __syncthreads();
  if (tid < 64) {
    float sacc = 0.f;
    for (int l = 0; l <= tid; ++l) sacc += sg[l];
    sG[tid] = sacc;
  }
  __syncthreads();
#pragma unroll
  for (int it = 0; it < 8; ++it) {
    const int idx = it * 256 + tid, c = idx >> 5, c4 = idx & 31;
    const u16* src = qkvn + ((size_t)tok(c) * 8 + h) * 384 + c4 * 4;
    const uint2 q = *(const uint2*)src;
    const uint2 k = *(const uint2*)(src + 128);
    *(uint2*)(sQb + c * 136 + c4 * 4) = q;
    *(uint2*)(sKb + c * 136 + c4 * 4) = k;
    const float eg = __expf(sG[c]);
    *(uint2*)(rec + 16384 + c * 128 + c4 * 4) = make_uint2(pack2(lo2f(q.x) * eg, hi2f(q.x) * eg), pack2(lo2f(q.y) * eg, hi2f(q.y) * eg));
  }
  __syncthreads();
  {
    const int i = 16 * w + fr;
    bf16x8 kif[4], qif[4];
#pragma unroll
    for (int kk = 0; kk < 4; ++kk) {
      kif[kk] = *(const bf16x8*)(sKb + i * 136 + kk * 32 + fq * 8);
      qif[kk] = *(const bf16x8*)(sQb + i * 136 + kk * 32 + fq * 8);
    }
    const float Gi = sG[i], bi = sBeta[i];
#pragma unroll
    for (int jt = 0; jt < 4; ++jt) {
      f32x4 akk = (f32x4){0.f, 0.f, 0.f, 0.f}, aqk = (f32x4){0.f, 0.f, 0.f, 0.f};
      if (jt <= w) {
#pragma unroll
        for (int kk = 0; kk < 4; ++kk) {
          const bf16x8 kj = *(const bf16x8*)(sKb + (16 * jt + fr) * 136 + kk * 32 + fq * 8);
          akk = __builtin_amdgcn_mfma_f32_16x16x32_bf16(kj, kif[kk], akk, 0, 0, 0);
          aqk = __builtin_amdgcn_mfma_f32_16x16x32_bf16(kj, qif[kk], aqk, 0, 0, 0);
        }
      }
      float av[4], qv[4];
#pragma unroll
      for (int jj = 0; jj < 4; ++jj) {
        const int j = 16 * jt + 4 * fq + jj;
        const float dec = (j <= i) ? __expf(Gi - sG[j]) : 0.f;
        av[jj] = (j < i) ? bi * akk[jj] * dec : 0.f;
        qv[jj] = aqk[jj] * dec;
      }
      *(float4*)(sA + i * 68 + 16 * jt + 4 * fq) = make_float4(av[0], av[1], av[2], av[3]);
      *(uint2*)(rec + 32768 + i * 64 + 16 * jt + 4 * fq) = make_uint2(pack2(qv[0], qv[1]), pack2(qv[2], qv[3]));
    }
  }
  __syncthreads();
  {
    const int c = tid;
    const bool isU = c < 128;
    const int col = isU ? (256 + c) : c;
    float x[64];
#pragma unroll
    for (int i = 0; i < 64; ++i) x[i] = bf2f(qkvn[((size_t)tok(i) * 8 + h) * 384 + col]);
#pragma unroll
    for (int i = 0; i < 64; ++i) {
      float acc = x[i] * sBeta[i] * (isU ? 1.f : __expf(sG[i]));
      float ac1 = 0.f, ac2 = 0.f, ac3 = 0.f;
#pragma unroll
      for (int j4 = 0; j4 < (i + 3) / 4; ++j4) {
        const float4 a = *(const float4*)(sA + i * 68 + 4 * j4);
        acc -= a.x * x[4 * j4];
        if (4 * j4 + 1 < i) ac1 -= a.y * x[4 * j4 + 1];
        if (4 * j4 + 2 < i) ac2 -= a.z * x[4 * j4 + 2];
        if (4 * j4 + 3 < i) ac3 -= a.w * x[4 * j4 + 3];
      }
      x[i] = (acc + ac1) + (ac2 + ac3);
    }
    if (isU) {
      u16* dst = rec + (size_t)c * 64;
#pragma unroll
      for (int q8 = 0; q8 < 8; ++q8)
        *(uint4*)(dst + q8 * 8) = make_uint4(pack2(x[q8 * 8], x[q8 * 8 + 1]), pack2(x[q8 * 8 + 2], x[q8 * 8 + 3]),
                                             pack2(x[q8 * 8 + 4], x[q8 * 8 + 5]), pack2(x[q8 * 8 + 6], x[q8 * 8 + 7]));
    } else {
#pragma unroll
      for (int i = 0; i < 64; ++i) sQb[i * 136 + (c - 128)] = f2bf(x[i]);
    }
  }
  __syncthreads();
#pragma unroll
  for (int it = 0; it < 4; ++it) {
    const int idx = it * 256 + tid, row = idx >> 4, ch = idx & 15;
    *(uint4*)(rec + 8192 + row * 128 + ch * 8) = *(const uint4*)(sQb + row * 136 + ch * 8);
  }
  if (tid < 128) {
    const float Gl = sG[63];
    u16* dst = rec + 24576 + (size_t)tid * 64;
#pragma unroll
    for (int q8 = 0; q8 < 8; ++q8) {
      float v[8];
#pragma unroll
      for (int e2 = 0; e2 < 8; ++e2) {
        const int i = q8 * 8 + e2;
        v[e2] = bf2f(sKb[i * 136 + tid]) * __expf(Gl - sG[i]);
      }
      *(uint4*)(dst + q8 * 8) = make_uint4(pack2(v[0], v[1]), pack2(v[2], v[3]), pack2(v[4], v[5]), pack2(v[6], v[7]));
    }
  }
  if (tid == 0) GL[r] = __expf(sG[63]);
  __syncthreads();
}

__device__ __forceinline__ void gdn_cscan_item(int L, int ci, int half, const u16* rec_base, const float* GL, float* odir, char* smem) {
  const int NC = L / 64;
  const int dir = ci & 1, h = (ci >> 1) & 7, bl = ci >> 4;
  u16* sST = (u16*)smem;
  u16* sVT = sST + 64 * 136;
  const int tid = tidx(), lane = tid & 63, w = tid >> 6, fr = lane & 15, fq = lane >> 4;
  f32x4 S[2][4];
#pragma unroll
  for (int u = 0; u < 2; ++u)
#pragma unroll
    for (int t = 0; t < 4; ++t) S[u][t] = (f32x4){0.f, 0.f, 0.f, 0.f};
  for (int idx = tid; idx < 64 * 136 / 2; idx += 256) ((unsigned*)sST)[idx] = 0u;
  __syncthreads();
  bf16x8 nwf[4], nqgf[4], nqkf[2], nkdf[2][2];
  uint2 nut[4];
  float ngl;
#define SCAN_LOAD(nn)                                                                                             \
  {                                                                                                               \
    const u16* rec = rec_base + (size_t)(ci * NC + (nn)) * REC_ELEMS;                                             \
    ngl = GL[ci * NC + (nn)];                                                                                     \
    _Pragma("unroll") for (int kk = 0; kk < 4; ++kk) {                                                            \
      nwf[kk] = *(const bf16x8*)(rec + 8192 + (16 * w + fr) * 128 + kk * 32 + fq * 8);                            \
      nqgf[kk] = *(const bf16x8*)(rec + 16384 + (16 * w + fr) * 128 + kk * 32 + fq * 8);                          \
    }                                                                                                             \
    _Pragma("unroll") for (int kk = 0; kk < 2; ++kk) {                                                            \
      nqkf[kk] = *(const bf16x8*)(rec + 32768 + (16 * w + fr) * 64 + kk * 32 + fq * 8);                           \
      _Pragma("unroll") for (int u = 0; u < 2; ++u)                                                               \
        nkdf[u][kk] = *(const bf16x8*)(rec + 24576 + (32 * w + 16 * u + fr) * 64 + kk * 32 + fq * 8);             \
    }                                                                                                             \
    _Pragma("unroll") for (int t = 0; t < 4; ++t) nut[t] = *(const uint2*)(rec + (half * 64 + 16 * t + fr) * 64 + 16 * w + 4 * fq); \
  }
  SCAN_LOAD(0)
#pragma unroll 1
  for (int n = 0; n < NC; ++n) {
    const float gl = ngl;
    bf16x8 wf[4], qgf[4], qkf[2], kdf[2][2];
    uint2 ut[4];
#pragma unroll
    for (int kk = 0; kk < 4; ++kk) { wf[kk] = nwf[kk]; qgf[kk] = nqgf[kk]; }
#pragma unroll
    for (int kk = 0; kk < 2; ++kk) { qkf[kk] = nqkf[kk]; kdf[0][kk] = nkdf[0][kk]; kdf[1][kk] = nkdf[1][kk]; }
#pragma unroll
    for (int t = 0; t < 4; ++t) ut[t] = nut[t];
    if (n + 1 < NC) SCAN_LOAD(n + 1)
#pragma unroll
    for (int t = 0; t < 4; ++t) {
      f32x4 acc = (f32x4){0.f, 0.f, 0.f, 0.f};
#pragma unroll
      for (int kk = 0; kk < 4; ++kk) {
        const bf16x8 b = *(const bf16x8*)(sST + (16 * t + fr) * 136 + kk * 32 + fq * 8);
        acc = __builtin_amdgcn_mfma_f32_16x16x32_bf16(wf[kk], b, acc, 0, 0, 0);
      }
      const float v0 = lo2f(ut[t].x) - acc[0], v1 = hi2f(ut[t].x) - acc[1], v2 = lo2f(ut[t].y) - acc[2], v3 = hi2f(ut[t].y) - acc[3];
      *(uint2*)(sVT + (16 * t + fr) * 72 + 16 * w + 4 * fq) = make_uint2(pack2(v0, v1), pack2(v2, v3));
    }
    __syncthreads();
#pragma unroll
    for (int t = 0; t < 4; ++t) {
      f32x4 acc = (f32x4){0.f, 0.f, 0.f, 0.f};
#pragma unroll
      for (int kk = 0; kk < 4; ++kk) {
        const bf16x8 b = *(const bf16x8*)(sST + (16 * t + fr) * 136 + kk * 32 + fq * 8);
        acc = __builtin_amdgcn_mfma_f32_16x16x32_bf16(qgf[kk], b, acc, 0, 0, 0);
      }
#pragma unroll
      for (int kk = 0; kk < 2; ++kk) {
        const bf16x8 b = *(const bf16x8*)(sVT + (16 * t + fr) * 72 + kk * 32 + fq * 8);
        acc = __builtin_amdgcn_mfma_f32_16x16x32_bf16(qkf[kk], b, acc, 0, 0, 0);
      }
#pragma unroll
      for (int j = 0; j < 4; ++j) {
        const int pos = n * 64 + 16 * w + 4 * fq + j;
        const int tk = bl * L + (dir ? (L - 1 - pos) : pos);
        odir[(size_t)tk * 1024 + h * 128 + half * 64 + 16 * t + fr] = acc[j];
      }
    }
#pragma unroll
    for (int u = 0; u < 2; ++u)
#pragma unroll
      for (int t = 0; t < 4; ++t) {
        f32x4 acc = S[u][t] * gl;
#pragma unroll
        for (int kk = 0; kk < 2; ++kk) {
          const bf16x8 b = *(const bf16x8*)(sVT + (16 * t + fr) * 72 + kk * 32 + fq * 8);
          acc = __builtin_amdgcn_mfma_f32_16x16x32_bf16(kdf[u][kk], b, acc, 0, 0, 0);
        }
        S[u][t] = acc;
      }
    __syncthreads();
#pragma unroll
    for (int u = 0; u < 2; ++u)
#pragma unroll
      for (int t = 0; t < 4; ++t)
        *(uint2*)(sST + (16 * t + fr) * 136 + 32 * w + 16 * u + 4 * fq) = make_uint2(pack2(S[u][t][0], S[u][t][1]), pack2(S[u][t][2], S[u][t][3]));
    __syncthreads();
  }
}

#undef SCAN_LOAD
__device__ __forceinline__ void gdn_post_item(const P& p, int tt, const float* of, const float* ob, const u16* gateB, u16* cat) {
  const int tid = tidx(), lane = tid & 63, w = tid >> 6;
  const int p4 = lane >> 4, d8 = (lane & 15) * 8;
  const float4 g0 = *(const float4*)(p.gdn_norm_g + d8), g1 = *(const float4*)(p.gdn_norm_g + d8 + 4);
#pragma unroll
  for (int it = 0; it < 4; ++it) {
    const int pr = w * 16 + it * 4 + p4;
    const int t = tt * 8 + (pr >> 3), h = pr & 7;
    const size_t o = (size_t)t * 1024 + h * 128 + d8;
    const float4 a0 = *(const float4*)(of + o), a1 = *(const float4*)(of + o + 4);
    const float4 b0 = *(const float4*)(ob + o), b1 = *(const float4*)(ob + o + 4);
    u16* cp = cat + (size_t)t * CATW + 1024 + h * 128 + d8;
    const uint4 gg = *(const uint4*)(gateB + (size_t)t * 1024 + h * 128 + d8);
    float x[8] = {a0.x + b0.x, a0.y + b0.y, a0.z + b0.z, a0.w + b0.w, a1.x + b1.x, a1.y + b1.y, a1.z + b1.z, a1.w + b1.w};
    float ss = 0.f;
#pragma unroll
    for (int e2 = 0; e2 < 8; ++e2) ss += x[e2] * x[e2];
    ss = row_sum16(ss);
    const float rinv = rsqrtf(ss * (1.f / 128.f) + EPSF);
    const float gn[8] = {g0.x, g0.y, g0.z, g0.w, g1.x, g1.y, g1.z, g1.w};
    const unsigned gw[4] = {gg.x, gg.y, gg.z, gg.w};
    unsigned ow[4];
#pragma unroll
    for (int q = 0; q < 4; ++q)
      ow[q] = pack2(x[2 * q] * rinv * gn[2 * q] * lo2f(gw[q]), x[2 * q + 1] * rinv * gn[2 * q + 1] * hi2f(gw[q]));
    *(uint4*)cp = make_uint4(ow[0], ow[1], ow[2], ow[3]);
  }
}

template <bool COPY>
__device__ __forceinline__ void resid_item(int item, const float* xin, const float* outb, const float* rsp, const float* g, float* dst, u16* xb, float* rinvb) {
  const int tid = tidx(), lane = tid & 63, w = tid >> 6;
  const int row = item * 4 + w;
  float s = 0.f;
#pragma unroll
  for (int i = 0; i < 16; ++i) s += rsp[(size_t)row * 16 + i];
  const float rinv = rsqrtf(s * (1.f / 1024.f) + EPSF);
  float sq = 0.f;
#pragma unroll
  for (int i = 0; i < 4; ++i) {
    const int col = i * 256 + lane * 4;
    float4 x = *(const float4*)(xin + (size_t)row * 1024 + col);
    float4 o = *(const float4*)(outb + (size_t)row * 1024 + col);
    float4 gg = *(const float4*)(g + col);
    float4 y = make_float4(x.x + o.x * rinv * gg.x, x.y + o.y * rinv * gg.y, x.z + o.z * rinv * gg.z, x.w + o.w * rinv * gg.w);
    *(float4*)(dst + (size_t)row * 1024 + col) = y;
    if (COPY) {
      sq += y.x * y.x + y.y * y.y + y.z * y.z + y.w * y.w;
      *(uint2*)(xb + (size_t)row * 1024 + col) = make_uint2(pack2(y.x, y.y), pack2(y.z, y.w));
    }
  }
  if (COPY) {
    sq = wave_sum(sq);
    if (lane == 0) rinvb[row] = rsqrtf(sq * (1.f / 1024.f) + EPSF);
  }
}

struct AttnIO {
  const u16* q; long qstep;
  const u16* k; const u16* v; long kstep;
  u16* o; long ostep;
  const u16* g; long gstep;
  float* lse; long lstep;
};

template <int DH, int NTW, int NCHUNK, int CHCOLS, int VSTR, bool MASK, int NH = 1>
__device__ __forceinline__ void attn_block(const AttnIO& io, int Lr, int q0, int HW, float scale, const float* sinkp, long hstep, char* smem) {
  u16* sV = (u16*)smem;
  const int tid = tidx(), lane = tid & 63, w = tid >> 6, fr = lane & 15, fq = lane >> 4;
  constexpr int NKK = DH / 32;
  constexpr int NDD = DH / 16;
  constexpr int SPC = NTW / 2 / NCHUNK;
  const int qw0 = q0 + 16 * w;
  const int kw0 = MASK ? (qw0 - HW) : 0;
  const int qp = qw0 + fr;
  const bool has_sink = (sinkp != nullptr);
  auto stage = [&](int c) {
    __syncthreads();
    const int k0c = MASK ? (q0 - HW) : c * CHCOLS;
    {
      constexpr int NIDX = CHCOLS * (DH / 8);
      constexpr int NIT = (NIDX + 255) / 256;
      uint4 vv[NIT];
#pragma unroll
      for (int q = 0; q < NIT; ++q) {
        const int idx = q * 256 + tid;
        const int col = idx % CHCOLS, dch = idx / CHCOLS;
        const int kp = k0c + col;
        vv[q] = make_uint4(0, 0, 0, 0);
        if (idx < NIDX && kp >= 0 && kp < Lr) vv[q] = *(const uint4*)(io.v + (long)kp * io.kstep + dch * 8);
      }
#pragma unroll
      for (int q = 0; q < NIT; ++q) {
        const int idx = q * 256 + tid;
        if (idx < NIDX) {
          const int col = idx % CHCOLS, dch = idx / CHCOLS;
          u16* d = sV + (dch * 8) * VSTR + col;
          d[0] = (u16)(vv[q].x & 0xffff); d[VSTR] = (u16)(vv[q].x >> 16);
          d[2 * VSTR] = (u16)(vv[q].y & 0xffff); d[3 * VSTR] = (u16)(vv[q].y >> 16);
          d[4 * VSTR] = (u16)(vv[q].z & 0xffff); d[5 * VSTR] = (u16)(vv[q].z >> 16);
          d[6 * VSTR] = (u16)(vv[q].w & 0xffff); d[7 * VSTR] = (u16)(vv[q].w >> 16);
        }
      }
    }
    __syncthreads();
  };
  if (NCHUNK == 1) stage(0);
#pragma unroll 1
  for (int hd = 0; hd < NH; ++hd) {
  const float sink = has_sink ? sinkp[hd] : 0.f;
  bf16x8 qf[NKK];
  {
    const u16* qptr = io.q + hd * hstep + (long)qp * io.qstep + fq * 8;
#pragma unroll
    for (int kk = 0; kk < NKK; ++kk) qf[kk] = *(const bf16x8*)(qptr + kk * 32);
  }
  f32x4 oacc[NDD];
#pragma unroll
  for (int dd = 0; dd < NDD; ++dd) oacc[dd] = (f32x4){0.f, 0.f, 0.f, 0.f};
  float m = has_sink ? sink : -1e30f;
  float den = 0.f;
#pragma unroll
  for (int c = 0; c < NCHUNK; ++c) {
    if (NCHUNK > 1) stage(c);
    auto kload = [&](bf16x8 (&dst)[2][NKK], int ktbase) {
#pragma unroll
      for (int tt = 0; tt < 2; ++tt) {
        const int kp = kw0 + 16 * (ktbase + tt) + fr;
        const bool valid = (kp >= 0) && (kp < Lr);
        const u16* kptr = io.k + (long)(valid ? kp : 0) * io.kstep + fq * 8;
#pragma unroll
        for (int kk = 0; kk < NKK; ++kk) {
          bf16x8 kf = {0, 0, 0, 0, 0, 0, 0, 0};
          if (valid) kf = *(const bf16x8*)(kptr + kk * 32);
          dst[tt][kk] = kf;
        }
      }
    };
    auto qk = [&](bf16x8 (&kf)[2][NKK], f32x4 (&st)[2]) {
#pragma unroll
      for (int tt = 0; tt < 2; ++tt) {
        st[tt] = (f32x4){0.f, 0.f, 0.f, 0.f};
#pragma unroll
        for (int kk = 0; kk < NKK; ++kk)
          st[tt] = __builtin_amdgcn_mfma_f32_16x16x32_bf16(kf[tt][kk], qf[kk], st[tt], 0, 0, 0);
      }
    };
    auto tail = [&](f32x4 (&st)[2], int kt0) {
      bool ok[2][4];
      float mloc = -1e30f;
#pragma unroll
      for (int tt = 0; tt < 2; ++tt)
#pragma unroll
        for (int j = 0; j < 4; ++j) {
          bool okv = true;
          if (MASK) {
            const int kp = kw0 + 16 * (kt0 + tt) + 4 * fq + j;
            const int dlt = qp - kp;
            okv = (kp >= 0) && (kp < Lr) && (dlt <= HW) && (dlt >= -HW);
          }
          ok[tt][j] = okv;
          const float sv = st[tt][j] * scale;
          st[tt][j] = sv;
          if (okv) mloc = fmaxf(mloc, sv);
        }
      mloc = xmax16(mloc);
      mloc = xmax32(mloc);
      const float mnew = fmaxf(m, mloc);
      const float alpha = __expf(m - mnew);
      m = mnew;
      float psum = 0.f;
#pragma unroll
      for (int tt = 0; tt < 2; ++tt)
#pragma unroll
        for (int j = 0; j < 4; ++j) {
          const float pv = ok[tt][j] ? __expf(st[tt][j] - mnew) : 0.f;
          st[tt][j] = pv;
          psum += pv;
        }
      den = den * alpha + psum;
      union { unsigned u[4]; bf16x8 v; } pf;
      pf.u[0] = pack2(st[0][0], st[0][1]);
      pf.u[1] = pack2(st[0][2], st[0][3]);
      pf.u[2] = pack2(st[1][0], st[1][1]);
      pf.u[3] = pack2(st[1][2], st[1][3]);
      const int cb0 = MASK ? (16 * w + 16 * kt0) : (16 * kt0 - c * CHCOLS);
      const int cb1 = cb0 + 16;
#pragma unroll
      for (int dd = 0; dd < NDD; ++dd) {
        const u16* vr = sV + (dd * 16 + fr) * VSTR + 4 * fq;
        union { uint2 h[2]; bf16x8 v; } vf;
        vf.h[0] = *(const uint2*)(vr + cb0);
        vf.h[1] = *(const uint2*)(vr + cb1);
        oacc[dd] = oacc[dd] * alpha;
        oacc[dd] = __builtin_amdgcn_mfma_f32_16x16x32_bf16(vf.v, pf.v, oacc[dd], 0, 0, 0);
      }
    };
    bf16x8 kfa[2][NKK], kfb[2][NKK];
    kload(kfa, 2 * (c * SPC));
    if (SPC > 1) kload(kfb, 2 * (c * SPC) + 2);
#pragma unroll 1
    for (int s2l = 0; s2l < SPC; s2l += 2) {
      {
        const int kt0 = 2 * (c * SPC + s2l);
        f32x4 st[2];
        qk(kfa, st);
        if (s2l + 2 < SPC) kload(kfa, kt0 + 4);
        tail(st, kt0);
      }
      if (s2l + 1 >= SPC) break;
      {
        const int kt0 = 2 * (c * SPC + s2l + 1);
        f32x4 st[2];
        qk(kfb, st);
        if (s2l + 3 < SPC) kload(kfb, kt0 + 4);
        tail(st, kt0);
      }
    }
  }
  den = xsum16(den);
  den = xsum32(den);
  if (has_sink) den += __expf(sink - m);
  const float rden = 1.f / den;
  u16* op = io.o + hd * hstep + (long)qp * io.ostep;
  const u16* gp = io.g ? (io.g + hd * hstep + (long)qp * io.gstep) : nullptr;
#pragma unroll
  for (int dd = 0; dd < NDD; ++dd) {
    const int d0 = dd * 16 + 4 * fq;
    float y0 = oacc[dd][0] * rden, y1 = oacc[dd][1] * rden, y2 = oacc[dd][2] * rden, y3 = oacc[dd][3] * rden;
    if (gp) {
      uint2 gg = *(const uint2*)(gp + d0);
      y0 *= silu(lo2f(gg.x)); y1 *= silu(hi2f(gg.x)); y2 *= silu(lo2f(gg.y)); y3 *= silu(hi2f(gg.y));
    }
    *(uint2*)(op + d0) = make_uint2(pack2(y0, y1), pack2(y2, y3));
  }
  if (io.lse && fq == 0) io.lse[(long)qp * io.lstep] = m + __logf(den);
  }
  __syncthreads();
}

__device__ __forceinline__ void xattn_item(int L, int nb, int item, int grp, const u16* z, int zs, int xq_col, int gx_col, const u16* mkv, u16* cat, int cat_col, char* smem) {
  const int nqb = L / 64;
  const int qb = item % nqb;
  const int rest = item / nqb;
  const int h = rest & 3, bl = rest >> 2;
  const int sq = (grp == 0) ? bl : (8 + (grp - 1) * 4 + bl);
  AttnIO io;
  io.q = z + (size_t)(bl * L) * zs + xq_col + h * 128; io.qstep = zs;
  io.k = mkv + (size_t)(sq * 256) * 1024 + h * 128;
  io.v = mkv + (size_t)(sq * 256) * 1024 + 512 + h * 128; io.kstep = 1024;
  io.o = cat + (size_t)(bl * L) * CATW + cat_col + h * 128; io.ostep = CATW;
  io.g = z + (size_t)(bl * L) * zs + gx_col + h * 128; io.gstep = zs;
  io.lse = nullptr; io.lstep = 0;
  attn_block<128, 16, 2, 128, 144, false>(io, 256, qb * 64, 0, 0.08838834764831845f, nullptr, 0, smem);
}

__global__ void __launch_bounds__(256, 2) mega(P p) {
  cg::grid_group grid = cg::this_grid();
  __shared__ __attribute__((aligned(16))) char smem[65536];
  const int nblk = gridDim.x, bid = blockIdx.x;
  char* ws = p.ws;
  XcdBarrier xb;
  xb.bar = (unsigned*)(ws + OFF_BAR); xb.x = xb_xcc_id(); xb.nloc = 0u; xb.nx = 0u;
  if (__builtin_amdgcn_workitem_id_x() == 0) (void)xb_add(&xb.bar[XB_XCNT(xb.x)], 1u);
  u16* wt_e_in = (u16*)(ws + OFF_WT_E_IN);
  u16* wt_o_in = (u16*)(ws + OFF_WT_O_IN);
  u16* wt_e_out = (u16*)(ws + OFF_WT_E_OUT);
  u16* wt_o_out = (u16*)(ws + OFF_WT_O_OUT);
  u16* wt_e_mkv = (u16*)(ws + OFF_WT_E_MKV);
  u16* wt_o_mkv = (u16*)(ws + OFF_WT_O_MKV);
  u16* mkv_e = (u16*)(ws + OFF_MKV_E);
  u16* mkv_o = (u16*)(ws + OFF_MKV_O);
  u16* hr_a = (u16*)(ws + OFF_HR_A);
  u16* hr_b = (u16*)(ws + OFF_HR_B);
  u16* z = (u16*)(ws + OFF_Z);
  u16* cat = (u16*)(ws + OFF_CAT);
  float* outb = (float*)(ws + OFF_OUT);
  float* rsp = (float*)(ws + OFF_RSP);
  u16* gateA = (u16*)(ws + OFF_OUT);
  u16* gateB = gateA + (size_t)GT * 1024;
  u16* ut = (u16*)(ws + OFF_UT);
  u16* yt = (u16*)(ws + OFF_YT);
  u16* qkvn = (u16*)(ws + OFF_QKVN);
  float* gba = (float*)(ws + OFF_GBA);
  float* of = (float*)(ws + OFF_OF);
  float* ob = (float*)(ws + OFF_OB);
  u16* og = (u16*)(ws + OFF_OG);
  float* lse = (float*)(ws + OFF_LSE);
  u16* xbf = (u16*)(ws + OFF_XB);
  float* rinvb = (float*)(ws + OFF_RINVB);
  u16* memb = (u16*)(ws + OFF_MEMB);
  float* rinvm = (float*)(ws + OFF_RINVM);

  {
    const int n_e_in = 16 * (ZSE / 64), n_o_in = 16 * (ZSO / 64), n_e_out = 40 * 16, n_o_out = 32 * 16, n_mkv = 16 * 16;
    const int n_f = 256 + 512;
    const int n_rp = GT / 4 + 6144 / 4;
    const int total = n_rp + n_e_in + n_o_in + n_e_out + n_o_out + 2 * n_mkv + n_f;
    REP(5) for (int it = bid; it < total; it += nblk) {
      int i = it;
      if (i < GT / 4) { rowprep_item(i, p.xp, xbf, rinvb); continue; }
      i -= GT / 4;
      if (i < 6144 / 4) { if (i < 512) rowprep_item(i, p.memp, memb, rinvm); else rowprep_item(i - 512, p.mems, memb + (size_t)2048 * 1024, rinvm + 2048); continue; }
      i -= 6144 / 4;
      if (i < n_e_in) { wt_tile(p.e_w_in, 9248, p.e_pre_g, wt_e_in, 1024, i & 15, i >> 4, 1, smem); continue; }
      i -= n_e_in;
      if (i < n_o_in) { wt_tile(p.o_w_in, 8448, p.o_pre_g, wt_o_in, 1024, i & 15, i >> 4, 0, smem); continue; }
      i -= n_o_in;
      if (i < n_e_out) { wt_tile(p.e_w_out, 1024, nullptr, wt_e_out, 2560, i % 40, i / 40, 0, smem); continue; }
      i -= n_e_out;
      if (i < n_o_out) { wt_tile(p.o_w_out, 1024, nullptr, wt_o_out, 2048, i % 32, i / 32, 0, smem); continue; }
      i -= n_o_out;
      if (i < n_mkv) { wt_tile(p.e_w_mkv, 1024, p.e_mem_g, wt_e_mkv, 1024, i & 15, i >> 4, 0, smem); continue; }
      i -= n_mkv;
      if (i < n_mkv) { wt_tile(p.o_w_mkv, 1024, p.o_mem_g, wt_o_mkv, 1024, i & 15, i >> 4, 0, smem); continue; }
      i -= n_mkv;
      if (i < 256) { filt_item(p, 2048, i >> 3, i & 7, hr_a, smem); continue; }
      i -= 256;
      filt_item(p, 4096, i >> 3, i & 7, hr_b, smem);
    }
  }
  grid.sync();
  for (int layer = 0; layer < 2; ++layer) {
    Epi e; e.out = layer ? mkv_o : mkv_e; e.ldo = 1024; e.rsp = nullptr; e.L = 1; e.rinv = rinvm;
    gemm_phase<0>(bid, nblk, 24 * 8, 24, memb, 1024, layer ? wt_o_mkv : wt_e_mkv, 1024, e, smem);
  }
  xcd_barrier(xb);

  for (int grp = 0; grp < NGROUP; ++grp) {
    const int L = (grp == 0) ? 2048 : 4096;
    const int nb = GT / L;
    const float* xg = (grp == 0) ? p.xp : (p.xs + (size_t)(grp - 1) * GT * 1024);
    float* dg = p.out + (size_t)grp * GT * 1024;
    const u16* hr = (grp == 0) ? hr_a : hr_b;

    REP(0) {
      Epi e; e.out = z; e.ldo = ZSE; e.rsp = nullptr; e.L = L; e.rinv = rinvb;
      gemm_phase<0>(bid, nblk, 64 * 73, 64, xbf, 1024, wt_e_in, 1024, e, smem);
    }
    xcd_barrier(xb);
    {
      const int n_hy = 256 * 8, n_gd = 256 * 8, n_x = 1024;
      REP(1) for (int it = bid; it < n_hy + n_gd + n_x; it += nblk) {
        int i = it;
        if (i < n_x) { xattn_item(L, nb, i, grp, z, ZSE, E_XQ, E_GX, mkv_e, cat, 2048, smem); continue; }
        i -= n_x;
        if (i < n_gd) { gdn_pre_item(p, L, i >> 3, i & 7, z, qkvn, gba, gateB); continue; }
        i -= n_gd;
        hy_pre_item(p, L, i >> 3, i & 7, z, gateA, ut);
      }
    }
    xcd_barrier(xb);
    REP(4) for (int it = bid; it < 4096; it += nblk) gdn_chunk_item(L, it, qkvn, gba, z, (float*)(ws + OFF_GL), smem);
    xcd_barrier(xb);
    {
      const int n_scan = nb * 32;
      REP(2) {
      if (bid < n_scan) {
        const int ci = bid >> 1, half = bid & 1;
        gdn_cscan_item(L, ci, half, z, (const float*)(ws + OFF_GL), (ci & 1) ? ob : of, smem);
      }
      unsigned* hctr = (unsigned*)(ws + OFF_BAR) + 3600 + grp + 8 * rep_;
      volatile unsigned* slot = (volatile unsigned*)(smem + (2 * L - 1) * 4);
      for (;;) {
        __syncthreads();
        if (__builtin_amdgcn_workitem_id_x() == 0) *slot = atomicAdd(hctr, 1u);
        __syncthreads();
        const unsigned chn = *slot;
        if (chn >= 1024u) break;
        hy_conv_item(L, nb, (int)chn, hr, ut, yt, smem);
      }
      }
    }
    xcd_barrier(xb);
    {
      const int n_hy = 256 * 8, n_gd = GT / 8;
      REP(6) for (int it = bid; it < n_hy + n_gd; it += nblk) {
        if (it < n_hy) hy_post_item(it >> 3, it & 7, yt, gateA, cat);
        else gdn_post_item(p, it - n_hy, of, ob, gateB, cat);
      }
    }
    xcd_barrier(xb);
    REP(0) {
      Epi e; e.out = outb; e.ldo = 1024; e.rsp = rsp; e.L = L; e.rinv = nullptr;
      gemm_phase<2>(bid, nblk, 64 * 8, 64, cat, CATW, wt_e_out, 2560, e, smem);
    }
    xcd_barrier(xb);
    for (int it = bid; it < GT / 4; it += nblk) resid_item<true>(it, xg, outb, rsp, p.e_post_g, dg, xbf, rinvb);
    xcd_barrier(xb);
    REP(0) {
      Epi e; e.out = z; e.ldo = ZSO; e.rsp = nullptr; e.L = L; e.rinv = rinvb;
      gemm_phase<1>(bid, nblk, 64 * 66, 64, xbf, 1024, wt_o_in, 1024, e, smem);
    }
    xcd_barrier(xb);
    {
      const int n_dil = 3072, n_swa = 512, n_x = 1024;
      REP(3) for (int it = bid; it < n_dil + n_swa + n_x; it += nblk) {
        int i = it;
        if (i < n_swa) {
          const int kvh = i & 1, rem = i >> 1;
          const int nqb = L / 64, qb = rem % nqb, bl = rem / nqb;
          const int qh = kvh * 8;
          AttnIO io;
          io.q = z + (size_t)(bl * L) * ZSO + O_DQ + qh * 64; io.qstep = ZSO;
          io.k = z + (size_t)(bl * L) * ZSO + O_DK + kvh * 64;
          io.v = z + (size_t)(bl * L) * ZSO + O_DV + kvh * 64; io.kstep = ZSO;
          io.o = cat + (size_t)(bl * L) * CATW + 512 + qh * 64; io.ostep = CATW;
          io.g = z + (size_t)(bl * L) * ZSO + O_GD + qh * 64; io.gstep = ZSO;
          io.lse = nullptr; io.lstep = 0;
          attn_block<64, 18, 1, 336, 336, true, 8>(io, L, qb * 64, 128, 0.125f, p.swa_sink + qh, 64, smem);
          continue;
        }
        i -= n_swa;
        if (i < n_dil) {
          const int gi = i >> 10, rem = i & 1023;
          const int h = rem & 3, rem2 = rem >> 2;
          const int d = (gi == 0) ? 1 : (gi == 1 ? 4 : 16);
          const int Lr = L / d, nqb = Lr / 64;
          const int qb = rem2 % nqb, rem3 = rem2 / nqb;
          const int r = rem3 % d, bl = rem3 / d;
          const size_t row0 = (size_t)bl * L + r;
          AttnIO io;
          io.q = z + row0 * ZSO + O_CQ + gi * 512 + h * 128; io.qstep = (long)d * ZSO;
          io.k = z + row0 * ZSO + O_CK + gi * 512 + h * 128;
          io.v = z + row0 * ZSO + O_CV + gi * 512 + h * 128; io.kstep = (long)d * ZSO;
          io.o = og + row0 * 1536 + gi * 512 + h * 128; io.ostep = (long)d * 1536;
          io.g = nullptr; io.gstep = 0;
          io.lse = lse + row0 * 12 + gi * 4 + h; io.lstep = (long)d * 12;
          attn_block<128, 10, 1, 208, 208, true>(io, Lr, qb * 64, 64, 0.08838834764831845f, nullptr, 0, smem);
          continue;
        }
        i -= n_dil;
        xattn_item(L, nb, i, grp, z, ZSO, O_XQ, O_GX, mkv_o, cat, 1536, smem);
      }
    }
    xcd_barrier(xb);
    for (int it = bid; it < GT / 4; it += nblk) {
      const int tid = tidx(), lane = tid & 63, w = tid >> 6;
      const int t = it * 4 + w;
      const int h = lane >> 4, d0 = (lane & 15) * 8;
      const float l0 = lse[(size_t)t * 12 + h], l1 = lse[(size_t)t * 12 + 4 + h], l2 = lse[(size_t)t * 12 + 8 + h];
      const float mx = fmaxf(l0, fmaxf(l1, l2));
      float w0 = __expf(l0 - mx), w1 = __expf(l1 - mx), w2 = __expf(l2 - mx);
      const float rs = 1.f / (w0 + w1 + w2);
      w0 *= rs; w1 *= rs; w2 *= rs;
      uint4 a = *(const uint4*)(og + (size_t)t * 1536 + h * 128 + d0);
      uint4 b = *(const uint4*)(og + (size_t)t * 1536 + 512 + h * 128 + d0);
      uint4 c = *(const uint4*)(og + (size_t)t * 1536 + 1024 + h * 128 + d0);
      uint4 g = *(const uint4*)(z + (size_t)t * ZSO + O_GC + h * 128 + d0);
      unsigned au[4] = {a.x, a.y, a.z, a.w}, bu[4] = {b.x, b.y, b.z, b.w}, cu[4] = {c.x, c.y, c.z, c.w}, gu[4] = {g.x, g.y, g.z, g.w};
      unsigned ru[4];
#pragma unroll
      for (int i = 0; i < 4; ++i) {
        const float ylo = (w0 * lo2f(au[i]) + w1 * lo2f(bu[i]) + w2 * lo2f(cu[i])) * silu(lo2f(gu[i]));
        const float yhi = (w0 * hi2f(au[i]) + w1 * hi2f(bu[i]) + w2 * hi2f(cu[i])) * silu(hi2f(gu[i]));
        ru[i] = pack2(ylo, yhi);
      }
      *(uint4*)(cat + (size_t)t * CATW + h * 128 + d0) = make_uint4(ru[0], ru[1], ru[2], ru[3]);
    }
    xcd_barrier(xb);
    REP(0) {
      Epi e; e.out = outb; e.ldo = 1024; e.rsp = rsp; e.L = L; e.rinv = nullptr;
      gemm_phase<2>(bid, nblk, 64 * 8, 64, cat, CATW, wt_o_out, 2048, e, smem);
    }
    if (grp + 1 < NGROUP) {
      const float* xn = p.xs + (size_t)grp * GT * 1024;
      for (int it = nblk - 1 - bid; it < GT / 4; it += nblk) rowprep_item(it, xn, xbf, rinvb);
    }
    xcd_barrier(xb);
    for (int it = bid; it < GT / 4; it += nblk) resid_item<false>(it, dg, outb, rsp, p.o_post_g, dg, nullptr, nullptr);
  }
}

extern "C" void kernel_launch(void* const* d_in, const int* in_sizes, int n_in, void* d_out, int out_size, void* d_ws,
                              size_t ws_size, hipStream_t stream) {
  static int grid_blocks = 0;
  if (!grid_blocks) {
    int dev = 0, cus = 0, per_cu = 0;
    hipGetDevice(&dev);
    hipDeviceGetAttribute(&cus, hipDeviceAttributeMultiprocessorCount, dev);
    hipOccupancyMaxActiveBlocksPerMultiprocessor(&per_cu, mega, 256, 0);
    if (per_cu > 2) per_cu = 2;
    if (per_cu < 1) per_cu = 1;
    grid_blocks = cus * per_cu;
  }
  P p{};
  const float** f = (const float**)&p;
  for (int i = 0; i < 30; ++i) f[i] = (const float*)d_in[i];
  p.out = (float*)d_out;
  p.ws = (char*)d_ws;
  hipMemsetAsync((char*)d_ws + OFF_BAR, 0, 16384, stream);
  void* args[] = {&p};
  hipError_t e = hipLaunchCooperativeKernel((void*)mega, dim3(grid_blocks), dim3(256), args, 0, stream);
  if (e != hipSuccess) fprintf(stderr, "cooperative launch failed: %s (grid %d)\n", hipGetErrorString(e), grid_blocks);
}
```

```cpp
#include <hip/hip_runtime.h>
#include <hip/hip_cooperative_groups.h>
#include <cstdio>
namespace cg = cooperative_groups;

typedef unsigned short u16;
typedef __attribute__((ext_vector_type(8))) short bf16x8;
typedef __attribute__((ext_vector_type(4))) float f32x4;

#define DEVI __device__ __forceinline__
#define EPSF 1e-6f

#ifndef DUPMASK
#define DUPMASK 0
#endif
#define REP(k) for (int rep_ = 0; rep_ < 1 + ((DUPMASK >> (k)) & 1); ++rep_)
constexpr int GT = 16384;
constexpr int NGROUP = 5;
constexpr int ZSE = 9344;
constexpr int ZSO = 8448;
constexpr int CATW = 2560;
constexpr int E_HY = 0, E_GHY = 3072, E_QKV = 4096, E_GG = 7168, E_XQ = 8192, E_GX = 8704, E_BETA = 9216, E_A = 9232;
constexpr int O_CQ = 0, O_CK = 1536, O_CV = 3072, O_GC = 4608, O_DQ = 5120, O_DK = 6144, O_DV = 6272, O_GD = 6400, O_XQ = 7424, O_GX = 7936;

constexpr size_t OFF_WT_E_IN  = 0;
constexpr size_t OFF_WT_O_IN  = OFF_WT_E_IN  + (size_t)ZSE * 1024 * 2;
constexpr size_t OFF_WT_E_OUT = OFF_WT_O_IN  + (size_t)ZSO * 1024 * 2;
constexpr size_t OFF_WT_O_OUT = OFF_WT_E_OUT + (size_t)1024 * 2560 * 2;
constexpr size_t OFF_WT_E_MKV = OFF_WT_O_OUT + (size_t)1024 * 2048 * 2;
constexpr size_t OFF_WT_O_MKV = OFF_WT_E_MKV + (size_t)1024 * 1024 * 2;
constexpr size_t OFF_MKV_E    = OFF_WT_O_MKV + (size_t)1024 * 1024 * 2;
constexpr size_t OFF_MKV_O    = OFF_MKV_E    + (size_t)6144 * 1024 * 2;
constexpr size_t OFF_HR_A     = OFF_MKV_O    + (size_t)6144 * 1024 * 2;
constexpr size_t OFF_HR_B     = OFF_HR_A     + (size_t)1024 * 4096 * 2;
constexpr size_t OFF_Z        = OFF_HR_B     + (size_t)1024 * 8192 * 2;
constexpr size_t OFF_CAT      = OFF_Z        + (size_t)GT * ZSE * 2;
constexpr size_t OFF_OUT      = OFF_CAT      + (size_t)GT * CATW * 2;
constexpr size_t OFF_RSP      = OFF_OUT      + (size_t)GT * 1024 * 4;
constexpr size_t OFF_UT       = OFF_RSP      + (size_t)GT * 16 * 4;
constexpr size_t OFF_YT       = OFF_UT       + (size_t)1024 * GT * 2;
constexpr size_t OFF_QKVN     = OFF_YT       + (size_t)1024 * GT * 2;
constexpr size_t OFF_GBA      = OFF_QKVN     + (size_t)GT * 3072 * 4;
constexpr size_t OFF_OF       = OFF_GBA      + (size_t)GT * 32 * 4;
constexpr size_t OFF_OB       = OFF_OF       + (size_t)GT * 1024 * 4;
constexpr size_t OFF_END      = OFF_OB       + (size_t)GT * 1024 * 4;
constexpr size_t OFF_OG       = OFF_QKVN;
constexpr size_t OFF_LSE      = OFF_OG + (size_t)GT * 1536 * 2;
constexpr size_t OFF_BAR      = OFF_END;
constexpr size_t OFF_XB       = OFF_BAR + 16384;
constexpr size_t OFF_RINVB    = OFF_XB + (size_t)GT * 1024 * 2;
constexpr size_t OFF_MEMB     = OFF_RINVB + (size_t)GT * 4;
constexpr size_t OFF_RINVM    = OFF_MEMB + (size_t)6144 * 1024 * 2;
static_assert(OFF_RINVM + 6144 * 4 <= (size_t)1 << 30, "workspace too large");

struct P {
  const float *xp, *xs, *memp, *mems;
  const float *e_pre_g, *e_post_g, *e_w_in, *e_w_out, *hy_conv_w, *hy_conv_b, *hy_w1, *hy_b1, *hy_w2, *hy_b2, *hy_w3,
      *hy_freq, *hy_skip, *gdn_conv_w, *gdn_A_log, *gdn_dt_bias, *gdn_norm_g, *e_mem_g, *e_w_mkv;
  const float *o_pre_g, *o_post_g, *o_w_in, *o_w_out, *swa_sink, *o_mem_g, *o_w_mkv;
  float* out;
  char* ws;
};

DEVI int tidx() { int t = __builtin_amdgcn_workitem_id_x(); asm volatile("" : "+v"(t)); return t; }
DEVI u16 f2bf(float f) {
  unsigned u = __float_as_uint(f);
  u += 0x7fffu + ((u >> 16) & 1u);
  return (u16)(u >> 16);
}
DEVI float bf2f(u16 h) { return __uint_as_float(((unsigned)h) << 16); }
DEVI unsigned pack2(float a, float b) { return (unsigned)f2bf(a) | ((unsigned)f2bf(b) << 16); }
DEVI float lo2f(unsigned u) { return __uint_as_float(u << 16); }
DEVI float hi2f(unsigned u) { return __uint_as_float(u & 0xffff0000u); }
DEVI float silu(float x) { return x / (1.f + __expf(-x)); }
DEVI void fsincos(float x, float* sn, float* cs) {
  const float k = rintf(x * 0.15915494309189535f);
  float r = fmaf(-k, 6.28125f, x);
  r = fmaf(-k, 0.0019353071795864769f, r);
  *sn = __sinf(r);
  *cs = __cosf(r);
}
#define DPP_ADD(v, ctrl) ((v) + __int_as_float(__builtin_amdgcn_mov_dpp(__float_as_int(v), (ctrl), 0xf, 0xf, true)))
DEVI float wave_sum(float v) {
  v = DPP_ADD(v, 0xB1);
  v = DPP_ADD(v, 0x4E);
  v = DPP_ADD(v, 0x141);
  v = DPP_ADD(v, 0x140);
  const float r0 = __int_as_float(__builtin_amdgcn_readlane(__float_as_int(v), 0));
  const float r1 = __int_as_float(__builtin_amdgcn_readlane(__float_as_int(v), 16));
  const float r2 = __int_as_float(__builtin_amdgcn_readlane(__float_as_int(v), 32));
  const float r3 = __int_as_float(__builtin_amdgcn_readlane(__float_as_int(v), 48));
  return (r0 + r1) + (r2 + r3);
}


DEVI float xmax16(float v) { auto r = __builtin_amdgcn_permlane16_swap(__float_as_uint(v), __float_as_uint(v), false, false); return fmaxf(__uint_as_float(r[0]), __uint_as_float(r[1])); }
DEVI float xmax32(float v) { auto r = __builtin_amdgcn_permlane32_swap(__float_as_uint(v), __float_as_uint(v), false, false); return fmaxf(__uint_as_float(r[0]), __uint_as_float(r[1])); }
DEVI float xsum16(float v) { auto r = __builtin_amdgcn_permlane16_swap(__float_as_uint(v), __float_as_uint(v), false, false); return __uint_as_float(r[0]) + __uint_as_float(r[1]); }
DEVI float xsum32(float v) { auto r = __builtin_amdgcn_permlane32_swap(__float_as_uint(v), __float_as_uint(v), false, false); return __uint_as_float(r[0]) + __uint_as_float(r[1]); }
DEVI float row_sum16(float v) {
  v = DPP_ADD(v, 0xB1); v = DPP_ADD(v, 0x4E); v = DPP_ADD(v, 0x141); v = DPP_ADD(v, 0x140);
  return v;
}

#define XB_TMO      128
#define XB_XCNT(j)  (256  + 64 * (j))
#define XB_XSUB(j)  (1280 + 64 * (j))
#define XB_XGEN(j)  (2304 + 64 * (j))
#define XB_TOP      3328
#define XB_TOPGEN   3392
#define XCD_BAR_WORDS 3456
#define XB_SPIN_CAP (1u << 22)
DEVI unsigned xb_ld(unsigned* p) { return __hip_atomic_load(p, __ATOMIC_RELAXED, __HIP_MEMORY_SCOPE_AGENT); }
DEVI unsigned xb_add(unsigned* p, unsigned v) { return __hip_atomic_fetch_add(p, v, __ATOMIC_RELAXED, __HIP_MEMORY_SCOPE_AGENT); }
DEVI unsigned xb_xcc_id() { return (unsigned)__builtin_amdgcn_s_getreg((3 << 11) | 20) & 0xFu; }
#define XB_SPIN(cond, bar) do { unsigned _sp = 0; while (cond) { __builtin_amdgcn_s_sleep(1); \
    if ((++_sp & 255u) == 0u) { if (xb_ld(&(bar)[XB_TMO])) break; if (_sp > XB_SPIN_CAP) { atomicAdd(&(bar)[XB_TMO], 1u); break; } } } } while (0)
struct XcdBarrier { unsigned* bar; unsigned x; unsigned nloc; unsigned nx; };
DEVI void xcd_barrier_complete(unsigned* bar, unsigned x, unsigned& nloc, unsigned& nx) {
  const unsigned G = gridDim.x;
  unsigned sum, cnt, mine, sp = 0u;
  for (;;) {
    sum = 0u; cnt = 0u; mine = 0u;
#pragma unroll
    for (unsigned j = 0; j < 16; ++j) { const unsigned c = xb_ld(&bar[XB_XCNT(j)]); sum += c; cnt += (c > 0u) ? 1u : 0u; mine = (j == x) ? c : mine; }
    if (sum == G) break;
    __builtin_amdgcn_s_sleep(1);
    if ((++sp & 255u) == 0u) { if (xb_ld(&bar[XB_TMO])) break; if (sp > XB_SPIN_CAP) { atomicAdd(&bar[XB_TMO], 1u); break; } }
  }
  nloc = mine > 0u ? mine : 1u; nx = cnt > 0u ? cnt : 1u;
}
DEVI void xcd_barrier(XcdBarrier& b) {
  asm volatile("s_waitcnt vmcnt(0)" ::: "memory");
  __syncthreads();
  if (__builtin_amdgcn_workitem_id_x() == 0) {
    unsigned* bar = b.bar;
    __builtin_amdgcn_s_waitcnt(0);
    if (b.nloc == 0u) xcd_barrier_complete(bar, b.x, b.nloc, b.nx);
    const unsigned nloc = b.nloc, nx = b.nx;
    const unsigned old = xb_add(&bar[XB_XSUB(b.x)], 1u);
    const unsigned gen = old / nloc;
    if (old + 1u == (gen + 1u) * nloc) {
      __builtin_amdgcn_fence(__ATOMIC_RELEASE, "agent");
      asm volatile("s_waitcnt vmcnt(0)" ::: "memory");
      const unsigned og = xb_add(&bar[XB_TOP], 1u);
      const unsigned tg = og / nx;
      if (og + 1u == (tg + 1u) * nx) xb_add(&bar[XB_TOPGEN], 1u);
      else XB_SPIN(xb_ld(&bar[XB_TOPGEN]) == tg, bar);
      __builtin_amdgcn_fence(__ATOMIC_ACQUIRE, "agent");
      xb_add(&bar[XB_XGEN(b.x)], 1u);
      asm volatile("s_waitcnt vmcnt(0)" ::: "memory");
    } else {
      XB_SPIN(xb_ld(&bar[XB_XGEN(b.x)]) == gen, bar);
      __builtin_amdgcn_fence(__ATOMIC_ACQUIRE, "agent");
      asm volatile("s_waitcnt vmcnt(0)" ::: "memory");
    }
  }
  __syncthreads();
}

struct Epi { void* out; int ldo; float* rsp; int L; const float* rinv; };

template <int EPI>
__device__ __forceinline__ void gemm_phase(int first, int stride, int ntiles, int tmc, const u16* Abase, int lda, const u16* Wbase, int K, const Epi& e, char* smem) {
  const int tid = tidx(), lane = tid & 63, w = tid >> 6, wr = w >> 1, wc = w & 1, fr = lane & 15, fq = lane >> 4;
  const int gr = tid >> 2, gp = tid & 3;
  int it = first;
  if (it >= ntiles) return;
  const u16* Ab = Abase + (size_t)((it % tmc) * 256 + gr) * lda + gp * 8;
  const u16* Wp = Wbase + (size_t)((it / tmc) * 128 + gr) * K + gp * 8;
  const size_t a64 = (size_t)64 * lda, w64 = (size_t)64 * K;
  char* stA = smem + gr * 64 + ((gp ^ (((gr >> 3) & 1) * 3)) * 16);
  char* stB = stA + 16384;
  const int cho = (fq ^ ((fr >> 3) * 3)) * 16;
  const char* rdA = smem + (wr * 128 + fr) * 64 + cho;
  const char* rdB = smem + 16384 + (wc * 64 + fr) * 64 + cho;
  uint4 ra0_0, ra0_1, ra0_2, ra0_3, rb0_0, rb0_1, ra1_0, ra1_1, ra1_2, ra1_3, rb1_0, rb1_1;
  const int nk = K / 32;
#define G_LOAD(u, k0) ra##u##_0 = *(const uint4*)(Ab + (k0)); ra##u##_1 = *(const uint4*)(Ab + a64 + (k0)); ra##u##_2 = *(const uint4*)(Ab + 2 * a64 + (k0)); ra##u##_3 = *(const uint4*)(Ab + 3 * a64 + (k0)); \
                      rb##u##_0 = *(const uint4*)(Wp + (k0)); rb##u##_1 = *(const uint4*)(Wp + w64 + (k0));
#define G_STORE(u, stg) { char* pa_ = stA + (stg) * 24576; char* pb_ = stB + (stg) * 24576; \
    *(uint4*)pa_ = ra##u##_0; *(uint4*)(pa_ + 4096) = ra##u##_1; *(uint4*)(pa_ + 8192) = ra##u##_2; *(uint4*)(pa_ + 12288) = ra##u##_3; \
    *(uint4*)pb_ = rb##u##_0; *(uint4*)(pb_ + 4096) = rb##u##_1; }
#define G_COMPUTE(stg) { const char* qa_ = rdA + (stg) * 24576; const char* qb_ = rdB + (stg) * 24576; bf16x8 fb_[4]; \
    _Pragma("unroll") for (int ni = 0; ni < 4; ++ni) fb_[ni] = *(const bf16x8*)(qb_ + ni * 1024); \
    _Pragma("unroll") for (int mh = 0; mh < 2; ++mh) { bf16x8 fa_[4]; \
      _Pragma("unroll") for (int mi = 0; mi < 4; ++mi) fa_[mi] = *(const bf16x8*)(qa_ + (mh * 4 + mi) * 1024); \
      __builtin_amdgcn_s_setprio(1); \
      _Pragma("unroll") for (int mi = 0; mi < 4; ++mi) _Pragma("unroll") for (int ni = 0; ni < 4; ++ni) \
        acc[mh * 4 + mi][ni] = __builtin_amdgcn_mfma_f32_16x16x32_bf16(fb_[ni], fa_[mi], acc[mh * 4 + mi][ni], 0, 0, 0); \
      __builtin_amdgcn_s_setprio(0); } }
  G_LOAD(0, 0) G_LOAD(1, 32)
#pragma unroll 1
  for (;;) {
  const int m0 = (it % tmc) * 256, n0 = (it / tmc) * 128;
  f32x4 acc[8][4];
#pragma unroll
  for (int i = 0; i < 8; ++i)
#pragma unroll
    for (int j = 0; j < 4; ++j) acc[i][j] = (f32x4){0.f, 0.f, 0.f, 0.f};
  G_STORE(0, 0)
  G_LOAD(0, 64)
  __syncthreads();
#pragma unroll 1
  for (int kt0 = 0; kt0 < nk; kt0 += 2) {
    G_STORE(1, 1)
    if (kt0 + 3 < nk) { const int k0 = (kt0 + 3) * 32; G_LOAD(1, k0) }
    G_COMPUTE(0)
    __syncthreads();
    if (kt0 + 2 < nk) G_STORE(0, 0)
    if (kt0 + 4 < nk) { const int k0 = (kt0 + 4) * 32; G_LOAD(0, k0) }
    G_COMPUTE(1)
    __syncthreads();
  }
  const int itn = it + stride;
  if (itn < ntiles) {
    Ab = Abase + (size_t)((itn % tmc) * 256 + gr) * lda + gp * 8;
    Wp = Wbase + (size_t)((itn / tmc) * 128 + gr) * K + gp * 8;
    G_LOAD(0, 0) G_LOAD(1, 32)
  }
  if (EPI == 0 || EPI == 1) {
    u16* out = (u16*)e.out;
    const int cb = n0 + wc * 64;
    int ropemode = 0;
    if (EPI == 1) {
      if (cb < 3072 && (cb & 127) == 0) ropemode = 1;
      else if (cb >= O_DQ && cb < O_DV) ropemode = 2;
    }
#pragma unroll
    for (int mi = 0; mi < 8; ++mi) {
      const int rl = wr * 128 + mi * 16 + fr;
      const int row = m0 + rl;
      const float rv = e.rinv[row];
      f32x4 v[4];
#pragma unroll
      for (int ni = 0; ni < 4; ++ni) v[ni] = acc[mi][ni] * rv;
      if (EPI == 1 && ropemode != 0) {
        const float pos = (float)(row % e.L);
        if (ropemode == 1) {
#pragma unroll
          for (int j = 0; j < 4; ++j) {
            const int i = fq * 4 + j;
            const float inv = __expf(-13.122363377404328f * (float)i * (1.f / 16.f));
            float sn, cs;
            fsincos(pos * inv, &sn, &cs);
            const float x1 = v[0][j], x2 = v[1][j];
            v[0][j] = x1 * cs - x2 * sn;
            v[1][j] = x2 * cs + x1 * sn;
          }
        } else {
#pragma unroll
          for (int j = 0; j < 4; ++j) {
            const int i = (fq & 1) * 4 + j;
            const float inv = __expf(-13.122363377404328f * (float)i * (1.f / 8.f));
            float sn, cs;
            fsincos(pos * inv, &sn, &cs);
            const float mine = v[0][j];
            const float other = __shfl_xor(mine, 32);
            v[0][j] = (fq < 2) ? (mine * cs - other * sn) : (mine * cs + other * sn);
          }
        }
      }
#pragma unroll
      for (int np = 0; np < 2; ++np) {
        uint2 a = make_uint2(pack2(v[2 * np][0], v[2 * np][1]), pack2(v[2 * np][2], v[2 * np][3]));
        uint2 b = make_uint2(pack2(v[2 * np + 1][0], v[2 * np + 1][1]), pack2(v[2 * np + 1][2], v[2 * np + 1][3]));
        auto r0 = __builtin_amdgcn_permlane16_swap(a.x, b.x, false, false);
        auto r1 = __builtin_amdgcn_permlane16_swap(a.y, b.y, false, false);
        const int col = cb + (2 * np + (fq & 1)) * 16 + (fq >> 1) * 8;
        *(uint4*)(out + (size_t)row * e.ldo + col) = make_uint4(r0[0], r1[0], r0[1], r1[1]);
      }
    }
  } else {
    float* out = (float*)e.out;
    const int slot = (n0 >> 7) * 2 + wc;
#pragma unroll
    for (int mi = 0; mi < 8; ++mi) {
      const int row = m0 + wr * 128 + mi * 16 + fr;
      float sq = 0.f;
#pragma unroll
      for (int ni = 0; ni < 4; ++ni) {
        const int col = n0 + wc * 64 + ni * 16 + fq * 4;
        f32x4 v = acc[mi][ni];
        sq += v[0] * v[0] + v[1] * v[1] + v[2] * v[2] + v[3] * v[3];
        *(float4*)(out + (size_t)row * e.ldo + col) = make_float4(v[0], v[1], v[2], v[3]);
      }
      sq = xsum16(sq);
      sq = xsum32(sq);
      if (fq == 0) e.rsp[(size_t)row * 16 + slot] = sq;
    }
  }
  if (itn >= ntiles) break;
  it = itn;
  }
#undef G_COMPUTE
#undef G_STORE
#undef G_LOAD
}

__device__ __forceinline__ void rowprep_item(int item, const float* src, u16* dst, float* rinv) {
  const int tid = tidx(), lane = tid & 63, w = tid >> 6;
  const int row = item * 4 + w;
  float sq = 0.f;
#pragma unroll
  for (int i = 0; i < 4; ++i) {
    const int col = i * 256 + lane * 4;
    const float4 x = *(const float4*)(src + (size_t)row * 1024 + col);
    sq += x.x * x.x + x.y * x.y + x.z * x.z + x.w * x.w;
    *(uint2*)(dst + (size_t)row * 1024 + col) = make_uint2(pack2(x.x, x.y), pack2(x.z, x.w));
  }
  sq = wave_sum(sq);
  if (lane == 0) rinv[row] = rsqrtf(sq * (1.f / 1024.f) + EPSF);
}

DEVI int srccol_even(int n) {
  if (n < 8192) return n;
  if (n < 9216) return n + 32;
  if (n < 9248) return n - 1024;
  return -1;
}
__device__ __forceinline__ void wt_tile(const float* src, int Nsrc, const float* gain, u16* dst, int K, int kt, int nt, int evenmap, char* smem) {
  float (*tile)[65] = (float (*)[65])smem;
  const int tid = tidx(), r = tid >> 6, c = tid & 63;
  const int n = nt * 64 + c;
  const int sc = evenmap ? srccol_even(n) : n;
#pragma unroll
  for (int rr = r; rr < 64; rr += 4) {
    const int k = kt * 64 + rr;
    float v = 0.f;
    if (sc >= 0) v = src[(size_t)k * Nsrc + sc] * (gain ? gain[k] : 1.f);
    tile[rr][c] = v;
  }
  __syncthreads();
  for (int rr = r; rr < 64; rr += 4) {
    const int nn = nt * 64 + rr;
    const int k = kt * 64 + c;
    dst[(size_t)nn * K + k] = f2bf(tile[c][rr]);
  }
  __syncthreads();
}

__device__ __forceinline__ void filt_item(const P& p, int L, int pc, int cc, u16* Hr, char* smem) {
  float (*semb)[33] = (float (*)[33])smem;
  float (*sh1)[65] = (float (*)[65])(smem + 64 * 33 * 4);
  float (*sh2)[65] = (float (*)[65])(smem + 64 * 33 * 4 + 64 * 65 * 4);
  const int tid = tidx();
  for (int idx = tid; idx < 64 * 17; idx += 256) {
    const int i = idx / 17, b = idx % 17;
    const int t = pc * 64 + i;
    if (b == 16) {
      semb[i][0] = (float)t / (float)(L - 1);
    } else {
      const float f = 1e-4f + (float)b * ((15.f - 1e-4f) / 15.f);
      const float wv = (6.283185307179586f / (float)L) * (float)t;
      float sn, cs;
      fsincos(f * wv, &sn, &cs);
      semb[i][1 + b] = cs;
      semb[i][17 + b] = -sn;
    }
  }
  __syncthreads();
  {
    const int hh = tid & 63, ig = tid >> 6;
    const float fr_ = p.hy_freq[hh], b1 = p.hy_b1[hh];
    float a16[16];
#pragma unroll
    for (int r = 0; r < 16; ++r) a16[r] = b1;
    const float* wp = p.hy_w1 + hh;
#pragma unroll 1
    for (int e0 = 0; e0 < 33; e0 += 11) {
      float wv[11];
#pragma unroll
      for (int q = 0; q < 11; ++q) wv[q] = wp[(e0 + q) * 64];
#pragma unroll
      for (int q = 0; q < 11; ++q)
#pragma unroll
        for (int r = 0; r < 16; ++r) a16[r] += semb[ig * 16 + r][e0 + q] * wv[q];
    }
#pragma unroll
    for (int r = 0; r < 16; ++r) { float sn_, cs_; fsincos(fr_ * a16[r], &sn_, &cs_); sh1[ig * 16 + r][hh] = sn_; }
  }
  __syncthreads();
  {
    const int hh = tid & 63, ig = tid >> 6;
    const float fr_ = p.hy_freq[hh], b2 = p.hy_b2[hh];
    float a16[16];
#pragma unroll
    for (int r = 0; r < 16; ++r) a16[r] = b2;
    const float* wp = p.hy_w2 + hh;
#pragma unroll 1
    for (int k0 = 0; k0 < 64; k0 += 8) {
      float wv[8];
#pragma unroll
      for (int q = 0; q < 8; ++q) wv[q] = wp[(k0 + q) * 64];
#pragma unroll
      for (int q = 0; q < 8; ++q)
#pragma unroll
        for (int r = 0; r < 16; ++r) a16[r] += sh1[ig * 16 + r][k0 + q] * wv[q];
    }
#pragma unroll
    for (int r = 0; r < 16; ++r) { float sn_, cs_; fsincos(fr_ * a16[r], &sn_, &cs_); sh2[ig * 16 + r][hh] = sn_; }
  }
  __syncthreads();
  {
    const int c = cc * 256 + tid;
    const int ch = c & 1023;
    const bool bwd = c >= 1024;
    const float delta = 3.0701134573253946f + (float)ch * ((15.350567286626973f - 3.0701134573253946f) / 1023.f);
    const float skip = p.hy_skip[ch];
    u16* hr = Hr + (size_t)ch * (2 * L);
#pragma unroll 1
    for (int i0 = 0; i0 < 64; i0 += 8) {
      float acc8[8];
#pragma unroll
      for (int ii = 0; ii < 8; ++ii) acc8[ii] = 0.f;
      const float* wp = p.hy_w3 + c;
#pragma unroll 1
      for (int k0 = 0; k0 < 64; k0 += 8) {
        float wv[8];
#pragma unroll
        for (int q = 0; q < 8; ++q) wv[q] = wp[(size_t)(k0 + q) * 2048];
#pragma unroll
        for (int q = 0; q < 8; ++q)
#pragma unroll
          for (int ii = 0; ii < 8; ++ii) acc8[ii] += sh2[i0 + ii][k0 + q] * wv[q];
      }
#pragma unroll
      for (int ii = 0; ii < 8; ++ii) {
        const int t = pc * 64 + i0 + ii;
        float s = acc8[ii];
        const float tt = (float)t / (float)(L - 1);
        s *= __expf(-tt * delta);
        if (!bwd) {
          if (t == 0) s += skip;
          hr[L - 1 - t] = f2bf(s);
        } else if (t > 0) {
          hr[L - 1 + t] = f2bf(s);
        }
      }
    }
    if (bwd && pc == 0) hr[2 * L - 1] = 0;
  }
  __syncthreads();
}

__device__ __forceinline__ void hy_pre_item(const P& p, int L, int tt, int cq, const u16* z, u16* cat, u16* ut) {
  const int tid = tidx(), cg = tid & 31, tr = tid >> 5;
  const int c0 = cq * 128 + cg * 4;
  const int t0 = tt * 64 + tr * 8;
  float w[3][3][4], b[3][4];
#pragma unroll
  for (int s = 0; s < 3; ++s) {
#pragma unroll
    for (int j = 0; j < 3; ++j) {
      const float4 a = *(const float4*)(p.hy_conv_w + j * 3072 + s * 1024 + c0);
      w[s][j][0] = a.x; w[s][j][1] = a.y; w[s][j][2] = a.z; w[s][j][3] = a.w;
    }
    const float4 a = *(const float4*)(p.hy_conv_b + s * 1024 + c0);
    b[s][0] = a.x; b[s][1] = a.y; b[s][2] = a.z; b[s][3] = a.w;
  }
  uint2 prev[3], cur[3], nxt[3];
#pragma unroll
  for (int s = 0; s < 3; ++s) {
    prev[s] = ((t0 % L) > 0) ? *(const uint2*)(z + (size_t)(t0 - 1) * ZSE + E_HY + s * 1024 + c0) : make_uint2(0, 0);
    cur[s] = *(const uint2*)(z + (size_t)t0 * ZSE + E_HY + s * 1024 + c0);
  }
  unsigned up[4][4];
#pragma unroll
  for (int r = 0; r < 8; ++r) {
    const int t = t0 + r;
    const bool hasn = (t % L) < L - 1;
    float uc[3][4];
#pragma unroll
    for (int s = 0; s < 3; ++s) {
      nxt[s] = hasn ? *(const uint2*)(z + (size_t)(t + 1) * ZSE + E_HY + s * 1024 + c0) : make_uint2(0, 0);
      uc[s][0] = w[s][0][0] * lo2f(prev[s].x) + w[s][1][0] * lo2f(cur[s].x) + w[s][2][0] * lo2f(nxt[s].x) + b[s][0];
      uc[s][1] = w[s][0][1] * hi2f(prev[s].x) + w[s][1][1] * hi2f(cur[s].x) + w[s][2][1] * hi2f(nxt[s].x) + b[s][1];
      uc[s][2] = w[s][0][2] * lo2f(prev[s].y) + w[s][1][2] * lo2f(cur[s].y) + w[s][2][2] * lo2f(nxt[s].y) + b[s][2];
      uc[s][3] = w[s][0][3] * hi2f(prev[s].y) + w[s][1][3] * hi2f(cur[s].y) + w[s][2][3] * hi2f(nxt[s].y) + b[s][3];
      prev[s] = cur[s];
      cur[s] = nxt[s];
    }
    const uint2 g2 = *(const uint2*)(z + (size_t)t * ZSE + E_GHY + c0);
    *(uint2*)(cat + (size_t)t * 1024 + c0) = make_uint2(pack2(uc[0][0] * silu(lo2f(g2.x)), uc[0][1] * silu(hi2f(g2.x))),
                                                        pack2(uc[0][2] * silu(lo2f(g2.y)), uc[0][3] * silu(hi2f(g2.y))));
#pragma unroll
    for (int e2 = 0; e2 < 4; ++e2) {
      const unsigned hb = (unsigned)f2bf(uc[2][e2] * uc[1][e2]);
      if (r & 1) up[e2][r >> 1] |= hb << 16; else up[e2][r >> 1] = hb;
    }
  }
#pragma unroll
  for (int e2 = 0; e2 < 4; ++e2)
    *(uint4*)(ut + (size_t)(c0 + e2) * GT + t0) = make_uint4(up[e2][0], up[e2][1], up[e2][2], up[e2][3]);
}

__device__ __forceinline__ void hy_post_item(int tt, int cq, const u16* yt, const u16* gateA, u16* cat) {
  const int tid = tidx(), cg = tid & 31, tr = tid >> 5;
  const int c0 = cq * 128 + cg * 4;
  const int t0 = tt * 64 + tr * 8;
  unsigned yw[4][4];
#pragma unroll
  for (int e2 = 0; e2 < 4; ++e2) {
    const uint4 v = *(const uint4*)(yt + (size_t)(c0 + e2) * GT + t0);
    yw[e2][0] = v.x; yw[e2][1] = v.y; yw[e2][2] = v.z; yw[e2][3] = v.w;
  }
#pragma unroll
  for (int r = 0; r < 8; ++r) {
    u16* q = cat + (size_t)(t0 + r) * CATW + c0;
    const uint2 g = *(const uint2*)(gateA + (size_t)(t0 + r) * 1024 + c0);
    float y[4];
#pragma unroll
    for (int e2 = 0; e2 < 4; ++e2) y[e2] = (r & 1) ? hi2f(yw[e2][r >> 1]) : lo2f(yw[e2][r >> 1]);
    *(uint2*)q = make_uint2(pack2(lo2f(g.x) * y[0], hi2f(g.x) * y[1]), pack2(lo2f(g.y) * y[2], hi2f(g.y) * y[3]));
  }
}

__device__ __forceinline__ void hy_conv_item(int L, int nb, int ch, const u16* Hr, const u16* ut, u16* yt, char* smem) {
  unsigned* w0 = (unsigned*)smem;
  unsigned* w1 = w0 + L;
  u16* sU = (u16*)(w1 + L);
  constexpr int DL = 1024;
  const int S = 16 / nb;
  const int tid = tidx(), lane = tid & 63, w = tid >> 6, fr = lane & 15, fq = lane >> 4;
  {
    const u16* hr = Hr + (size_t)ch * 2 * L;
    const unsigned* hw = (const unsigned*)hr;
#pragma unroll 8
    for (int i = tid; i < L; i += 256) {
      const unsigned a = hw[i];
      const unsigned nx = (i + 1 < L) ? hw[i + 1] : 0u;
      w0[i] = a;
      if (i + 1 < L) w1[i] = (a >> 16) | (nx << 16);
    }
    const uint4* src = (const uint4*)(ut + (size_t)ch * GT);
    const int cpr = L / 8;
#pragma unroll
    for (int idx = tid; idx < GT / 8; idx += 256) {
      const int b = idx / cpr, q = idx % cpr;
      const int key = (b * S + ((q * 8) >> 10)) & 15;
      ((uint4*)sU)[b * cpr + (q ^ key)] = src[idx];
    }
  }
  __syncthreads();
  const int cs = fr / nb, cb = fr % nb;
  const int xl = L - 1 - fr + 8 * fq;
  const unsigned* wb = (xl & 1) ? (w1 + ((xl - 1) >> 1)) : (w0 + (xl >> 1));
  const uint4* urow = (const uint4*)sU + cb * (L / 8);
  const int mstart = -(S - 1) * DL;
#pragma unroll 1
  for (int pass = 0; pass < 2; ++pass) {
    const int n0 = (pass * 4 + w) * 128;
    f32x4 acc[8];
#pragma unroll
    for (int i = 0; i < 8; ++i) acc[i] = (f32x4){0.f, 0.f, 0.f, 0.f};
    union AF { unsigned u[4]; bf16x8 v; };
    AF ring[8];
#pragma unroll
    for (int i = 0; i < 8; ++i) {
      const unsigned* src = wb - ((n0 - mstart + 16 * i) >> 1);
      ring[i].u[0] = src[0]; ring[i].u[1] = src[1]; ring[i].u[2] = src[2]; ring[i].u[3] = src[3];
    }
#pragma unroll 1
    for (int m0 = mstart; m0 < L; m0 += 128) {
#pragma unroll
      for (int j = 0; j < 4; ++j) {
        const int mm = m0 + 32 * j;
        const int mb = mm + cs * DL;
        bf16x8 bfrag = {0, 0, 0, 0, 0, 0, 0, 0};
        if (mb >= 0 && mb < L) {
          const int mp = mb + 8 * fq;
          const int q = mp >> 3;
          const int key = (cb * S + (mp >> 10)) & 15;
          union { uint4 q4; bf16x8 v; } t;
          t.q4 = urow[q ^ key];
          bfrag = t.v;
        }
#pragma unroll
        for (int i = 0; i < 8; ++i)
          acc[i] = __builtin_amdgcn_mfma_f32_16x16x32_bf16(ring[(i - 2 * j) & 7].v, bfrag, acc[i], 0, 0, 0);
        if (mm + 32 < L) {
          const unsigned* s0 = wb - ((n0 - mm - 32) >> 1);
          AF& r0 = ring[(0 - 2 * (j + 1)) & 7];
          AF& r1 = ring[(1 - 2 * (j + 1)) & 7];
          r0.u[0] = s0[0]; r0.u[1] = s0[1]; r0.u[2] = s0[2]; r0.u[3] = s0[3];
          r1.u[0] = s0[-8]; r1.u[1] = s0[-7]; r1.u[2] = s0[-6]; r1.u[3] = s0[-5];
        }
      }
    }
#pragma unroll
    for (int i = 0; i < 8; ++i) {
      const int n = cs * DL + n0 + 16 * i + fq * 4;
      *(uint2*)(yt + (size_t)ch * GT + cb * L + n) = make_uint2(pack2(acc[i][0], acc[i][1]), pack2(acc[i][2], acc[i][3]));
    }
  }
  __syncthreads();
}

__device__ __forceinline__ void gdn_pre_item(const P& p, int L, int tt, int h, const u16* z, u16* qkvn, float* gba, u16* cat) {
  const int tid = tidx(), lane = tid & 63, w = tid >> 6;
  float cw[3][5][2];
#pragma unroll
  for (int s = 0; s < 3; ++s)
#pragma unroll
    for (int j = 0; j < 5; ++j) {
      cw[s][j][0] = p.gdn_conv_w[j * 3072 + s * 1024 + h * 128 + 2 * lane];
      cw[s][j][1] = p.gdn_conv_w[j * 3072 + s * 1024 + h * 128 + 2 * lane + 1];
    }
  const int t0 = tt * 64 + w * 16;
  const int seq0 = (t0 / L) * L;
  auto ld = [&](int t, int s) -> unsigned {
    if (t < seq0 || t >= seq0 + L) return 0u;
    return *(const unsigned*)(z + (size_t)t * ZSE + E_QKV + s * 1024 + h * 128 + 2 * lane);
  };
  unsigned win[3][5];
#pragma unroll
  for (int s = 0; s < 3; ++s) {
    win[s][0] = ld(t0 - 2, s);
    win[s][1] = ld(t0 - 1, s);
    win[s][2] = ld(t0, s);
    win[s][3] = ld(t0 + 1, s);
    win[s][4] = 0;
  }
#pragma unroll
  for (int r = 0; r < 16; ++r) {
    const int t = t0 + r;
    float y[3][2];
#pragma unroll
    for (int s = 0; s < 3; ++s) {
      win[s][4] = ld(t + 2, s);
      float a0 = 0.f, a1 = 0.f;
#pragma unroll
      for (int j = 0; j < 5; ++j) {
        a0 += lo2f(win[s][j]) * cw[s][j][0];
        a1 += hi2f(win[s][j]) * cw[s][j][1];
      }
      y[s][0] = silu(a0);
      y[s][1] = silu(a1);
#pragma unroll
      for (int j = 0; j < 4; ++j) win[s][j] = win[s][j + 1];
    }
    const float ssq = wave_sum(y[0][0] * y[0][0] + y[0][1] * y[0][1]);
    const float ssk = wave_sum(y[1][0] * y[1][0] + y[1][1] * y[1][1]);
    const float rq = rsqrtf(ssq + EPSF) * 0.08838834764831845f;
    const float rk = rsqrtf(ssk + EPSF);
    u16* dst = qkvn + ((size_t)t * 8 + h) * 384 + 2 * lane;
    *(unsigned*)dst = pack2(y[0][0] * rq, y[0][1] * rq);
    *(unsigned*)(dst + 128) = pack2(y[1][0] * rk, y[1][1] * rk);
    *(unsigned*)(dst + 256) = pack2(y[2][0], y[2][1]);
    {
      const unsigned gg = *(const unsigned*)(z + (size_t)t * ZSE + E_GG + h * 128 + 2 * lane);
      *(unsigned*)(cat + (size_t)t * 1024 + h * 128 + 2 * lane) = pack2(silu(lo2f(gg)), silu(hi2f(gg)));
    }
  }
  if (tid < 128) {
    const int t = tt * 64 + (tid >> 1), dir = tid & 1;
    const float zb = bf2f(z[(size_t)t * ZSE + E_BETA + dir * 8 + h]);
    const float za = bf2f(z[(size_t)t * ZSE + E_A + dir * 8 + h]);
    const float beta = 1.f / (1.f + __expf(-zb));
    const float xx = za + p.gdn_dt_bias[dir * 8 + h];
    const float sp = (xx > 20.f) ? xx : log1pf(__expf(xx));
    const float gl = -__expf(p.gdn_A_log[dir * 8 + h]) * sp;
    float* d = gba + (((size_t)t * 8 + h) * 2 + dir) * 2;
    d[0] = beta;
    d[1] = gl;
  }
}

constexpr int REC_ELEMS = 36864;
constexpr size_t OFF_GL = OFF_Z + (size_t)4096 * REC_ELEMS * 2;
static_assert(OFF_GL + 4096 * 4 <= OFF_CAT, "chunk records overflow z region");

__device__ __forceinline__ void gdn_chunk_item(int L, int r, const u16* qkvn, const float* gba, u16* rec_base, float* GL, char* smem) {
  const int NC = L / 64;
  const int n = r % NC, ci = r / NC;
  const int dir = ci & 1, h = (ci >> 1) & 7, bl = ci >> 4;
  u16* rec = rec_base + (size_t)r * REC_ELEMS;
  u16* sKb = (u16*)smem;
  u16* sQb = sKb + 64 * 136;
  float* sA = (float*)(smem + 2 * 17408);
  float* sG = (float*)(smem + 3 * 17408);
  float* sBeta = sG + 64;
  float* sg = sBeta + 64;
  const int tid = tidx(), lane = tid & 63, w = tid >> 6, fr = lane & 15, fq = lane >> 4;
  auto tok = [&](int c) -> int { const int pos = n * 64 + c; return bl * L + (dir ? (L - 1 - pos) : pos); };
  if (tid < 64) {
    const size_t o = (((size_t)tok(tid) * 8 + h) * 2 + dir) * 2;
    sBeta[tid] = gba[o];
    sg[tid] = gba[o + 1];
  }
  __syncthreads();
  if (tid < 64) {
    float sacc = 0.f;
    for (int l = 0; l <= tid; ++l) sacc += sg[l];
    sG[tid] = sacc;
  }
  __syncthreads();
#pragma unroll
  for (int it = 0; it < 8; ++it) {
    const int idx = it * 256 + tid, c = idx >> 5, c4 = idx & 31;
    const u16* src = qkvn + ((size_t)tok(c) * 8 + h) * 384 + c4 * 4;
    const uint2 q = *(const uint2*)src;
    const uint2 k = *(const uint2*)(src + 128);
    *(uint2*)(sQb + c * 136 + c4 * 4) = q;
    *(uint2*)(sKb + c * 136 + c4 * 4) = k;
    const float eg = __expf(sG[c]);
    *(uint2*)(rec + 16384 + c * 128 + c4 * 4) = make_uint2(pack2(lo2f(q.x) * eg, hi2f(q.x) * eg), pack2(lo2f(q.y) * eg, hi2f(q.y) * eg));
  }
  __syncthreads();
  {
    const int i = 16 * w + fr;
    bf16x8 kif[4], qif[4];
#pragma unroll
    for (int kk = 0; kk < 4; ++kk) {
      kif[kk] = *(const bf16x8*)(sKb + i * 136 + kk * 32 + fq * 8);
      qif[kk] = *(const bf16x8*)(sQb + i * 136 + kk * 32 + fq * 8);
    }
    const float Gi = sG[i], bi = sBeta[i];
#pragma unroll
    for (int jt = 0; jt < 4; ++jt) {
      f32x4 akk = (f32x4){0.f, 0.f, 0.f, 0.f}, aqk = (f32x4){0.f, 0.f, 0.f, 0.f};
      if (jt <= w) {
#pragma unroll
        for (int kk = 0; kk < 4; ++kk) {
          const bf16x8 kj = *(const bf16x8*)(sKb + (16 * jt + fr) * 136 + kk * 32 + fq * 8);
          akk = __builtin_amdgcn_mfma_f32_16x16x32_bf16(kj, kif[kk], akk, 0, 0, 0);
          aqk = __builtin_amdgcn_mfma_f32_16x16x32_bf16(kj, qif[kk], aqk, 0, 0, 0);
        }
      }
      float av[4], qv[4];
#pragma unroll
      for (int jj = 0; jj < 4; ++jj) {
        const int j = 16 * jt + 4 * fq + jj;
        const float dec = (j <= i) ? __expf(Gi - sG[j]) : 0.f;
        av[jj] = (j < i) ? bi * akk[jj] * dec : 0.f;
        qv[jj] = aqk[jj] * dec;
      }
      *(float4*)(sA + i * 68 + 16 * jt + 4 * fq) = make_float4(av[0], av[1], av[2], av[3]);
      *(uint2*)(rec + 32768 + i * 64 + 16 * jt + 4 * fq) = make_uint2(pack2(qv[0], qv[1]), pack2(qv[2], qv[3]));
    }
  }
  __syncthreads();
  {
    const int c = tid;
    const bool isU = c < 128;
    const int col = isU ? (256 + c) : c;
    float x[64];
#pragma unroll
    for (int i = 0; i < 64; ++i) x[i] = bf2f(qkvn[((size_t)tok(i) * 8 + h) * 384 + col]);
#pragma unroll
    for (int i = 0; i < 64; ++i) {
      float acc = x[i] * sBeta[i] * (isU ? 1.f : __expf(sG[i]));
      float ac1 = 0.f, ac2 = 0.f, ac3 = 0.f;
#pragma unroll
      for (int j4 = 0; j4 < (i + 3) / 4; ++j4) {
        const float4 a = *(const float4*)(sA + i * 68 + 4 * j4);
        acc -= a.x * x[4 * j4];
        if (4 * j4 + 1 < i) ac1 -= a.y * x[4 * j4 + 1];
        if (4 * j4 + 2 < i) ac2 -= a.z * x[4 * j4 + 2];
        if (4 * j4 + 3 < i) ac3 -= a.w * x[4 * j4 + 3];
      }
      x[i] = (acc + ac1) + (ac2 + ac3);
    }
    if (isU) {
      u16* dst = rec + (size_t)c * 64;
#pragma unroll
      for (int q8 = 0; q8 < 8; ++q8)
        *(uint4*)(dst + q8 * 8) = make_uint4(pack2(x[q8 * 8], x[q8 * 8 + 1]), pack2(x[q8 * 8 + 2], x[q8 * 8 + 3]),
                                             pack2(x[q8 * 8 + 4], x[q8 * 8 + 5]), pack2(x[q8 * 8 + 6], x[q8 * 8 + 7]));
    } else {
#pragma unroll
      for (int i = 0; i < 64; ++i) sQb[i * 136 + (c - 128)] = f2bf(x[i]);
    }
  }
  __syncthreads();
#pragma unroll
  for (int it = 0; it < 4; ++it) {
    const int idx = it * 256 + tid, row = idx >> 4, ch = idx & 15;
    *(uint4*)(rec + 8192 + row * 128 + ch * 8) = *(const uint4*)(sQb + row * 136 + ch * 8);
  }
  if (tid < 128) {
    const float Gl = sG[63];
    u16* dst = rec + 24576 + (size_t)tid * 64;
#pragma unroll
    for (int q8 = 0; q8 < 8; ++q8) {
      float v[8];
#pragma unroll
      for (int e2 = 0; e2 < 8; ++e2) {
        const int i = q8 * 8 + e2;
        v[e2] = bf2f(sKb[i * 136 + tid]) * __expf(Gl - sG[i]);
      }
      *(uint4*)(dst + q8 * 8) = make_uint4(pack2(v[0], v[1]), pack2(v[2], v[3]), pack2(v[4], v[5]), pack2(v[6], v[7]));
    }
  }
  if (tid == 0) GL[r] = __expf(sG[63]);
  __syncthreads();
}

__device__ __forceinline__ void gdn_cscan_item(int L, int ci, int half, const u16* rec_base, const float* GL, float* odir, char* smem) {
  const int NC = L / 64;
  const int dir = ci & 1, h = (ci >> 1) & 7, bl = ci >> 4;
  u16* sST = (u16*)smem;
  u16* sVT = sST + 64 * 136;
  const int tid = tidx(), lane = tid & 63, w = tid >> 6, fr = lane & 15, fq = lane >> 4;
  f32x4 S[2][4];
#pragma unroll
  for (int u = 0; u < 2; ++u)
#pragma unroll
    for (int t = 0; t < 4; ++t) S[u][t] = (f32x4){0.f, 0.f, 0.f, 0.f};
  for (int idx = tid; idx < 64 * 136 / 2; idx += 256) ((unsigned*)sST)[idx] = 0u;
  __syncthreads();
  bf16x8 nwf[4], nqgf[4], nqkf[2], nkdf[2][2];
  uint2 nut[4];
  float ngl;
#define SCAN_LOAD(nn)                                                                                             \
  {                                                                                                               \
    const u16* rec = rec_base + (size_t)(ci * NC + (nn)) * REC_ELEMS;                                             \
    ngl = GL[ci * NC + (nn)];                                                                                     \
    _Pragma("unroll") for (int kk = 0; kk < 4; ++kk) {                                                            \
      nwf[kk] = *(const bf16x8*)(rec + 8192 + (16 * w + fr) * 128 + kk * 32 + fq * 8);                            \
      nqgf[kk] = *(const bf16x8*)(rec + 16384 + (16 * w + fr) * 128 + kk * 32 + fq * 8);                          \
    }                                                                                                             \
    _Pragma("unroll") for (int kk = 0; kk < 2; ++kk) {                                                            \
      nqkf[kk] = *(const bf16x8*)(rec + 32768 + (16 * w + fr) * 64 + kk * 32 + fq * 8);                           \
      _Pragma("unroll") for (int u = 0; u < 2; ++u)                                                               \
        nkdf[u][kk] = *(const bf16x8*)(rec + 24576 + (32 * w + 16 * u + fr) * 64 + kk * 32 + fq * 8);             \
    }                                                                                                             \
    _Pragma("unroll") for (int t = 0; t < 4; ++t) nut[t] = *(const uint2*)(rec + (half * 64 + 16 * t + fr) * 64 + 16 * w + 4 * fq); \
  }
  SCAN_LOAD(0)
#pragma unroll 1
  for (int n = 0; n < NC; ++n) {
    const float gl = ngl;
    bf16x8 wf[4], qgf[4], qkf[2], kdf[2][2];
    uint2 ut[4];
#pragma unroll
    for (int kk = 0; kk < 4; ++kk) { wf[kk] = nwf[kk]; qgf[kk] = nqgf[kk]; }
#pragma unroll
    for (int kk = 0; kk < 2; ++kk) { qkf[kk] = nqkf[kk]; kdf[0][kk] = nkdf[0][kk]; kdf[1][kk] = nkdf[1][kk]; }
#pragma unroll
    for (int t = 0; t < 4; ++t) ut[t] = nut[t];
    if (n + 1 < NC) SCAN_LOAD(n + 1)
#pragma unroll
    for (int t = 0; t < 4; ++t) {
      f32x4 acc = (f32x4){0.f, 0.f, 0.f, 0.f};
#pragma unroll
      for (int kk = 0; kk < 4; ++kk) {
        const bf16x8 b = *(const bf16x8*)(sST + (16 * t + fr) * 136 + kk * 32 + fq * 8);
        acc = __builtin_amdgcn_mfma_f32_16x16x32_bf16(wf[kk], b, acc, 0, 0, 0);
      }
      const float v0 = lo2f(ut[t].x) - acc[0], v1 = hi2f(ut[t].x) - acc[1], v2 = lo2f(ut[t].y) - acc[2], v3 = hi2f(ut[t].y) - acc[3];
      *(uint2*)(sVT + (16 * t + fr) * 72 + 16 * w + 4 * fq) = make_uint2(pack2(v0, v1), pack2(v2, v3));
    }
    __syncthreads();
#pragma unroll
    for (int t = 0; t < 4; ++t) {
      f32x4 acc = (f32x4){0.f, 0.f, 0.f, 0.f};
#pragma unroll
      for (int kk = 0; kk < 4; ++kk) {
        const bf16x8 b = *(const bf16x8*)(sST + (16 * t + fr) * 136 + kk * 32 + fq * 8);
        acc = __builtin_amdgcn_mfma_f32_16x16x32_bf16(qgf[kk], b, acc, 0, 0, 0);
      }
#pragma unroll
      for (int kk = 0; kk < 2; ++kk) {
        const bf16x8 b = *(const bf16x8*)(sVT + (16 * t + fr) * 72 + kk * 32 + fq * 8);
        acc = __builtin_amdgcn_mfma_f32_16x16x32_bf16(qkf[kk], b, acc, 0, 0, 0);
      }
#pragma unroll
      for (int j = 0; j < 4; ++j) {
        const int pos = n * 64 + 16 * w + 4 * fq + j;
        const int tk = bl * L + (dir ? (L - 1 - pos) : pos);
        odir[(size_t)tk * 1024 + h * 128 + half * 64 + 16 * t + fr] = acc[j];
      }
    }
#pragma unroll
    for (int u = 0; u < 2; ++u)
#pragma unroll
      for (int t = 0; t < 4; ++t) {
        f32x4 acc = S[u][t] * gl;
#pragma unroll
        for (int kk = 0; kk < 2; ++kk) {
          const bf16x8 b = *(const bf16x8*)(sVT + (16 * t + fr) * 72 + kk * 32 + fq * 8);
          acc = __builtin_amdgcn_mfma_f32_16x16x32_bf16(kdf[u][kk], b, acc, 0, 0, 0);
        }
        S[u][t] = acc;
      }
    __syncthreads();
#pragma unroll
    for (int u = 0; u < 2; ++u)
#pragma unroll
      for (int t = 0; t < 4; ++t)
        *(uint2*)(sST + (16 * t + fr) * 136 + 32 * w + 16 * u + 4 * fq) = make_uint2(pack2(S[u][t][0], S[u][t][1]), pack2(S[u][t][2], S[u][t][3]));
    __syncthreads();
  }
}

#undef SCAN_LOAD
__device__ __forceinline__ void gdn_post_item(const P& p, int tt, const float* of, const float* ob, const u16* gateB, u16* cat) {
  const int tid = tidx(), lane = tid & 63, w = tid >> 6;
  const int p4 = lane >> 4, d8 = (lane & 15) * 8;
  const float4 g0 = *(const float4*)(p.gdn_norm_g + d8), g1 = *(const float4*)(p.gdn_norm_g + d8 + 4);
#pragma unroll
  for (int it = 0; it < 4; ++it) {
    const int pr = w * 16 + it * 4 + p4;
    const int t = tt * 8 + (pr >> 3), h = pr & 7;
    const size_t o = (size_t)t * 1024 + h * 128 + d8;
    const float4 a0 = *(const float4*)(of + o), a1 = *(const float4*)(of + o + 4);
    const float4 b0 = *(const float4*)(ob + o), b1 = *(const float4*)(ob + o + 4);
    u16* cp = cat + (size_t)t * CATW + 1024 + h * 128 + d8;
    const uint4 gg = *(const uint4*)(gateB + (size_t)t * 1024 + h * 128 + d8);
    float x[8] = {a0.x + b0.x, a0.y + b0.y, a0.z + b0.z, a0.w + b0.w, a1.x + b1.x, a1.y + b1.y, a1.z + b1.z, a1.w + b1.w};
    float ss = 0.f;
#pragma unroll
    for (int e2 = 0; e2 < 8; ++e2) ss += x[e2] * x[e2];
    ss = row_sum16(ss);
    const float rinv = rsqrtf(ss * (1.f / 128.f) + EPSF);
    const float gn[8] = {g0.x, g0.y, g0.z, g0.w, g1.x, g1.y, g1.z, g1.w};
    const unsigned gw[4] = {gg.x, gg.y, gg.z, gg.w};
    unsigned ow[4];
#pragma unroll
    for (int q = 0; q < 4; ++q)
      ow[q] = pack2(x[2 * q] * rinv * gn[2 * q] * lo2f(gw[q]), x[2 * q + 1] * rinv * gn[2 * q + 1] * hi2f(gw[q]));
    *(uint4*)cp = make_uint4(ow[0], ow[1], ow[2], ow[3]);
  }
}

template <bool COPY>
__device__ __forceinline__ void resid_item(int item, const float* xin, const float* outb, const float* rsp, const float* g, float* dst, u16* xb, float* rinvb) {
  const int tid = tidx(), lane = tid & 63, w = tid >> 6;
  const int row = item * 4 + w;
  float s = 0.f;
#pragma unroll
  for (int i = 0; i < 16; ++i) s += rsp[(size_t)row * 16 + i];
  const float rinv = rsqrtf(s * (1.f / 1024.f) + EPSF);
  float sq = 0.f;
#pragma unroll
  for (int i = 0; i < 4; ++i) {
    const int col = i * 256 + lane * 4;
    float4 x = *(const float4*)(xin + (size_t)row * 1024 + col);
    float4 o = *(const float4*)(outb + (size_t)row * 1024 + col);
    float4 gg = *(const float4*)(g + col);
    float4 y = make_float4(x.x + o.x * rinv * gg.x, x.y + o.y * rinv * gg.y, x.z + o.z * rinv * gg.z, x.w + o.w * rinv * gg.w);
    *(float4*)(dst + (size_t)row * 1024 + col) = y;
    if (COPY) {
      sq += y.x * y.x + y.y * y.y + y.z * y.z + y.w * y.w;
      *(uint2*)(xb + (size_t)row * 1024 + col) = make_uint2(pack2(y.x, y.y), pack2(y.z, y.w));
    }
  }
  if (COPY) {
    sq = wave_sum(sq);
    if (lane == 0) rinvb[row] = rsqrtf(sq * (1.f / 1024.f) + EPSF);
  }
}

struct AttnIO {
  const u16* q; long qstep;
  const u16* k; const u16* v; long kstep;
  u16* o; long ostep;
  const u16* g; long gstep;
  float* lse; long lstep;
};

template <int DH, int NTW, int NCHUNK, int CHCOLS, int VSTR, bool MASK, int NH = 1>
__device__ __forceinline__ void attn_block(const AttnIO& io, int Lr, int q0, int HW, float scale, const float* sinkp, long hstep, char* smem) {
  u16* sV = (u16*)smem;
  const int tid = tidx(), lane = tid & 63, w = tid >> 6, fr = lane & 15, fq = lane >> 4;
  constexpr int NKK = DH / 32;
  constexpr int NDD = DH / 16;
  constexpr int SPC = NTW / 2 / NCHUNK;
  const int qw0 = q0 + 16 * w;
  const int kw0 = MASK ? (qw0 - HW) : 0;
  const int qp = qw0 + fr;
  const bool has_sink = (sinkp != nullptr);
  auto stage = [&](int c) {
    __syncthreads();
    const int k0c = MASK ? (q0 - HW) : c * CHCOLS;
    {
      constexpr int NIDX = CHCOLS * (DH / 8);
      constexpr int NIT = (NIDX + 255) / 256;
      uint4 vv[NIT];
#pragma unroll
      for (int q = 0; q < NIT; ++q) {
        const int idx = q * 256 + tid;
        const int col = idx % CHCOLS, dch = idx / CHCOLS;
        const int kp = k0c + col;
        vv[q] = make_uint4(0, 0, 0, 0);
        if (idx < NIDX && kp >= 0 && kp < Lr) vv[q] = *(const uint4*)(io.v + (long)kp * io.kstep + dch * 8);
      }
#pragma unroll
      for (int q = 0; q < NIT; ++q) {
        const int idx = q * 256 + tid;
        if (idx < NIDX) {
          const int col = idx % CHCOLS, dch = idx / CHCOLS;
          u16* d = sV + (dch * 8) * VSTR + col;
          d[0] = (u16)(vv[q].x & 0xffff); d[VSTR] = (u16)(vv[q].x >> 16);
          d[2 * VSTR] = (u16)(vv[q].y & 0xffff); d[3 * VSTR] = (u16)(vv[q].y >> 16);
          d[4 * VSTR] = (u16)(vv[q].z & 0xffff); d[5 * VSTR] = (u16)(vv[q].z >> 16);
          d[6 * VSTR] = (u16)(vv[q].w & 0xffff); d[7 * VSTR] = (u16)(vv[q].w >> 16);
        }
      }
    }
    __syncthreads();
  };
  if (NCHUNK == 1) stage(0);
#pragma unroll 1
  for (int hd = 0; hd < NH; ++hd) {
  const float sink = has_sink ? sinkp[hd] : 0.f;
  bf16x8 qf[NKK];
  {
    const u16* qptr = io.q + hd * hstep + (long)qp * io.qstep + fq * 8;
#pragma unroll
    for (int kk = 0; kk < NKK; ++kk) qf[kk] = *(const bf16x8*)(qptr + kk * 32);
  }
  f32x4 oacc[NDD];
#pragma unroll
  for (int dd = 0; dd < NDD; ++dd) oacc[dd] = (f32x4){0.f, 0.f, 0.f, 0.f};
  float m = has_sink ? sink : -1e30f;
  float den = 0.f;
#pragma unroll
  for (int c = 0; c < NCHUNK; ++c) {
    if (NCHUNK > 1) stage(c);
    auto kload = [&](bf16x8 (&dst)[2][NKK], int ktbase) {
#pragma unroll
      for (int tt = 0; tt < 2; ++tt) {
        const int kp = kw0 + 16 * (ktbase + tt) + fr;
        const bool valid = (kp >= 0) && (kp < Lr);
        const u16* kptr = io.k + (long)(valid ? kp : 0) * io.kstep + fq * 8;
#pragma unroll
        for (int kk = 0; kk < NKK; ++kk) {
          bf16x8 kf = {0, 0, 0, 0, 0, 0, 0, 0};
          if (valid) kf = *(const bf16x8*)(kptr + kk * 32);
          dst[tt][kk] = kf;
        }
      }
    };
    auto qk = [&](bf16x8 (&kf)[2][NKK], f32x4 (&st)[2]) {
#pragma unroll
      for (int tt = 0; tt < 2; ++tt) {
        st[tt] = (f32x4){0.f, 0.f, 0.f, 0.f};
#pragma unroll
        for (int kk = 0; kk < NKK; ++kk)
          st[tt] = __builtin_amdgcn_mfma_f32_16x16x32_bf16(kf[tt][kk], qf[kk], st[tt], 0, 0, 0);
      }
    };
    auto tail = [&](f32x4 (&st)[2], int kt0) {
      bool ok[2][4];
      float mloc = -1e30f;
#pragma unroll
      for (int tt = 0; tt < 2; ++tt)
#pragma unroll
        for (int j = 0; j < 4; ++j) {
          bool okv = true;
          if (MASK) {
            const int kp = kw0 + 16 * (kt0 + tt) + 4 * fq + j;
            const int dlt = qp - kp;
            okv = (kp >= 0) && (kp < Lr) && (dlt <= HW) && (dlt >= -HW);
          }
          ok[tt][j] = okv;
          const float sv = st[tt][j] * scale;
          st[tt][j] = sv;
          if (okv) mloc = fmaxf(mloc, sv);
        }
      mloc = xmax16(mloc);
      mloc = xmax32(mloc);
      const float mnew = fmaxf(m, mloc);
      const float alpha = __expf(m - mnew);
      m = mnew;
      float psum = 0.f;
#pragma unroll
      for (int tt = 0; tt < 2; ++tt)
#pragma unroll
        for (int j = 0; j < 4; ++j) {
          const float pv = ok[tt][j] ? __expf(st[tt][j] - mnew) : 0.f;
          st[tt][j] = pv;
          psum += pv;
        }
      den = den * alpha + psum;
      union { unsigned u[4]; bf16x8 v; } pf;
      pf.u[0] = pack2(st[0][0], st[0][1]);
      pf.u[1] = pack2(st[0][2], st[0][3]);
      pf.u[2] = pack2(st[1][0], st[1][1]);
      pf.u[3] = pack2(st[1][2], st[1][3]);
      const int cb0 = MASK ? (16 * w + 16 * kt0) : (16 * kt0 - c * CHCOLS);
      const int cb1 = cb0 + 16;
#pragma unroll
      for (int dd = 0; dd < NDD; ++dd) {
        const u16* vr = sV + (dd * 16 + fr) * VSTR + 4 * fq;
        union { uint2 h[2]; bf16x8 v; } vf;
        vf.h[0] = *(const uint2*)(vr + cb0);
        vf.h[1] = *(const uint2*)(vr + cb1);
        oacc[dd] = oacc[dd] * alpha;
        oacc[dd] = __builtin_amdgcn_mfma_f32_16x16x32_bf16(vf.v, pf.v, oacc[dd], 0, 0, 0);
      }
    };
    bf16x8 kfa[2][NKK], kfb[2][NKK];
    kload(kfa, 2 * (c * SPC));
    if (SPC > 1) kload(kfb, 2 * (c * SPC) + 2);
#pragma unroll 1
    for (int s2l = 0; s2l < SPC; s2l += 2) {
      {
        const int kt0 = 2 * (c * SPC + s2l);
        f32x4 st[2];
        qk(kfa, st);
        if (s2l + 2 < SPC) kload(kfa, kt0 + 4);
        tail(st, kt0);
      }
      if (s2l + 1 >= SPC) break;
      {
        const int kt0 = 2 * (c * SPC + s2l + 1);
        f32x4 st[2];
        qk(kfb, st);
        if (s2l + 3 < SPC) kload(kfb, kt0 + 4);
        tail(st, kt0);
      }
    }
  }
  den = xsum16(den);
  den = xsum32(den);
  if (has_sink) den += __expf(sink - m);
  const float rden = 1.f / den;
  u16* op = io.o + hd * hstep + (long)qp * io.ostep;
  const u16* gp = io.g ? (io.g + hd * hstep + (long)qp * io.gstep) : nullptr;
#pragma unroll
  for (int dd = 0; dd < NDD; ++dd) {
    const int d0 = dd * 16 + 4 * fq;
    float y0 = oacc[dd][0] * rden, y1 = oacc[dd][1] * rden, y2 = oacc[dd][2] * rden, y3 = oacc[dd][3] * rden;
    if (gp) {
      uint2 gg = *(const uint2*)(gp + d0);
      y0 *= silu(lo2f(gg.x)); y1 *= silu(hi2f(gg.x)); y2 *= silu(lo2f(gg.y)); y3 *= silu(hi2f(gg.y));
    }
    *(uint2*)(op + d0) = make_uint2(pack2(y0, y1), pack2(y2, y3));
  }
  if (io.lse && fq == 0) io.lse[(long)qp * io.lstep] = m + __logf(den);
  }
  __syncthreads();
}

__device__ __forceinline__ void xattn_item(int L, int nb, int item, int grp, const u16* z, int zs, int xq_col, int gx_col, const u16* mkv, u16* cat, int cat_col, char* smem) {
  const int nqb = L / 64;
  const int qb = item % nqb;
  const int rest = item / nqb;
  const int h = rest & 3, bl = rest >> 2;
  const int sq = (grp == 0) ? bl : (8 + (grp - 1) * 4 + bl);
  AttnIO io;
  io.q = z + (size_t)(bl * L) * zs + xq_col + h * 128; io.qstep = zs;
  io.k = mkv + (size_t)(sq * 256) * 1024 + h * 128;
  io.v = mkv + (size_t)(sq * 256) * 1024 + 512 + h * 128; io.kstep = 1024;
  io.o = cat + (size_t)(bl * L) * CATW + cat_col + h * 128; io.ostep = CATW;
  io.g = z + (size_t)(bl * L) * zs + gx_col + h * 128; io.gstep = zs;
  io.lse = nullptr; io.lstep = 0;
  attn_block<128, 16, 2, 128, 144, false>(io, 256, qb * 64, 0, 0.08838834764831845f, nullptr, 0, smem);
}

__global__ void __launch_bounds__(256, 2) mega(P p) {
  cg::grid_group grid = cg::this_grid();
  __shared__ __attribute__((aligned(16))) char smem[65536];
  const int nblk = gridDim.x, bid = blockIdx.x;
  char* ws = p.ws;
  XcdBarrier xb;
  xb.bar = (unsigned*)(ws + OFF_BAR); xb.x = xb_xcc_id(); xb.nloc = 0u; xb.nx = 0u;
  if (__builtin_amdgcn_workitem_id_x() == 0) (void)xb_add(&xb.bar[XB_XCNT(xb.x)], 1u);
  u16* wt_e_in = (u16*)(ws + OFF_WT_E_IN);
  u16* wt_o_in = (u16*)(ws + OFF_WT_O_IN);
  u16* wt_e_out = (u16*)(ws + OFF_WT_E_OUT);
  u16* wt_o_out = (u16*)(ws + OFF_WT_O_OUT);
  u16* wt_e_mkv = (u16*)(ws + OFF_WT_E_MKV);
  u16* wt_o_mkv = (u16*)(ws + OFF_WT_O_MKV);
  u16* mkv_e = (u16*)(ws + OFF_MKV_E);
  u16* mkv_o = (u16*)(ws + OFF_MKV_O);
  u16* hr_a = (u16*)(ws + OFF_HR_A);
  u16* hr_b = (u16*)(ws + OFF_HR_B);
  u16* z = (u16*)(ws + OFF_Z);
  u16* cat = (u16*)(ws + OFF_CAT);
  float* outb = (float*)(ws + OFF_OUT);
  float* rsp = (float*)(ws + OFF_RSP);
  u16* gateA = (u16*)(ws + OFF_OUT);
  u16* gateB = gateA + (size_t)GT * 1024;
  u16* ut = (u16*)(ws + OFF_UT);
  u16* yt = (u16*)(ws + OFF_YT);
  u16* qkvn = (u16*)(ws + OFF_QKVN);
  float* gba = (float*)(ws + OFF_GBA);
  float* of = (float*)(ws + OFF_OF);
  float* ob = (float*)(ws + OFF_OB);
  u16* og = (u16*)(ws + OFF_OG);
  float* lse = (float*)(ws + OFF_LSE);
  u16* xbf = (u16*)(ws + OFF_XB);
  float* rinvb = (float*)(ws + OFF_RINVB);
  u16* memb = (u16*)(ws + OFF_MEMB);
  float* rinvm = (float*)(ws + OFF_RINVM);

  {
    const int n_e_in = 16 * (ZSE / 64), n_o_in = 16 * (ZSO / 64), n_e_out = 40 * 16, n_o_out = 32 * 16, n_mkv = 16 * 16;
    const int n_f = 256 + 512;
    const int n_rp = GT / 4 + 6144 / 4;
    const int total = n_rp + n_e_in + n_o_in + n_e_out + n_o_out + 2 * n_mkv + n_f;
    REP(5) for (int it = bid; it < total; it += nblk) {
      int i = it;
      if (i < GT / 4) { rowprep_item(i, p.xp, xbf, rinvb); continue; }
      i -= GT / 4;
      if (i < 6144 / 4) { if (i < 512) rowprep_item(i, p.memp, memb, rinvm); else rowprep_item(i - 512, p.mems, memb + (size_t)2048 * 1024, rinvm + 2048); continue; }
      i -= 6144 / 4;
      if (i < n_e_in) { wt_tile(p.e_w_in, 9248, p.e_pre_g, wt_e_in, 1024, i & 15, i >> 4, 1, smem); continue; }
      i -= n_e_in;
      if (i < n_o_in) { wt_tile(p.o_w_in, 8448, p.o_pre_g, wt_o_in, 1024, i & 15, i >> 4, 0, smem); continue; }
      i -= n_o_in;
      if (i < n_e_out) { wt_tile(p.e_w_out, 1024, nullptr, wt_e_out, 2560, i % 40, i / 40, 0, smem); continue; }
      i -= n_e_out;
      if (i < n_o_out) { wt_tile(p.o_w_out, 1024, nullptr, wt_o_out, 2048, i % 32, i / 32, 0, smem); continue; }
      i -= n_o_out;
      if (i < n_mkv) { wt_tile(p.e_w_mkv, 1024, p.e_mem_g, wt_e_mkv, 1024, i & 15, i >> 4, 0, smem); continue; }
      i -= n_mkv;
      if (i < n_mkv) { wt_tile(p.o_w_mkv, 1024, p.o_mem_g, wt_o_mkv, 1024, i & 15, i >> 4, 0, smem); continue; }
      i -= n_mkv;
      if (i < 256) { filt_item(p, 2048, i >> 3, i & 7, hr_a, smem); continue; }
      i -= 256;
      filt_item(p, 4096, i >> 3, i & 7, hr_b, smem);
    }
  }
  grid.sync();
  for (int layer = 0; layer < 2; ++layer) {
    Epi e; e.out = layer ? mkv_o : mkv_e; e.ldo = 1024; e.rsp = nullptr; e.L = 1; e.rinv = rinvm;
    gemm_phase<0>(bid, nblk, 24 * 8, 24, memb, 1024, layer ? wt_o_mkv : wt_e_mkv, 1024, e, smem);
  }
  xcd_barrier(xb);

  for (int grp = 0; grp < NGROUP; ++grp) {
    const int L = (grp == 0) ? 2048 : 4096;
    const int nb = GT / L;
    const float* xg = (grp == 0) ? p.xp : (p.xs + (size_t)(grp - 1) * GT * 1024);
    float* dg = p.out + (size_t)grp * GT * 1024;
    const u16* hr = (grp == 0) ? hr_a : hr_b;

    REP(0) {
      Epi e; e.out = z; e.ldo = ZSE; e.rsp = nullptr; e.L = L; e.rinv = rinvb;
      gemm_phase<0>(bid, nblk, 64 * 73, 64, xbf, 1024, wt_e_in, 1024, e, smem);
    }
    xcd_barrier(xb);
    {
      const int n_hy = 256 * 8, n_gd = 256 * 8, n_x = 1024;
      REP(1) for (int it = bid; it < n_hy + n_gd + n_x; it += nblk) {
        int i = it;
        if (i < n_x) { xattn_item(L, nb, i, grp, z, ZSE, E_XQ, E_GX, mkv_e, cat, 2048, smem); continue; }
        i -= n_x;
        if (i < n_gd) { gdn_pre_item(p, L, i >> 3, i & 7, z, qkvn, gba, gateB); continue; }
        i -= n_gd;
        hy_pre_item(p, L, i >> 3, i & 7, z, gateA, ut);
      }
    }
    xcd_barrier(xb);
    REP(4) for (int it = bid; it < 4096; it += nblk) gdn_chunk_item(L, it, qkvn, gba, z, (float*)(ws + OFF_GL), smem);
    xcd_barrier(xb);
    {
      const int n_scan = nb * 32;
      REP(2) {
      if (bid < n_scan) {
        const int ci = bid >> 1, half = bid & 1;
        gdn_cscan_item(L, ci, half, z, (const float*)(ws + OFF_GL), (ci & 1) ? ob : of, smem);
      }
      unsigned* hctr = (unsigned*)(ws + OFF_BAR) + 3600 + grp + 8 * rep_;
      volatile unsigned* slot = (volatile unsigned*)(smem + (2 * L - 1) * 4);
      for (;;) {
        __syncthreads();
        if (__builtin_amdgcn_workitem_id_x() == 0) *slot = atomicAdd(hctr, 1u);
        __syncthreads();
        const unsigned chn = *slot;
        if (chn >= 1024u) break;
        hy_conv_item(L, nb, (int)chn, hr, ut, yt, smem);
      }
      }
    }
    xcd_barrier(xb);
    {
      const int n_hy = 256 * 8, n_gd = GT / 8;
      REP(6) for (int it = bid; it < n_hy + n_gd; it += nblk) {
        if (it < n_hy) hy_post_item(it >> 3, it & 7, yt, gateA, cat);
        else gdn_post_item(p, it - n_hy, of, ob, gateB, cat);
      }
    }
    xcd_barrier(xb);
    REP(0) {
      Epi e; e.out = outb; e.ldo = 1024; e.rsp = rsp; e.L = L; e.rinv = nullptr;
      gemm_phase<2>(bid, nblk, 64 * 8, 64, cat, CATW, wt_e_out, 2560, e, smem);
    }
    xcd_barrier(xb);
    for (int it = bid; it < GT / 4; it += nblk) resid_item<true>(it, xg, outb, rsp, p.e_post_g, dg, xbf, rinvb);
    xcd_barrier(xb);
    REP(0) {
      Epi e; e.out = z; e.ldo = ZSO; e.rsp = nullptr; e.L = L; e.rinv = rinvb;
      gemm_phase<1>(bid, nblk, 64 * 66, 64, xbf, 1024, wt_o_in, 1024, e, smem);
    }
    xcd_barrier(xb);
    {
      const int n_dil = 3072, n_swa = 512, n_x = 1024;
      REP(3) for (int it = bid; it < n_dil + n_swa + n_x; it += nblk) {
        int i = it;
        if (i < n_swa) {
          const int kvh = i & 1, rem = i >> 1;
          const int nqb = L / 64, qb = rem % nqb, bl = rem / nqb;
          const int qh = kvh * 8;
          AttnIO io;
          io.q = z + (size_t)(bl * L) * ZSO + O_DQ + qh * 64; io.qstep = ZSO;
          io.k = z + (size_t)(bl * L) * ZSO + O_DK + kvh * 64;
          io.v = z + (size_t)(bl * L) * ZSO + O_DV + kvh * 64; io.kstep = ZSO;
          io.o = cat + (size_t)(bl * L) * CATW + 512 + qh * 64; io.ostep = CATW;
          io.g = z + (size_t)(bl * L) * ZSO + O_GD + qh * 64; io.gstep = ZSO;
          io.lse = nullptr; io.lstep = 0;
          attn_block<64, 18, 1, 336, 336, true, 8>(io, L, qb * 64, 128, 0.125f, p.swa_sink + qh, 64, smem);
          continue;
        }
        i -= n_swa;
        if (i < n_dil) {
          const int gi = i >> 10, rem = i & 1023;
          const int h = rem & 3, rem2 = rem >> 2;
          const int d = (gi == 0) ? 1 : (gi == 1 ? 4 : 16);
          const int Lr = L / d, nqb = Lr / 64;
          const int qb = rem2 % nqb, rem3 = rem2 / nqb;
          const int r = rem3 % d, bl = rem3 / d;
          const size_t row0 = (size_t)bl * L + r;
          AttnIO io;
          io.q = z + row0 * ZSO + O_CQ + gi * 512 + h * 128; io.qstep = (long)d * ZSO;
          io.k = z + row0 * ZSO + O_CK + gi * 512 + h * 128;
          io.v = z + row0 * ZSO + O_CV + gi * 512 + h * 128; io.kstep = (long)d * ZSO;
          io.o = og + row0 * 1536 + gi * 512 + h * 128; io.ostep = (long)d * 1536;
          io.g = nullptr; io.gstep = 0;
          io.lse = lse + row0 * 12 + gi * 4 + h; io.lstep = (long)d * 12;
          attn_block<128, 10, 1, 208, 208, true>(io, Lr, qb * 64, 64, 0.08838834764831845f, nullptr, 0, smem);
          continue;
        }
        i -= n_dil;
        xattn_item(L, nb, i, grp, z, ZSO, O_XQ, O_GX, mkv_o, cat, 1536, smem);
      }
    }
    xcd_barrier(xb);
    for (int it = bid; it < GT / 4; it += nblk) {
      const int tid = tidx(), lane = tid & 63, w = tid >> 6;
      const int t = it * 4 + w;
      const int h = lane >> 4, d0 = (lane & 15) * 8;
      const float l0 = lse[(size_t)t * 12 + h], l1 = lse[(size_t)t * 12 + 4 + h], l2 = lse[(size_t)t * 12 + 8 + h];
      const float mx = fmaxf(l0, fmaxf(l1, l2));
      float w0 = __expf(l0 - mx), w1 = __expf(l1 - mx), w2 = __expf(l2 - mx);
      const float rs = 1.f / (w0 + w1 + w2);
      w0 *= rs; w1 *= rs; w2 *= rs;
      uint4 a = *(const uint4*)(og + (size_t)t * 1536 + h * 128 + d0);
      uint4 b = *(const uint4*)(og + (size_t)t * 1536 + 512 + h * 128 + d0);
      uint4 c = *(const uint4*)(og + (size_t)t * 1536 + 1024 + h * 128 + d0);
      uint4 g = *(const uint4*)(z + (size_t)t * ZSO + O_GC + h * 128 + d0);
      unsigned au[4] = {a.x, a.y, a.z, a.w}, bu[4] = {b.x, b.y, b.z, b.w}, cu[4] = {c.x, c.y, c.z, c.w}, gu[4] = {g.x, g.y, g.z, g.w};
      unsigned ru[4];
#pragma unroll
      for (int i = 0; i < 4; ++i) {
        const float ylo = (w0 * lo2f(au[i]) + w1 * lo2f(bu[i]) + w2 * lo2f(cu[i])) * silu(lo2f(gu[i]));
        const float yhi = (w0 * hi2f(au[i]) + w1 * hi2f(bu[i]) + w2 * hi2f(cu[i])) * silu(hi2f(gu[i]));
        ru[i] = pack2(ylo, yhi);
      }
      *(uint4*)(cat + (size_t)t * CATW + h * 128 + d0) = make_uint4(ru[0], ru[1], ru[2], ru[3]);
    }
    xcd_barrier(xb);
    REP(0) {
      Epi e; e.out = outb; e.ldo = 1024; e.rsp = rsp; e.L = L; e.rinv = nullptr;
      gemm_phase<2>(bid, nblk, 64 * 8, 64, cat, CATW, wt_o_out, 2048, e, smem);
    }
    if (grp + 1 < NGROUP) {
      const float* xn = p.xs + (size_t)grp * GT * 1024;
      for (int it = nblk - 1 - bid; it < GT / 4; it += nblk) rowprep_item(it, xn, xbf, rinvb);
    }
    xcd_barrier(xb);
    for (int it = bid; it < GT / 4; it += nblk) resid_item<false>(it, dg, outb, rsp, p.o_post_g, dg, nullptr, nullptr);
  }
}

extern "C" void kernel_launch(void* const* d_in, const int* in_sizes, int n_in, void* d_out, int out_size, void* d_ws,
                              size_t ws_size, hipStream_t stream) {
  static int grid_blocks = 0;
  if (!grid_blocks) {
    int dev = 0, cus = 0, per_cu = 0;
    hipGetDevice(&dev);
    hipDeviceGetAttribute(&cus, hipDeviceAttributeMultiprocessorCount, dev);
    hipOccupancyMaxActiveBlocksPerMultiprocessor(&per_cu, mega, 256, 0);
    if (per_cu > 2) per_cu = 2;
    if (per_cu < 1) per_cu = 1;
    grid_blocks = cus * per_cu;
  }
  P p{};
  const float** f = (const float**)&p;
  for (int i = 0; i < 30; ++i) f[i] = (const float*)d_in[i];
  p.out = (float*)d_out;
  p.ws = (char*)d_ws;
  hipMemsetAsync((char*)d_ws + OFF_BAR, 0, 16384, stream);
  void* args[] = {&p};
  hipError_t e = hipLaunchCooperativeKernel((void*)mega, dim3(grid_blocks), dim3(256), args, 0, stream);
  if (e != hipSuccess) fprintf(stderr, "cooperative launch failed: %s (grid %d)\n", hipGetErrorString(e), grid_blocks);
}
```

```cpp
#include <hip/hip_runtime.h>
#include <hip/hip_cooperative_groups.h>
#include <cstdio>
namespace cg = cooperative_groups;

typedef unsigned short u16;
typedef __attribute__((ext_vector_type(8))) short bf16x8;
typedef __attribute__((ext_vector_type(4))) float f32x4;

#define DEVI __device__ __forceinline__
#define EPSF 1e-6f

#ifndef DUPMASK
#define DUPMASK 0
#endif
#define REP(k) for (int rep_ = 0; rep_ < 1 + ((DUPMASK >> (k)) & 1); ++rep_)
constexpr int GT = 16384;
constexpr int NGROUP = 5;
constexpr int ZSE = 9344;
constexpr int ZSO = 8448;
constexpr int CATW = 2560;
constexpr int E_HY = 0, E_GHY = 3072, E_QKV = 4096, E_GG = 7168, E_XQ = 8192, E_GX = 8704, E_BETA = 9216, E_A = 9232;
constexpr int O_CQ = 0, O_CK = 1536, O_CV = 3072, O_GC = 4608, O_DQ = 5120, O_DK = 6144, O_DV = 6272, O_GD = 6400, O_XQ = 7424, O_GX = 7936;

constexpr size_t OFF_WT_E_IN  = 0;
constexpr size_t OFF_WT_O_IN  = OFF_WT_E_IN  + (size_t)ZSE * 1024 * 2;
constexpr size_t OFF_WT_E_OUT = OFF_WT_O_IN  + (size_t)ZSO * 1024 * 2;
constexpr size_t OFF_WT_O_OUT = OFF_WT_E_OUT + (size_t)1024 * 2560 * 2;
constexpr size_t OFF_WT_E_MKV = OFF_WT_O_OUT + (size_t)1024 * 2048 * 2;
constexpr size_t OFF_WT_O_MKV = OFF_WT_E_MKV + (size_t)1024 * 1024 * 2;
constexpr size_t OFF_MKV_E    = OFF_WT_O_MKV + (size_t)1024 * 1024 * 2;
constexpr size_t OFF_MKV_O    = OFF_MKV_E    + (size_t)6144 * 1024 * 2;
constexpr size_t OFF_HR_A     = OFF_MKV_O    + (size_t)6144 * 1024 * 2;
constexpr size_t OFF_HR_B     = OFF_HR_A     + (size_t)1024 * 4096 * 2;
constexpr size_t OFF_Z        = OFF_HR_B     + (size_t)1024 * 8192 * 2;
constexpr size_t OFF_CAT      = OFF_Z        + (size_t)GT * ZSE * 2;
constexpr size_t OFF_OUT      = OFF_CAT      + (size_t)GT * CATW * 2;
constexpr size_t OFF_RSP      = OFF_OUT      + (size_t)GT * 1024 * 4;
constexpr size_t OFF_UT       = OFF_RSP      + (size_t)GT * 16 * 4;
constexpr size_t OFF_YT       = OFF_UT       + (size_t)1024 * GT * 2;
constexpr size_t OFF_QKVN     = OFF_YT       + (size_t)1024 * GT * 2;
constexpr size_t OFF_GBA      = OFF_QKVN     + (size_t)GT * 3072 * 4;
constexpr size_t OFF_OF       = OFF_GBA      + (size_t)GT * 32 * 4;
constexpr size_t OFF_OB       = OFF_OF       + (size_t)GT * 1024 * 4;
constexpr size_t OFF_END      = OFF_OB       + (size_t)GT * 1024 * 4;
constexpr size_t OFF_OG       = OFF_QKVN;
constexpr size_t OFF_LSE      = OFF_OG + (size_t)GT * 1536 * 2;
constexpr size_t OFF_BAR      = OFF_END;
constexpr size_t OFF_XB       = OFF_BAR + 16384;
constexpr size_t OFF_RINVB    = OFF_XB + (size_t)GT * 1024 * 2;
constexpr size_t OFF_MEMB     = OFF_RINVB + (size_t)GT * 4;
constexpr size_t OFF_RINVM    = OFF_MEMB + (size_t)6144 * 1024 * 2;
static_assert(OFF_RINVM + 6144 * 4 <= (size_t)1 << 30, "workspace too large");

struct P {
  const float *xp, *xs, *memp, *mems;
  const float *e_pre_g, *e_post_g, *e_w_in, *e_w_out, *hy_conv_w, *hy_conv_b, *hy_w1, *hy_b1, *hy_w2, *hy_b2, *hy_w3,
      *hy_freq, *hy_skip, *gdn_conv_w, *gdn_A_log, *gdn_dt_bias, *gdn_norm_g, *e_mem_g, *e_w_mkv;
  const float *o_pre_g, *o_post_g, *o_w_in, *o_w_out, *swa_sink, *o_mem_g, *o_w_mkv;
  float* out;
  char* ws;
};

DEVI int tidx() { int t = __builtin_amdgcn_workitem_id_x(); asm volatile("" : "+v"(t)); return t; }
DEVI u16 f2bf(float f) {
  unsigned u = __float_as_uint(f);
  u += 0x7fffu + ((u >> 16) & 1u);
  return (u16)(u >> 16);
}
DEVI float bf2f(u16 h) { return __uint_as_float(((unsigned)h) << 16); }
DEVI unsigned pack2(float a, float b) { return (unsigned)f2bf(a) | ((unsigned)f2bf(b) << 16); }
DEVI float lo2f(unsigned u) { return __uint_as_float(u << 16); }
DEVI float hi2f(unsigned u) { return __uint_as_float(u & 0xffff0000u); }
DEVI float silu(float x) { return x / (1.f + __expf(-x)); }
DEVI void fsincos(float x, float* sn, float* cs) {
  const float k = rintf(x * 0.15915494309189535f);
  float r = fmaf(-k, 6.28125f, x);
  r = fmaf(-k, 0.0019353071795864769f, r);
  *sn = __sinf(r);
  *cs = __cosf(r);
}
#define DPP_ADD(v, ctrl) ((v) + __int_as_float(__builtin_amdgcn_mov_dpp(__float_as_int(v), (ctrl), 0xf, 0xf, true)))
DEVI float wave_sum(float v) {
  v = DPP_ADD(v, 0xB1);
  v = DPP_ADD(v, 0x4E);
  v = DPP_ADD(v, 0x141);
  v = DPP_ADD(v, 0x140);
  const float r0 = __int_as_float(__builtin_amdgcn_readlane(__float_as_int(v), 0));
  const float r1 = __int_as_float(__builtin_amdgcn_readlane(__float_as_int(v), 16));
  const float r2 = __int_as_float(__builtin_amdgcn_readlane(__float_as_int(v), 32));
  const float r3 = __int_as_float(__builtin_amdgcn_readlane(__float_as_int(v), 48));
  return (r0 + r1) + (r2 + r3);
}


DEVI float xmax16(float v) { auto r = __builtin_amdgcn_permlane16_swap(__float_as_uint(v), __float_as_uint(v), false, false); return fmaxf(__uint_as_float(r[0]), __uint_as_float(r[1])); }
DEVI float xmax32(float v) { auto r = __builtin_amdgcn_permlane32_swap(__float_as_uint(v), __float_as_uint(v), false, false); return fmaxf(__uint_as_float(r[0]), __uint_as_float(r[1])); }
DEVI float xsum16(float v) { auto r = __builtin_amdgcn_permlane16_swap(__float_as_uint(v), __float_as_uint(v), false, false); return __uint_as_float(r[0]) + __uint_as_float(r[1]); }
DEVI float xsum32(float v) { auto r = __builtin_amdgcn_permlane32_swap(__float_as_uint(v), __float_as_uint(v), false, false); return __uint_as_float(r[0]) + __uint_as_float(r[1]); }
DEVI float row_sum16(float v) {
  v = DPP_ADD(v, 0xB1); v = DPP_ADD(v, 0x4E); v = DPP_ADD(v, 0x141); v = DPP_ADD(v, 0x140);
  return v;
}

#define XB_TMO      128
#define XB_XCNT(j)  (256  + 64 * (j))
#define XB_XSUB(j)  (1280 + 64 * (j))
#define XB_XGEN(j)  (2304 + 64 * (j))
#define XB_TOP      3328
#define XB_TOPGEN   3392
#define XCD_BAR_WORDS 3456
#define XB_SPIN_CAP (1u << 22)
DEVI unsigned xb_ld(unsigned* p) { return __hip_atomic_load(p, __ATOMIC_RELAXED, __HIP_MEMORY_SCOPE_AGENT); }
DEVI unsigned xb_add(unsigned* p, unsigned v) { return __hip_atomic_fetch_add(p, v, __ATOMIC_RELAXED, __HIP_MEMORY_SCOPE_AGENT); }
DEVI unsigned xb_xcc_id() { return (unsigned)__builtin_amdgcn_s_getreg((3 << 11) | 20) & 0xFu; }
#define XB_SPIN(cond, bar) do { unsigned _sp = 0; while (cond) { __builtin_amdgcn_s_sleep(1); \
    if ((++_sp & 255u) == 0u) { if (xb_ld(&(bar)[XB_TMO])) break; if (_sp > XB_SPIN_CAP) { atomicAdd(&(bar)[XB_TMO], 1u); break; } } } } while (0)
struct XcdBarrier { unsigned* bar; unsigned x; unsigned nloc; unsigned nx; };
DEVI void xcd_barrier_complete(unsigned* bar, unsigned x, unsigned& nloc, unsigned& nx) {
  const unsigned G = gridDim.x;
  unsigned sum, cnt, mine, sp = 0u;
  for (;;) {
    sum = 0u; cnt = 0u; mine = 0u;
#pragma unroll
    for (unsigned j = 0; j < 16; ++j) { const unsigned c = xb_ld(&bar[XB_XCNT(j)]); sum += c; cnt += (c > 0u) ? 1u : 0u; mine = (j == x) ? c : mine; }
    if (sum == G) break;
    __builtin_amdgcn_s_sleep(1);
    if ((++sp & 255u) == 0u) { if (xb_ld(&bar[XB_TMO])) break; if (sp > XB_SPIN_CAP) { atomicAdd(&bar[XB_TMO], 1u); break; } }
  }
  nloc = mine > 0u ? mine : 1u; nx = cnt > 0u ? cnt : 1u;
}
DEVI void xcd_barrier(XcdBarrier& b) {
  asm volatile("s_waitcnt vmcnt(0)" ::: "memory");
  __syncthreads();
  if (__builtin_amdgcn_workitem_id_x() == 0) {
    unsigned* bar = b.bar;
    __builtin_amdgcn_s_waitcnt(0);
    if (b.nloc == 0u) xcd_barrier_complete(bar, b.x, b.nloc, b.nx);
    const unsigned nloc = b.nloc, nx = b.nx;
    const unsigned old = xb_add(&bar[XB_XSUB(b.x)], 1u);
    const unsigned gen = old / nloc;
    if (old + 1u == (gen + 1u) * nloc) {
      __builtin_amdgcn_fence(__ATOMIC_RELEASE, "agent");
      asm volatile("s_waitcnt vmcnt(0)" ::: "memory");
      const unsigned og = xb_add(&bar[XB_TOP], 1u);
      const unsigned tg = og / nx;
      if (og + 1u == (tg + 1u) * nx) xb_add(&bar[XB_TOPGEN], 1u);
      else XB_SPIN(xb_ld(&bar[XB_TOPGEN]) == tg, bar);
      __builtin_amdgcn_fence(__ATOMIC_ACQUIRE, "agent");
      xb_add(&bar[XB_XGEN(b.x)], 1u);
      asm volatile("s_waitcnt vmcnt(0)" ::: "memory");
    } else {
      XB_SPIN(xb_ld(&bar[XB_XGEN(b.x)]) == gen, bar);
      __builtin_amdgcn_fence(__ATOMIC_ACQUIRE, "agent");
      asm volatile("s_waitcnt vmcnt(0)" ::: "memory");
    }
  }
  __syncthreads();
}

struct Epi { void* out; int ldo; float* rsp; int L; const float* rinv; };

template <int EPI>
__device__ __forceinline__ void gemm_phase(int first, int stride, int ntiles, int tmc, const u16* Abase, int lda, const u16* Wbase, int K, const Epi& e, char* smem) {
  const int tid = tidx(), lane = tid & 63, w = tid >> 6, wr = w >> 1, wc = w & 1, fr = lane & 15, fq = lane >> 4;
  const int gr = tid >> 2, gp = tid & 3;
  int it = first;
  if (it >= ntiles) return;
  const u16* Ab = Abase + (size_t)((it % tmc) * 256 + gr) * lda + gp * 8;
  const u16* Wp = Wbase + (size_t)((it / tmc) * 128 + gr) * K + gp * 8;
  const size_t a64 = (size_t)64 * lda, w64 = (size_t)64 * K;
  char* stA = smem + gr * 64 + ((gp ^ (((gr >> 3) & 1) * 3)) * 16);
  char* stB = stA + 16384;
  const int cho = (fq ^ ((fr >> 3) * 3)) * 16;
  const char* rdA = smem + (wr * 128 + fr) * 64 + cho;
  const char* rdB = smem + 16384 + (wc * 64 + fr) * 64 + cho;
  uint4 ra0_0, ra0_1, ra0_2, ra0_3, rb0_0, rb0_1, ra1_0, ra1_1, ra1_2, ra1_3, rb1_0, rb1_1;
  const int nk = K / 32;
#define G_LOAD(u, k0) ra##u##_0 = *(const uint4*)(Ab + (k0)); ra##u##_1 = *(const uint4*)(Ab + a64 + (k0)); ra##u##_2 = *(const uint4*)(Ab + 2 * a64 + (k0)); ra##u##_3 = *(const uint4*)(Ab + 3 * a64 + (k0)); \
                      rb##u##_0 = *(const uint4*)(Wp + (k0)); rb##u##_1 = *(const uint4*)(Wp + w64 + (k0));
#define G_STORE(u, stg) { char* pa_ = stA + (stg) * 24576; char* pb_ = stB + (stg) * 24576; \
    *(uint4*)pa_ = ra##u##_0; *(uint4*)(pa_ + 4096) = ra##u##_1; *(uint4*)(pa_ + 8192) = ra##u##_2; *(uint4*)(pa_ + 12288) = ra##u##_3; \
    *(uint4*)pb_ = rb##u##_0; *(uint4*)(pb_ + 4096) = rb##u##_1; }
#define G_COMPUTE(stg) { const char* qa_ = rdA + (stg) * 24576; const char* qb_ = rdB + (stg) * 24576; bf16x8 fb_[4]; \
    _Pragma("unroll") for (int ni = 0; ni < 4; ++ni) fb_[ni] = *(const bf16x8*)(qb_ + ni * 1024); \
    _Pragma("unroll") for (int mh = 0; mh < 2; ++mh) { bf16x8 fa_[4]; \
      _Pragma("unroll") for (int mi = 0; mi < 4; ++mi) fa_[mi] = *(const bf16x8*)(qa_ + (mh * 4 + mi) * 1024); \
      __builtin_amdgcn_s_setprio(1); \
      _Pragma("unroll") for (int mi = 0; mi < 4; ++mi) _Pragma("unroll") for (int ni = 0; ni < 4; ++ni) \
        acc[mh * 4 + mi][ni] = __builtin_amdgcn_mfma_f32_16x16x32_bf16(fb_[ni], fa_[mi], acc[mh * 4 + mi][ni], 0, 0, 0); \
      __builtin_amdgcn_s_setprio(0); } }
  G_LOAD(0, 0) G_LOAD(1, 32)
#pragma unroll 1
  for (;;) {
  const int m0 = (it % tmc) * 256, n0 = (it / tmc) * 128;
  f32x4 acc[8][4];
#pragma unroll
  for (int i = 0; i < 8; ++i)
#pragma unroll
    for (int j = 0; j < 4; ++j) acc[i][j] = (f32x4){0.f, 0.f, 0.f, 0.f};
  G_STORE(0, 0)
  G_LOAD(0, 64)
  __syncthreads();
#pragma unroll 1
  for (int kt0 = 0; kt0 < nk; kt0 += 2) {
    G_STORE(1, 1)
    if (kt0 + 3 < nk) { const int k0 = (kt0 + 3) * 32; G_LOAD(1, k0) }
    G_COMPUTE(0)
    __syncthreads();
    if (kt0 + 2 < nk) G_STORE(0, 0)
    if (kt0 + 4 < nk) { const int k0 = (kt0 + 4) * 32; G_LOAD(0, k0) }
    G_COMPUTE(1)
    __syncthreads();
  }
  const int itn = it + stride;
  if (itn < ntiles) {
    Ab = Abase + (size_t)((itn % tmc) * 256 + gr) * lda + gp * 8;
    Wp = Wbase + (size_t)((itn / tmc) * 128 + gr) * K + gp * 8;
    G_LOAD(0, 0) G_LOAD(1, 32)
  }
  if (EPI == 0 || EPI == 1) {
    u16* out = (u16*)e.out;
    const int cb = n0 + wc * 64;
    int ropemode = 0;
    if (EPI == 1) {
      if (cb < 3072 && (cb & 127) == 0) ropemode = 1;
      else if (cb >= O_DQ && cb < O_DV) ropemode = 2;
    }
#pragma unroll
    for (int mi = 0; mi < 8; ++mi) {
      const int rl = wr * 128 + mi * 16 + fr;
      const int row = m0 + rl;
      const float rv = e.rinv[row];
      f32x4 v[4];
#pragma unroll
      for (int ni = 0; ni < 4; ++ni) v[ni] = acc[mi][ni] * rv;
      if (EPI == 1 && ropemode != 0) {
        const float pos = (float)(row % e.L);
        if (ropemode == 1) {
#pragma unroll
          for (int j = 0; j < 4; ++j) {
            const int i = fq * 4 + j;
            const float inv = __expf(-13.122363377404328f * (float)i * (1.f / 16.f));
            float sn, cs;
            fsincos(pos * inv, &sn, &cs);
            const float x1 = v[0][j], x2 = v[1][j];
            v[0][j] = x1 * cs - x2 * sn;
            v[1][j] = x2 * cs + x1 * sn;
          }
        } else {
#pragma unroll
          for (int j = 0; j < 4; ++j) {
            const int i = (fq & 1) * 4 + j;
            const float inv = __expf(-13.122363377404328f * (float)i * (1.f / 8.f));
            float sn, cs;
            fsincos(pos * inv, &sn, &cs);
            const float mine = v[0][j];
            const float other = __shfl_xor(mine, 32);
            v[0][j] = (fq < 2) ? (mine * cs - other * sn) : (mine * cs + other * sn);
          }
        }
      }
#pragma unroll
      for (int np = 0; np < 2; ++np) {
        uint2 a = make_uint2(pack2(v[2 * np][0], v[2 * np][1]), pack2(v[2 * np][2], v[2 * np][3]));
        uint2 b = make_uint2(pack2(v[2 * np + 1][0], v[2 * np + 1][1]), pack2(v[2 * np + 1][2], v[2 * np + 1][3]));
        auto r0 = __builtin_amdgcn_permlane16_swap(a.x, b.x, false, false);
        auto r1 = __builtin_amdgcn_permlane16_swap(a.y, b.y, false, false);
        const int col = cb + (2 * np + (fq & 1)) * 16 + (fq >> 1) * 8;
        *(uint4*)(out + (size_t)row * e.ldo + col) = make_uint4(r0[0], r1[0], r0[1], r1[1]);
      }
    }
  } else {
    float* out = (float*)e.out;
    const int slot = (n0 >> 7) * 2 + wc;
#pragma unroll
    for (int mi = 0; mi < 8; ++mi) {
      const int row = m0 + wr * 128 + mi * 16 + fr;
      float sq = 0.f;
#pragma unroll
      for (int ni = 0; ni < 4; ++ni) {
        const int col = n0 + wc * 64 + ni * 16 + fq * 4;
        f32x4 v = acc[mi][ni];
        sq += v[0] * v[0] + v[1] * v[1] + v[2] * v[2] + v[3] * v[3];
        *(float4*)(out + (size_t)row * e.ldo + col) = make_float4(v[0], v[1], v[2], v[3]);
      }
      sq = xsum16(sq);
      sq = xsum32(sq);
      if (fq == 0) e.rsp[(size_t)row * 16 + slot] = sq;
    }
  }
  if (itn >= ntiles) break;
  it = itn;
  }
#undef G_COMPUTE
#undef G_STORE
#undef G_LOAD
}

__device__ __forceinline__ void rowprep_item(int item, const float* src, u16* dst, float* rinv) {
  const int tid = tidx(), lane = tid & 63, w = tid >> 6;
  const int row = item * 4 + w;
  float sq = 0.f;
#pragma unroll
  for (int i = 0; i < 4; ++i) {
    const int col = i * 256 + lane * 4;
    const float4 x = *(const float4*)(src + (size_t)row * 1024 + col);
    sq += x.x * x.x + x.y * x.y + x.z * x.z + x.w * x.w;
    *(uint2*)(dst + (size_t)row * 1024 + col) = make_uint2(pack2(x.x, x.y), pack2(x.z, x.w));
  }
  sq = wave_sum(sq);
  if (lane == 0) rinv[row] = rsqrtf(sq * (1.f / 1024.f) + EPSF);
}

DEVI int srccol_even(int n) {
  if (n < 8192) return n;
  if (n < 9216) return n + 32;
  if (n < 9248) return n - 1024;
  return -1;
}
__device__ __forceinline__ void wt_tile(const float* src, int Nsrc, const float* gain, u16* dst, int K, int kt, int nt, int evenmap, char* smem) {
  float (*tile)[65] = (float (*)[65])smem;
  const int tid = tidx(), r = tid >> 6, c = tid & 63;
  const int n = nt * 64 + c;
  const int sc = evenmap ? srccol_even(n) : n;
#pragma unroll
  for (int rr = r; rr < 64; rr += 4) {
    const int k = kt * 64 + rr;
    float v = 0.f;
    if (sc >= 0) v = src[(size_t)k * Nsrc + sc] * (gain ? gain[k] : 1.f);
    tile[rr][c] = v;
  }
  __syncthreads();
  for (int rr = r; rr < 64; rr += 4) {
    const int nn = nt * 64 + rr;
    const int k = kt * 64 + c;
    dst[(size_t)nn * K + k] = f2bf(tile[c][rr]);
  }
  __syncthreads();
}

__device__ __forceinline__ void filt_item(const P& p, int L, int pc, int cc, u16* Hr, char* smem) {
  float (*semb)[33] = (float (*)[33])smem;
  float (*sh1)[65] = (float (*)[65])(smem + 64 * 33 * 4);
  float (*sh2)[65] = (float (*)[65])(smem + 64 * 33 * 4 + 64 * 65 * 4);
  const int tid = tidx();
  for (int idx = tid; idx < 64 * 17; idx += 256) {
    const int i = idx / 17, b = idx % 17;
    const int t = pc * 64 + i;
    if (b == 16) {
      semb[i][0] = (float)t / (float)(L - 1);
    } else {
      const float f = 1e-4f + (float)b * ((15.f - 1e-4f) / 15.f);
      const float wv = (6.283185307179586f / (float)L) * (float)t;
      float sn, cs;
      fsincos(f * wv, &sn, &cs);
      semb[i][1 + b] = cs;
      semb[i][17 + b] = -sn;
    }
  }
  __syncthreads();
  {
    const int hh = tid & 63, ig = tid >> 6;
    const float fr_ = p.hy_freq[hh], b1 = p.hy_b1[hh];
    float a16[16];
#pragma unroll
    for (int r = 0; r < 16; ++r) a16[r] = b1;
    const float* wp = p.hy_w1 + hh;
#pragma unroll 1
    for (int e0 = 0; e0 < 33; e0 += 11) {
      float wv[11];
#pragma unroll
      for (int q = 0; q < 11; ++q) wv[q] = wp[(e0 + q) * 64];
#pragma unroll
      for (int q = 0; q < 11; ++q)
#pragma unroll
        for (int r = 0; r < 16; ++r) a16[r] += semb[ig * 16 + r][e0 + q] * wv[q];
    }
#pragma unroll
    for (int r = 0; r < 16; ++r) { float sn_, cs_; fsincos(fr_ * a16[r], &sn_, &cs_); sh1[ig * 16 + r][hh] = sn_; }
  }
  __syncthreads();
  {
    const int hh = tid & 63, ig = tid >> 6;
    const float fr_ = p.hy_freq[hh], b2 = p.hy_b2[hh];
    float a16[16];
#pragma unroll
    for (int r = 0; r < 16; ++r) a16[r] = b2;
    const float* wp = p.hy_w2 + hh;
#pragma unroll 1
    for (int k0 = 0; k0 < 64; k0 += 8) {
      float wv[8];
#pragma unroll
      for (int q = 0; q < 8; ++q) wv[q] = wp[(k0 + q) * 64];
#pragma unroll
      for (int q = 0; q < 8; ++q)
#pragma unroll
        for (int r = 0; r < 16; ++r) a16[r] += sh1[ig * 16 + r][k0 + q] * wv[q];
    }
#pragma unroll
    for (int r = 0; r < 16; ++r) { float sn_, cs_; fsincos(fr_ * a16[r], &sn_, &cs_); sh2[ig * 16 + r][hh] = sn_; }
  }
  __syncthreads();
  {
    const int c = cc * 256 + tid;
    const int ch = c & 1023;
    const bool bwd = c >= 1024;
    const float delta = 3.0701134573253946f + (float)ch * ((15.350567286626973f - 3.0701134573253946f) / 1023.f);
    const float skip = p.hy_skip[ch];
    u16* hr = Hr + (size_t)ch * (2 * L);
#pragma unroll 1
    for (int i0 = 0; i0 < 64; i0 += 8) {
      float acc8[8];
#pragma unroll
      for (int ii = 0; ii < 8; ++ii) acc8[ii] = 0.f;
      const float* wp = p.hy_w3 + c;
#pragma unroll 1
      for (int k0 = 0; k0 < 64; k0 += 8) {
        float wv[8];
#pragma unroll
        for (int q = 0; q < 8; ++q) wv[q] = wp[(size_t)(k0 + q) * 2048];
#pragma unroll
        for (int q = 0; q < 8; ++q)
#pragma unroll
          for (int ii = 0; ii < 8; ++ii) acc8[ii] += sh2[i0 + ii][k0 + q] * wv[q];
      }
#pragma unroll
      for (int ii = 0; ii < 8; ++ii) {
        const int t = pc * 64 + i0 + ii;
        float s = acc8[ii];
        const float tt = (float)t / (float)(L - 1);
        s *= __expf(-tt * delta);
        if (!bwd) {
          if (t == 0) s += skip;
          hr[L - 1 - t] = f2bf(s);
        } else if (t > 0) {
          hr[L - 1 + t] = f2bf(s);
        }
      }
    }
    if (bwd && pc == 0) hr[2 * L - 1] = 0;
  }
  __syncthreads();
}

__device__ __forceinline__ void hy_pre_item(const P& p, int L, int tt, int cq, const u16* z, u16* cat, u16* ut) {
  const int tid = tidx(), cg = tid & 31, tr = tid >> 5;
  const int c0 = cq * 128 + cg * 4;
  const int t0 = tt * 64 + tr * 8;
  float w[3][3][4], b[3][4];
#pragma unroll
  for (int s = 0; s < 3; ++s) {
#pragma unroll
    for (int j = 0; j < 3; ++j) {
      const float4 a = *(const float4*)(p.hy_conv_w + j * 3072 + s * 1024 + c0);
      w[s][j][0] = a.x; w[s][j][1] = a.y; w[s][j][2] = a.z; w[s][j][3] = a.w;
    }
    const float4 a = *(const float4*)(p.hy_conv_b + s * 1024 + c0);
    b[s][0] = a.x; b[s][1] = a.y; b[s][2] = a.z; b[s][3] = a.w;
  }
  uint2 prev[3], cur[3], nxt[3];
#pragma unroll
  for (int s = 0; s < 3; ++s) {
    prev[s] = ((t0 % L) > 0) ? *(const uint2*)(z + (size_t)(t0 - 1) * ZSE + E_HY + s * 1024 + c0) : make_uint2(0, 0);
    cur[s] = *(const uint2*)(z + (size_t)t0 * ZSE + E_HY + s * 1024 + c0);
  }
  unsigned up[4][4];
#pragma unroll
  for (int r = 0; r < 8; ++r) {
    const int t = t0 + r;
    const bool hasn = (t % L) < L - 1;
    float uc[3][4];
#pragma unroll
    for (int s = 0; s < 3; ++s) {
      nxt[s] = hasn ? *(const uint2*)(z + (size_t)(t + 1) * ZSE + E_HY + s * 1024 + c0) : make_uint2(0, 0);
      uc[s][0] = w[s][0][0] * lo2f(prev[s].x) + w[s][1][0] * lo2f(cur[s].x) + w[s][2][0] * lo2f(nxt[s].x) + b[s][0];
      uc[s][1] = w[s][0][1] * hi2f(prev[s].x) + w[s][1][1] * hi2f(cur[s].x) + w[s][2][1] * hi2f(nxt[s].x) + b[s][1];
      uc[s][2] = w[s][0][2] * lo2f(prev[s].y) + w[s][1][2] * lo2f(cur[s].y) + w[s][2][2] * lo2f(nxt[s].y) + b[s][2];
      uc[s][3] = w[s][0][3] * hi2f(prev[s].y) + w[s][1][3] * hi2f(cur[s].y) + w[s][2][3] * hi2f(nxt[s].y) + b[s][3];
      prev[s] = cur[s];
      cur[s] = nxt[s];
    }
    const uint2 g2 = *(const uint2*)(z + (size_t)t * ZSE + E_GHY + c0);
    *(uint2*)(cat + (size_t)t * 1024 + c0) = make_uint2(pack2(uc[0][0] * silu(lo2f(g2.x)), uc[0][1] * silu(hi2f(g2.x))),
                                                        pack2(uc[0][2] * silu(lo2f(g2.y)), uc[0][3] * silu(hi2f(g2.y))));
#pragma unroll
    for (int e2 = 0; e2 < 4; ++e2) {
      const unsigned hb = (unsigned)f2bf(uc[2][e2] * uc[1][e2]);
      if (r & 1) up[e2][r >> 1] |= hb << 16; else up[e2][r >> 1] = hb;
    }
  }
#pragma unroll
  for (int e2 = 0; e2 < 4; ++e2)
    *(uint4*)(ut + (size_t)(c0 + e2) * GT + t0) = make_uint4(up[e2][0], up[e2][1], up[e2][2], up[e2][3]);
}

__device__ __forceinline__ void hy_post_item(int tt, int cq, const u16* yt, const u16* gateA, u16* cat) {
  const int tid = tidx(), cg = tid & 31, tr = tid >> 5;
  const int c0 = cq * 128 + cg * 4;
  const int t0 = tt * 64 + tr * 8;
  unsigned yw[4][4];
#pragma unroll
  for (int e2 = 0; e2 < 4; ++e2) {
    const uint4 v = *(const uint4*)(yt + (size_t)(c0 + e2) * GT + t0);
    yw[e2][0] = v.x; yw[e2][1] = v.y; yw[e2][2] = v.z; yw[e2][3] = v.w;
  }
#pragma unroll
  for (int r = 0; r < 8; ++r) {
    u16* q = cat + (size_t)(t0 + r) * CATW + c0;
    const uint2 g = *(const uint2*)(gateA + (size_t)(t0 + r) * 1024 + c0);
    float y[4];
#pragma unroll
    for (int e2 = 0; e2 < 4; ++e2) y[e2] = (r & 1) ? hi2f(yw[e2][r >> 1]) : lo2f(yw[e2][r >> 1]);
    *(uint2*)q = make_uint2(pack2(lo2f(g.x) * y[0], hi2f(g.x) * y[1]), pack2(lo2f(g.y) * y[2], hi2f(g.y) * y[3]));
  }
}

__device__ __forceinline__ void hy_conv_item(int L, int nb, int ch, const u16* Hr, const u16* ut, u16* yt, char* smem) {
  unsigned* w0 = (unsigned*)smem;
  unsigned* w1 = w0 + L;
  u16* sU = (u16*)(w1 + L);
  constexpr int DL = 1024;
  const int S = 16 / nb;
  const int tid = tidx(), lane = tid & 63, w = tid >> 6, fr = lane & 15, fq = lane >> 4;
  {
    const u16* hr = Hr + (size_t)ch * 2 * L;
    const unsigned* hw = (const unsigned*)hr;
#pragma unroll 8
    for (int i = tid; i < L; i += 256) {
      const unsigned a = hw[i];
      const unsigned nx = (i + 1 < L) ? hw[i + 1] : 0u;
      w0[i] = a;
      if (i + 1 < L) w1[i] = (a >> 16) | (nx << 16);
    }
    const uint4* src = (const uint4*)(ut + (size_t)ch * GT);
    const int cpr = L / 8;
#pragma unroll
    for (int idx = tid; idx < GT / 8; idx += 256) {
      const int b = idx / cpr, q = idx % cpr;
      const int key = (b * S + ((q * 8) >> 10)) & 15;
      ((uint4*)sU)[b * cpr + (q ^ key)] = src[idx];
    }
  }
  __syncthreads();
  const int cs = fr / nb, cb = fr % nb;
  const int xl = L - 1 - fr + 8 * fq;
  const unsigned* wb = (xl & 1) ? (w1 + ((xl - 1) >> 1)) : (w0 + (xl >> 1));
  const uint4* urow = (const uint4*)sU + cb * (L / 8);
  const int mstart = -(S - 1) * DL;
#pragma unroll 1
  for (int pass = 0; pass < 2; ++pass) {
    const int n0 = (pass * 4 + w) * 128;
    f32x4 acc[8];
#pragma unroll
    for (int i = 0; i < 8; ++i) acc[i] = (f32x4){0.f, 0.f, 0.f, 0.f};
    union AF { unsigned u[4]; bf16x8 v; };
    AF ring[8];
#pragma unroll
    for (int i = 0; i < 8; ++i) {
      const unsigned* src = wb - ((n0 - mstart + 16 * i) >> 1);
      ring[i].u[0] = src[0]; ring[i].u[1] = src[1]; ring[i].u[2] = src[2]; ring[i].u[3] = src[3];
    }
#pragma unroll 1
    for (int m0 = mstart; m0 < L; m0 += 128) {
#pragma unroll
      for (int j = 0; j < 4; ++j) {
        const int mm = m0 + 32 * j;
        const int mb = mm + cs * DL;
        bf16x8 bfrag = {0, 0, 0, 0, 0, 0, 0, 0};
        if (mb >= 0 && mb < L) {
          const int mp = mb + 8 * fq;
          const int q = mp >> 3;
          const int key = (cb * S + (mp >> 10)) & 15;
          union { uint4 q4; bf16x8 v; } t;
          t.q4 = urow[q ^ key];
          bfrag = t.v;
        }
#pragma unroll
        for (int i = 0; i < 8; ++i)
          acc[i] = __builtin_amdgcn_mfma_f32_16x16x32_bf16(ring[(i - 2 * j) & 7].v, bfrag, acc[i], 0, 0, 0);
        if (mm + 32 < L) {
          const unsigned* s0 = wb - ((n0 - mm - 32) >> 1);
          AF& r0 = ring[(0 - 2 * (j + 1)) & 7];
          AF& r1 = ring[(1 - 2 * (j + 1)) & 7];
          r0.u[0] = s0[0]; r0.u[1] = s0[1]; r0.u[2] = s0[2]; r0.u[3] = s0[3];
          r1.u[0] = s0[-8]; r1.u[1] = s0[-7]; r1.u[2] = s0[-6]; r1.u[3] = s0[-5];
        }
      }
    }
#pragma unroll
    for (int i = 0; i < 8; ++i) {
      const int n = cs * DL + n0 + 16 * i + fq * 4;
      *(uint2*)(yt + (size_t)ch * GT + cb * L + n) = make_uint2(pack2(acc[i][0], acc[i][1]), pack2(acc[i][2], acc[i][3]));
    }
  }
  __syncthreads();
}

__device__ __forceinline__ void gdn_pre_item(const P& p, int L, int tt, int h, const u16* z, u16* qkvn, float* gba, u16* cat) {
  const int tid = tidx(), lane = tid & 63, w = tid >> 6;
  float cw[3][5][2];
#pragma unroll
  for (int s = 0; s < 3; ++s)
#pragma unroll
    for (int j = 0; j < 5; ++j) {
      cw[s][j][0] = p.gdn_conv_w[j * 3072 + s * 1024 + h * 128 + 2 * lane];
      cw[s][j][1] = p.gdn_conv_w[j * 3072 + s * 1024 + h * 128 + 2 * lane + 1];
    }
  const int t0 = tt * 64 + w * 16;
  const int seq0 = (t0 / L) * L;
  auto ld = [&](int t, int s) -> unsigned {
    if (t < seq0 || t >= seq0 + L) return 0u;
    return *(const unsigned*)(z + (size_t)t * ZSE + E_QKV + s * 1024 + h * 128 + 2 * lane);
  };
  unsigned win[3][5];
#pragma unroll
  for (int s = 0; s < 3; ++s) {
    win[s][0] = ld(t0 - 2, s);
    win[s][1] = ld(t0 - 1, s);
    win[s][2] = ld(t0, s);
    win[s][3] = ld(t0 + 1, s);
    win[s][4] = 0;
  }
#pragma unroll
  for (int r = 0; r < 16; ++r) {
    const int t = t0 + r;
    float y[3][2];
#pragma unroll
    for (int s = 0; s < 3; ++s) {
      win[s][4] = ld(t + 2, s);
      float a0 = 0.f, a1 = 0.f;
#pragma unroll
      for (int j = 0; j < 5; ++j) {
        a0 += lo2f(win[s][j]) * cw[s][j][0];
        a1 += hi2f(win[s][j]) * cw[s][j][1];
      }
      y[s][0] = silu(a0);
      y[s][1] = silu(a1);
#pragma unroll
      for (int j = 0; j < 4; ++j) win[s][j] = win[s][j + 1];
    }
    const float ssq = wave_sum(y[0][0] * y[0][0] + y[0][1] * y[0][1]);
    const float ssk = wave_sum(y[1][0] * y[1][0] + y[1][1] * y[1][1]);
    const float rq = rsqrtf(ssq + EPSF) * 0.08838834764831845f;
    const float rk = rsqrtf(ssk + EPSF);
    u16* dst = qkvn + ((size_t)t * 8 + h) * 384 + 2 * lane;
    *(unsigned*)dst = pack2(y[0][0] * rq, y[0][1] * rq);
    *(unsigned*)(dst + 128) = pack2(y[1][0] * rk, y[1][1] * rk);
    *(unsigned*)(dst + 256) = pack2(y[2][0], y[2][1]);
    {
      const unsigned gg = *(const unsigned*)(z + (size_t)t * ZSE + E_GG + h * 128 + 2 * lane);
      *(unsigned*)(cat + (size_t)t * 1024 + h * 128 + 2 * lane) = pack2(silu(lo2f(gg)), silu(hi2f(gg)));
    }
  }
  if (tid < 128) {
    const int t = tt * 64 + (tid >> 1), dir = tid & 1;
    const float zb = bf2f(z[(size_t)t * ZSE + E_BETA + dir * 8 + h]);
    const float za = bf2f(z[(size_t)t * ZSE + E_A + dir * 8 + h]);
    const float beta = 1.f / (1.f + __expf(-zb));
    const float xx = za + p.gdn_dt_bias[dir * 8 + h];
    const float sp = (xx > 20.f) ? xx : log1pf(__expf(xx));
    const float gl = -__expf(p.gdn_A_log[dir * 8 + h]) * sp;
    float* d = gba + (((size_t)t * 8 + h) * 2 + dir) * 2;
    d[0] = beta;
    d[1] = gl;
  }
}

constexpr int REC_ELEMS = 36864;
constexpr size_t OFF_GL = OFF_Z + (size_t)4096 * REC_ELEMS * 2;
static_assert(OFF_GL + 4096 * 4 <= OFF_CAT, "chunk records overflow z region");

__device__ __forceinline__ void gdn_chunk_item(int L, int r, const u16* qkvn, const float* gba, u16* rec_base, float* GL, char* smem) {
  const int NC = L / 64;
  const int n = r % NC, ci = r / NC;
  const int dir = ci & 1, h = (ci >> 1) & 7, bl = ci >> 4;
  u16* rec = rec_base + (size_t)r * REC_ELEMS;
  u16* sKb = (u16*)smem;
  u16* sQb = sKb + 64 * 136;
  float* sA = (float*)(smem + 2 * 17408);
  float* sG = (float*)(smem + 3 * 17408);
  float* sBeta = sG + 64;
  float* sg = sBeta + 64;
  const int tid = tidx(), lane = tid & 63, w = tid >> 6, fr = lane & 15, fq = lane >> 4;
  auto tok = [&](int c) -> int { const int pos = n * 64 + c; return bl * L + (dir ? (L - 1 - pos) : pos); };
  if (tid < 64) {
    const size_t o = (((size_t)tok(tid) * 8 + h) * 2 + dir) * 2;
    sBeta[tid] = gba[o];
    sg[tid] = gba[o + 1];
  }
  __syncthreads();
  if (tid < 64) {
    float sacc = 0.f;
    for (int l = 0; l <= tid; ++l) sacc += sg[l];
    sG[tid] = sacc;
  }
  __syncthreads();
#pragma unroll
  for (int it = 0; it < 8; ++it) {
    const int idx = it * 256 + tid, c = idx >> 5, c4 = idx & 31;
    const u16* src = qkvn + ((size_t)tok(c) * 8 + h) * 384 + c4 * 4;
    const uint2 q = *(const uint2*)src;
    const uint2 k = *(const uint2*)(src + 128);
    *(uint2*)(sQb + c * 136 + c4 * 4) = q;
    *(uint2*)(sKb + c * 136 + c4 * 4) = k;
    const float eg = __expf(sG[c]);
    *(uint2*)(rec + 16384 + c * 128 + c4 * 4) = make_uint2(pack2(lo2f(q.x) * eg, hi2f(q.x) * eg), pack2(lo2f(q.y) * eg, hi2f(q.y) * eg));
  }
  __syncthreads();
  {
    const int i = 16 * w + fr;
    bf16x8 kif[4], qif[4];
#pragma unroll
    for (int kk = 0; kk < 4; ++kk) {
      kif[kk] = *(const bf16x8*)(sKb + i * 136 + kk * 32 + fq * 8);
      qif[kk] = *(const bf16x8*)(sQb + i * 136 + kk * 32 + fq * 8);
    }
    const float Gi = sG[i], bi = sBeta[i];
#pragma unroll
    for (int jt = 0; jt < 4; ++jt) {
      f32x4 akk = (f32x4){0.f, 0.f, 0.f, 0.f}, aqk = (f32x4){0.f, 0.f, 0.f, 0.f};
      if (jt <= w) {
#pragma unroll
        for (int kk = 0; kk < 4; ++kk) {
          const bf16x8 kj = *(const bf16x8*)(sKb + (16 * jt + fr) * 136 + kk * 32 + fq * 8);
          akk = __builtin_amdgcn_mfma_f32_16x16x32_bf16(kj, kif[kk], akk, 0, 0, 0);
          aqk = __builtin_amdgcn_mfma_f32_16x16x32_bf16(kj, qif[kk], aqk, 0, 0, 0);
        }
      }
      float av[4], qv[4];
#pragma unroll
      for (int jj = 0; jj < 4; ++jj) {
        const int j = 16 * jt + 4 * fq + jj;
        const float dec = (j <= i) ? __expf(Gi - sG[j]) : 0.f;
        av[jj] = (j < i) ? bi * akk[jj] * dec : 0.f;
        qv[jj] = aqk[jj] * dec;
      }
      *(float4*)(sA + i * 68 + 16 * jt + 4 * fq) = make_float4(av[0], av[1], av[2], av[3]);
      *(uint2*)(rec + 32768 + i * 64 + 16 * jt + 4 * fq) = make_uint2(pack2(qv[0], qv[1]), pack2(qv[2], qv[3]));
    }
  }
  __syncthreads();
  {
    const int c = tid;
    const bool isU = c < 128;
    const int col = isU ? (256 + c) : c;
    float x[64];
#pragma unroll
    for (int i = 0; i < 64; ++i) x[i] = bf2f(qkvn[((size_t)tok(i) * 8 + h) * 384 + col]);
#pragma unroll
    for (int i = 0; i < 64; ++i) {
      float acc = x[i] * sBeta[i] * (isU ? 1.f : __expf(sG[i]));
      float ac1 = 0.f, ac2 = 0.f, ac3 = 0.f;
#pragma unroll
      for (int j4 = 0; j4 < (i + 3) / 4; ++j4) {
        const float4 a = *(const float4*)(sA + i * 68 + 4 * j4);
        acc -= a.x * x[4 * j4];
        if (4 * j4 + 1 < i) ac1 -= a.y * x[4 * j4 + 1];
        if (4 * j4 + 2 < i) ac2 -= a.z * x[4 * j4 + 2];
        if (4 * j4 + 3 < i) ac3 -= a.w * x[4 * j4 + 3];
      }
      x[i] = (acc + ac1) + (ac2 + ac3);
    }
    if (isU) {
      u16* dst = rec + (size_t)c * 64;
#pragma unroll
      for (int q8 = 0; q8 < 8; ++q8)
        *(uint4*)(dst + q8 * 8) = make_uint4(pack2(x[q8 * 8], x[q8 * 8 + 1]), pack2(x[q8 * 8 + 2], x[q8 * 8 + 3]),
                                             pack2(x[q8 * 8 + 4], x[q8 * 8 + 5]), pack2(x[q8 * 8 + 6], x[q8 * 8 + 7]));
    } else {
#pragma unroll
      for (int i = 0; i < 64; ++i) sQb[i * 136 + (c - 128)] = f2bf(x[i]);
    }
  }
  __syncthreads();
#pragma unroll
  for (int it = 0; it < 4; ++it) {
    const int idx = it * 256 + tid, row = idx >> 4, ch = idx & 15;
    *(uint4*)(rec + 8192 + row * 128 + ch * 8) = *(const uint4*)(sQb + row * 136 + ch * 8);
  }
  if (tid < 128) {
    const float Gl = sG[63];
    u16* dst = rec + 24576 + (size_t)tid * 64;
#pragma unroll
    for (int q8 = 0; q8 < 8; ++q8) {
      float v[8];
#pragma unroll
      for (int e2 = 0; e2 < 8; ++e2) {
        const int i = q8 * 8 + e2;
        v[e2] = bf2f(sKb[i * 136 + tid]) * __expf(Gl - sG[i]);
      }
      *(uint4*)(dst + q8 * 8) = make_uint4(pack2(v[0], v[1]), pack2(v[2], v[3]), pack2(v[4], v[5]), pack2(v[6], v[7]));
    }
  }
  if (tid == 0) GL[r] = __expf(sG[63]);
  __syncthreads();
}

__device__ __forceinline__ void gdn_cscan_item(int L, int ci, int half, const u16* rec_base, const float* GL, float* odir, char* smem) {
  const int NC = L / 64;
  const int dir = ci & 1, h = (ci >> 1) & 7, bl = ci >> 4;
  u16* sST = (u16*)smem;
  u16* sVT = sST + 64 * 136;
  const int tid = tidx(), lane = tid & 63, w = tid >> 6, fr = lane & 15, fq = lane >> 4;
  f32x4 S[2][4];
#pragma unroll
  for (int u = 0; u < 2; ++u)
#pragma unroll
    for (int t = 0; t < 4; ++t) S[u][t] = (f32x4){0.f, 0.f, 0.f, 0.f};
  for (int idx = tid; idx < 64 * 136 / 2; idx += 256) ((unsigned*)sST)[idx] = 0u;
  __syncthreads();
  bf16x8 nwf[4], nqgf[4], nqkf[2], nkdf[2][2];
  uint2 nut[4];
  float ngl;
#define SCAN_LOAD(nn)                                                                                             \
  {                                                                                                               \
    const u16* rec = rec_base + (size_t)(ci * NC + (nn)) * REC_ELEMS;                                             \
    ngl = GL[ci * NC + (nn)];                                                                                     \
    _Pragma("unroll") for (int kk = 0; kk < 4; ++kk) {                                                            \
      nwf[kk] = *(const bf16x8*)(rec + 8192 + (16 * w + fr) * 128 + kk * 32 + fq * 8);                            \
      nqgf[kk] = *(const bf16x8*)(rec + 16384 + (16 * w + fr) * 128 + kk * 32 + fq * 8);                          \
    }                                                                                                             \
    _Pragma("unroll") for (int kk = 0; kk < 2; ++kk) {                                                            \
      nqkf[kk] = *(const bf16x8*)(rec + 32768 + (16 * w + fr) * 64 + kk * 32 + fq * 8);                           \
      _Pragma("unroll") for (int u = 0; u < 2; ++u)                                                               \
        nkdf[u][kk] = *(const bf16x8*)(rec + 24576 + (32 * w + 16 * u + fr) * 64 + kk * 32 + fq * 8);             \
    }                                                                                                             \
    _Pragma("unroll") for (int t = 0; t < 4; ++t) nut[t] = *(const uint2*)(rec + (half * 64 + 16 * t + fr) * 64 + 16 * w + 4 * fq); \
  }
  SCAN_LOAD(0)
#pragma unroll 1
  for (int n = 0; n < NC; ++n) {
    const float gl = ngl;
    bf16x8 wf[4], qgf[4], qkf[2], kdf[2][2];
    uint2 ut[4];
#pragma unroll
    for (int kk = 0; kk < 4; ++kk) { wf[kk] = nwf[kk]; qgf[kk] = nqgf[kk]; }
#pragma unroll
    for (int kk = 0; kk < 2; ++kk) { qkf[kk] = nqkf[kk]; kdf[0][kk] = nkdf[0][kk]; kdf[1][kk] = nkdf[1][kk]; }
#pragma unroll
    for (int t = 0; t < 4; ++t) ut[t] = nut[t];
    if (n + 1 < NC) SCAN_LOAD(n + 1)
#pragma unroll
    for (int t = 0; t < 4; ++t) {
      f32x4 acc = (f32x4){0.f, 0.f, 0.f, 0.f};
#pragma unroll
      for (int kk = 0; kk < 4; ++kk) {
        const bf16x8 b = *(const bf16x8*)(sST + (16 * t + fr) * 136 + kk * 32 + fq * 8);
        acc = __builtin_amdgcn_mfma_f32_16x16x32_bf16(wf[kk], b, acc, 0, 0, 0);
      }
      const float v0 = lo2f(ut[t].x) - acc[0], v1 = hi2f(ut[t].x) - acc[1], v2 = lo2f(ut[t].y) - acc[2], v3 = hi2f(ut[t].y) - acc[3];
      *(uint2*)(sVT + (16 * t + fr) * 72 + 16 * w + 4 * fq) = make_uint2(pack2(v0, v1), pack2(v2, v3));
    }
    __syncthreads();
#pragma unroll
    for (int t = 0; t < 4; ++t) {
      f32x4 acc = (f32x4){0.f, 0.f, 0.f, 0.f};
#pragma unroll
      for (int kk = 0; kk < 4; ++kk) {
        const bf16x8 b = *(const bf16x8*)(sST + (16 * t + fr) * 136 + kk * 32 + fq * 8);
        acc = __builtin_amdgcn_mfma_f32_16x16x32_bf16(b, qgf[kk], acc, 0, 0, 0);
      }
#pragma unroll
      for (int kk = 0; kk < 2; ++kk) {
        const bf16x8 b = *(const bf16x8*)(sVT + (16 * t + fr) * 72 + kk * 32 + fq * 8);
        acc = __builtin_amdgcn_mfma_f32_16x16x32_bf16(b, qkf[kk], acc, 0, 0, 0);
      }
      {
        const int pos = n * 64 + 16 * w + fr;
        const int tk = bl * L + (dir ? (L - 1 - pos) : pos);
        *(float4*)(odir + (size_t)tk * 1024 + h * 128 + half * 64 + 16 * t + 4 * fq) = make_float4(acc[0], acc[1], acc[2], acc[3]);
      }
    }
#pragma unroll
    for (int u = 0; u < 2; ++u)
#pragma unroll
      for (int t = 0; t < 4; ++t) {
        f32x4 acc = S[u][t] * gl;
#pragma unroll
        for (int kk = 0; kk < 2; ++kk) {
          const bf16x8 b = *(const bf16x8*)(sVT + (16 * t + fr) * 72 + kk * 32 + fq * 8);
          acc = __builtin_amdgcn_mfma_f32_16x16x32_bf16(kdf[u][kk], b, acc, 0, 0, 0);
        }
        S[u][t] = acc;
      }
    __syncthreads();
#pragma unroll
    for (int u = 0; u < 2; ++u)
#pragma unroll
      for (int t = 0; t < 4; ++t)
        *(uint2*)(sST + (16 * t + fr) * 136 + 32 * w + 16 * u + 4 * fq) = make_uint2(pack2(S[u][t][0], S[u][t][1]), pack2(S[u][t][2], S[u][t][3]));
    __syncthreads();
  }
}

#undef SCAN_LOAD
__device__ __forceinline__ void gdn_post_item(const P& p, int tt, const float* of, const float* ob, const u16* gateB, u16* cat) {
  const int tid = tidx(), lane = tid & 63, w = tid >> 6;
  const int p4 = lane >> 4, d8 = (lane & 15) * 8;
  const float4 g0 = *(const float4*)(p.gdn_norm_g + d8), g1 = *(const float4*)(p.gdn_norm_g + d8 + 4);
#pragma unroll
  for (int it = 0; it < 4; ++it) {
    const int pr = w * 16 + it * 4 + p4;
    const int t = tt * 8 + (pr >> 3), h = pr & 7;
    const size_t o = (size_t)t * 1024 + h * 128 + d8;
    const float4 a0 = *(const float4*)(of + o), a1 = *(const float4*)(of + o + 4);
    const float4 b0 = *(const float4*)(ob + o), b1 = *(const float4*)(ob + o + 4);
    u16* cp = cat + (size_t)t * CATW + 1024 + h * 128 + d8;
    const uint4 gg = *(const uint4*)(gateB + (size_t)t * 1024 + h * 128 + d8);
    float x[8] = {a0.x + b0.x, a0.y + b0.y, a0.z + b0.z, a0.w + b0.w, a1.x + b1.x, a1.y + b1.y, a1.z + b1.z, a1.w + b1.w};
    float ss = 0.f;
#pragma unroll
    for (int e2 = 0; e2 < 8; ++e2) ss += x[e2] * x[e2];
    ss = row_sum16(ss);
    const float rinv = rsqrtf(ss * (1.f / 128.f) + EPSF);
    const float gn[8] = {g0.x, g0.y, g0.z, g0.w, g1.x, g1.y, g1.z, g1.w};
    const unsigned gw[4] = {gg.x, gg.y, gg.z, gg.w};
    unsigned ow[4];
#pragma unroll
    for (int q = 0; q < 4; ++q)
      ow[q] = pack2(x[2 * q] * rinv * gn[2 * q] * lo2f(gw[q]), x[2 * q + 1] * rinv * gn[2 * q + 1] * hi2f(gw[q]));
    *(uint4*)cp = make_uint4(ow[0], ow[1], ow[2], ow[3]);
  }
}

template <bool COPY>
__device__ __forceinline__ void resid_item(int item, const float* xin, const float* outb, const float* rsp, const float* g, float* dst, u16* xb, float* rinvb) {
  const int tid = tidx(), lane = tid & 63, w = tid >> 6;
  const int row = item * 4 + w;
  float s = 0.f;
#pragma unroll
  for (int i = 0; i < 16; ++i) s += rsp[(size_t)row * 16 + i];
  const float rinv = rsqrtf(s * (1.f / 1024.f) + EPSF);
  float sq = 0.f;
#pragma unroll
  for (int i = 0; i < 4; ++i) {
    const int col = i * 256 + lane * 4;
    float4 x = *(const float4*)(xin + (size_t)row * 1024 + col);
    float4 o = *(const float4*)(outb + (size_t)row * 1024 + col);
    float4 gg = *(const float4*)(g + col);
    float4 y = make_float4(x.x + o.x * rinv * gg.x, x.y + o.y * rinv * gg.y, x.z + o.z * rinv * gg.z, x.w + o.w * rinv * gg.w);
    *(float4*)(dst + (size_t)row * 1024 + col) = y;
    if (COPY) {
      sq += y.x * y.x + y.y * y.y + y.z * y.z + y.w * y.w;
      *(uint2*)(xb + (size_t)row * 1024 + col) = make_uint2(pack2(y.x, y.y), pack2(y.z, y.w));
    }
  }
  if (COPY) {
    sq = wave_sum(sq);
    if (lane == 0) rinvb[row] = rsqrtf(sq * (1.f / 1024.f) + EPSF);
  }
}

struct AttnIO {
  const u16* q; long qstep;
  const u16* k; const u16* v; long kstep;
  u16* o; long ostep;
  const u16* g; long gstep;
  float* lse; long lstep;
};

template <int DH, int NTW, int NCHUNK, int CHCOLS, int VSTR, bool MASK, int NH = 1>
__device__ __forceinline__ void attn_block(const AttnIO& io, int Lr, int q0, int HW, float scale, const float* sinkp, long hstep, char* smem) {
  u16* sV = (u16*)smem;
  const int tid = tidx(), lane = tid & 63, w = tid >> 6, fr = lane & 15, fq = lane >> 4;
  constexpr int NKK = DH / 32;
  constexpr int NDD = DH / 16;
  constexpr int SPC = NTW / 2 / NCHUNK;
  const int qw0 = q0 + 16 * w;
  const int kw0 = MASK ? (qw0 - HW) : 0;
  const int qp = qw0 + fr;
  const bool has_sink = (sinkp != nullptr);
  auto stage = [&](int c) {
    __syncthreads();
    const int k0c = MASK ? (q0 - HW) : c * CHCOLS;
    {
      constexpr int NIDX = CHCOLS * (DH / 8);
      constexpr int NIT = (NIDX + 255) / 256;
      uint4 vv[NIT];
#pragma unroll
      for (int q = 0; q < NIT; ++q) {
        const int idx = q * 256 + tid;
        const int col = idx % CHCOLS, dch = idx / CHCOLS;
        const int kp = k0c + col;
        vv[q] = make_uint4(0, 0, 0, 0);
        if (idx < NIDX && kp >= 0 && kp < Lr) vv[q] = *(const uint4*)(io.v + (long)kp * io.kstep + dch * 8);
      }
#pragma unroll
      for (int q = 0; q < NIT; ++q) {
        const int idx = q * 256 + tid;
        if (idx < NIDX) {
          const int col = idx % CHCOLS, dch = idx / CHCOLS;
          u16* d = sV + (dch * 8) * VSTR + col;
          d[0] = (u16)(vv[q].x & 0xffff); d[VSTR] = (u16)(vv[q].x >> 16);
          d[2 * VSTR] = (u16)(vv[q].y & 0xffff); d[3 * VSTR] = (u16)(vv[q].y >> 16);
          d[4 * VSTR] = (u16)(vv[q].z & 0xffff); d[5 * VSTR] = (u16)(vv[q].z >> 16);
          d[6 * VSTR] = (u16)(vv[q].w & 0xffff); d[7 * VSTR] = (u16)(vv[q].w >> 16);
        }
      }
    }
    __syncthreads();
  };
  if (NCHUNK == 1) stage(0);
#pragma unroll 1
  for (int hd = 0; hd < NH; ++hd) {
  const float sink = has_sink ? sinkp[hd] : 0.f;
  bf16x8 qf[NKK];
  {
    const u16* qptr = io.q + hd * hstep + (long)qp * io.qstep + fq * 8;
#pragma unroll
    for (int kk = 0; kk < NKK; ++kk) qf[kk] = *(const bf16x8*)(qptr + kk * 32);
  }
  f32x4 oacc[NDD];
#pragma unroll
  for (int dd = 0; dd < NDD; ++dd) oacc[dd] = (f32x4){0.f, 0.f, 0.f, 0.f};
  float m = has_sink ? sink : -1e30f;
  float den = 0.f;
#pragma unroll
  for (int c = 0; c < NCHUNK; ++c) {
    if (NCHUNK > 1) stage(c);
    auto kload = [&](bf16x8 (&dst)[2][NKK], int ktbase) {
#pragma unroll
      for (int tt = 0; tt < 2; ++tt) {
        const int kp = kw0 + 16 * (ktbase + tt) + fr;
        const bool valid = (kp >= 0) && (kp < Lr);
        const u16* kptr = io.k + (long)(valid ? kp : 0) * io.kstep + fq * 8;
#pragma unroll
        for (int kk = 0; kk < NKK; ++kk) {
          bf16x8 kf = {0, 0, 0, 0, 0, 0, 0, 0};
          if (valid) kf = *(const bf16x8*)(kptr + kk * 32);
          dst[tt][kk] = kf;
        }
      }
    };
    auto qk = [&](bf16x8 (&kf)[2][NKK], f32x4 (&st)[2]) {
#pragma unroll
      for (int tt = 0; tt < 2; ++tt) {
        st[tt] = (f32x4){0.f, 0.f, 0.f, 0.f};
#pragma unroll
        for (int kk = 0; kk < NKK; ++kk)
          st[tt] = __builtin_amdgcn_mfma_f32_16x16x32_bf16(kf[tt][kk], qf[kk], st[tt], 0, 0, 0);
      }
    };
    auto tail = [&](f32x4 (&st)[2], int kt0) {
      bool ok[2][4];
      float mloc = -1e30f;
#pragma unroll
      for (int tt = 0; tt < 2; ++tt)
#pragma unroll
        for (int j = 0; j < 4; ++j) {
          bool okv = true;
          if (MASK) {
            const int kp = kw0 + 16 * (kt0 + tt) + 4 * fq + j;
            const int dlt = qp - kp;
            okv = (kp >= 0) && (kp < Lr) && (dlt <= HW) && (dlt >= -HW);
          }
          ok[tt][j] = okv;
          const float sv = st[tt][j] * scale;
          st[tt][j] = sv;
          if (okv) mloc = fmaxf(mloc, sv);
        }
      mloc = xmax16(mloc);
      mloc = xmax32(mloc);
      const float mnew = fmaxf(m, mloc);
      const float alpha = __expf(m - mnew);
      m = mnew;
      float psum = 0.f;
#pragma unroll
      for (int tt = 0; tt < 2; ++tt)
#pragma unroll
        for (int j = 0; j < 4; ++j) {
          const float pv = ok[tt][j] ? __expf(st[tt][j] - mnew) : 0.f;
          st[tt][j] = pv;
          psum += pv;
        }
      den = den * alpha + psum;
      union { unsigned u[4]; bf16x8 v; } pf;
      pf.u[0] = pack2(st[0][0], st[0][1]);
      pf.u[1] = pack2(st[0][2], st[0][3]);
      pf.u[2] = pack2(st[1][0], st[1][1]);
      pf.u[3] = pack2(st[1][2], st[1][3]);
      const int cb0 = MASK ? (16 * w + 16 * kt0) : (16 * kt0 - c * CHCOLS);
      const int cb1 = cb0 + 16;
#pragma unroll
      for (int dd = 0; dd < NDD; ++dd) {
        const u16* vr = sV + (dd * 16 + fr) * VSTR + 4 * fq;
        union { uint2 h[2]; bf16x8 v; } vf;
        vf.h[0] = *(const uint2*)(vr + cb0);
        vf.h[1] = *(const uint2*)(vr + cb1);
        oacc[dd] = oacc[dd] * alpha;
        oacc[dd] = __builtin_amdgcn_mfma_f32_16x16x32_bf16(vf.v, pf.v, oacc[dd], 0, 0, 0);
      }
    };
    bf16x8 kfa[2][NKK], kfb[2][NKK];
    kload(kfa, 2 * (c * SPC));
    if (SPC > 1) kload(kfb, 2 * (c * SPC) + 2);
#pragma unroll 1
    for (int s2l = 0; s2l < SPC; s2l += 2) {
      {
        const int kt0 = 2 * (c * SPC + s2l);
        f32x4 st[2];
        qk(kfa, st);
        if (s2l + 2 < SPC) kload(kfa, kt0 + 4);
        tail(st, kt0);
      }
      if (s2l + 1 >= SPC) break;
      {
        const int kt0 = 2 * (c * SPC + s2l + 1);
        f32x4 st[2];
        qk(kfb, st);
        if (s2l + 3 < SPC) kload(kfb, kt0 + 4);
        tail(st, kt0);
      }
    }
  }
  den = xsum16(den);
  den = xsum32(den);
  if (has_sink) den += __expf(sink - m);
  const float rden = 1.f / den;
  u16* op = io.o + hd * hstep + (long)qp * io.ostep;
  const u16* gp = io.g ? (io.g + hd * hstep + (long)qp * io.gstep) : nullptr;
#pragma unroll
  for (int dd = 0; dd < NDD; ++dd) {
    const int d0 = dd * 16 + 4 * fq;
    float y0 = oacc[dd][0] * rden, y1 = oacc[dd][1] * rden, y2 = oacc[dd][2] * rden, y3 = oacc[dd][3] * rden;
    if (gp) {
      uint2 gg = *(const uint2*)(gp + d0);
      y0 *= silu(lo2f(gg.x)); y1 *= silu(hi2f(gg.x)); y2 *= silu(lo2f(gg.y)); y3 *= silu(hi2f(gg.y));
    }
    *(uint2*)(op + d0) = make_uint2(pack2(y0, y1), pack2(y2, y3));
  }
  if (io.lse && fq == 0) io.lse[(long)qp * io.lstep] = m + __logf(den);
  }
  __syncthreads();
}

__device__ __forceinline__ void xattn_item(int L, int nb, int item, int grp, const u16* z, int zs, int xq_col, int gx_col, const u16* mkv, u16* cat, int cat_col, char* smem) {
  const int nqb = L / 64;
  const int qb = item % nqb;
  const int rest = item / nqb;
  const int h = rest & 3, bl = rest >> 2;
  const int sq = (grp == 0) ? bl : (8 + (grp - 1) * 4 + bl);
  AttnIO io;
  io.q = z + (size_t)(bl * L) * zs + xq_col + h * 128; io.qstep = zs;
  io.k = mkv + (size_t)(sq * 256) * 1024 + h * 128;
  io.v = mkv + (size_t)(sq * 256) * 1024 + 512 + h * 128; io.kstep = 1024;
  io.o = cat + (size_t)(bl * L) * CATW + cat_col + h * 128; io.ostep = CATW;
  io.g = z + (size_t)(bl * L) * zs + gx_col + h * 128; io.gstep = zs;
  io.lse = nullptr; io.lstep = 0;
  attn_block<128, 16, 2, 128, 144, false>(io, 256, qb * 64, 0, 0.08838834764831845f, nullptr, 0, smem);
}

__global__ void __launch_bounds__(256, 2) mega(P p) {
  cg::grid_group grid = cg::this_grid();
  __shared__ __attribute__((aligned(16))) char smem[65536];
  const int nblk = gridDim.x, bid = blockIdx.x;
  char* ws = p.ws;
  XcdBarrier xb;
  xb.bar = (unsigned*)(ws + OFF_BAR); xb.x = xb_xcc_id(); xb.nloc = 0u; xb.nx = 0u;
  if (__builtin_amdgcn_workitem_id_x() == 0) (void)xb_add(&xb.bar[XB_XCNT(xb.x)], 1u);
  u16* wt_e_in = (u16*)(ws + OFF_WT_E_IN);
  u16* wt_o_in = (u16*)(ws + OFF_WT_O_IN);
  u16* wt_e_out = (u16*)(ws + OFF_WT_E_OUT);
  u16* wt_o_out = (u16*)(ws + OFF_WT_O_OUT);
  u16* wt_e_mkv = (u16*)(ws + OFF_WT_E_MKV);
  u16* wt_o_mkv = (u16*)(ws + OFF_WT_O_MKV);
  u16* mkv_e = (u16*)(ws + OFF_MKV_E);
  u16* mkv_o = (u16*)(ws + OFF_MKV_O);
  u16* hr_a = (u16*)(ws + OFF_HR_A);
  u16* hr_b = (u16*)(ws + OFF_HR_B);
  u16* z = (u16*)(ws + OFF_Z);
  u16* cat = (u16*)(ws + OFF_CAT);
  float* outb = (float*)(ws + OFF_OUT);
  float* rsp = (float*)(ws + OFF_RSP);
  u16* gateA = (u16*)(ws + OFF_OUT);
  u16* gateB = gateA + (size_t)GT * 1024;
  u16* ut = (u16*)(ws + OFF_UT);
  u16* yt = (u16*)(ws + OFF_YT);
  u16* qkvn = (u16*)(ws + OFF_QKVN);
  float* gba = (float*)(ws + OFF_GBA);
  float* of = (float*)(ws + OFF_OF);
  float* ob = (float*)(ws + OFF_OB);
  u16* og = (u16*)(ws + OFF_OG);
  float* lse = (float*)(ws + OFF_LSE);
  u16* xbf = (u16*)(ws + OFF_XB);
  float* rinvb = (float*)(ws + OFF_RINVB);
  u16* memb = (u16*)(ws + OFF_MEMB);
  float* rinvm = (float*)(ws + OFF_RINVM);

  {
    const int n_e_in = 16 * (ZSE / 64), n_o_in = 16 * (ZSO / 64), n_e_out = 40 * 16, n_o_out = 32 * 16, n_mkv = 16 * 16;
    const int n_f = 256 + 512;
    const int n_rp = GT / 4 + 6144 / 4;
    const int total = n_rp + n_e_in + n_o_in + n_e_out + n_o_out + 2 * n_mkv + n_f;
    REP(5) for (int it = bid; it < total; it += nblk) {
      int i = it;
      if (i < GT / 4) { rowprep_item(i, p.xp, xbf, rinvb); continue; }
      i -= GT / 4;
      if (i < 6144 / 4) { if (i < 512) rowprep_item(i, p.memp, memb, rinvm); else rowprep_item(i - 512, p.mems, memb + (size_t)2048 * 1024, rinvm + 2048); continue; }
      i -= 6144 / 4;
      if (i < n_e_in) { wt_tile(p.e_w_in, 9248, p.e_pre_g, wt_e_in, 1024, i & 15, i >> 4, 1, smem); continue; }
      i -= n_e_in;
      if (i < n_o_in) { wt_tile(p.o_w_in, 8448, p.o_pre_g, wt_o_in, 1024, i & 15, i >> 4, 0, smem); continue; }
      i -= n_o_in;
      if (i < n_e_out) { wt_tile(p.e_w_out, 1024, nullptr, wt_e_out, 2560, i % 40, i / 40, 0, smem); continue; }
      i -= n_e_out;
      if (i < n_o_out) { wt_tile(p.o_w_out, 1024, nullptr, wt_o_out, 2048, i % 32, i / 32, 0, smem); continue; }
      i -= n_o_out;
      if (i < n_mkv) { wt_tile(p.e_w_mkv, 1024, p.e_mem_g, wt_e_mkv, 1024, i & 15, i >> 4, 0, smem); continue; }
      i -= n_mkv;
      if (i < n_mkv) { wt_tile(p.o_w_mkv, 1024, p.o_mem_g, wt_o_mkv, 1024, i & 15, i >> 4, 0, smem); continue; }
      i -= n_mkv;
      if (i < 256) { filt_item(p, 2048, i >> 3, i & 7, hr_a, smem); continue; }
      i -= 256;
      filt_item(p, 4096, i >> 3, i & 7, hr_b, smem);
    }
  }
  grid.sync();
  for (int layer = 0; layer < 2; ++layer) {
    Epi e; e.out = layer ? mkv_o : mkv_e; e.ldo = 1024; e.rsp = nullptr; e.L = 1; e.rinv = rinvm;
    gemm_phase<0>(bid, nblk, 24 * 8, 24, memb, 1024, layer ? wt_o_mkv : wt_e_mkv, 1024, e, smem);
  }
  xcd_barrier(xb);

  for (int grp = 0; grp < NGROUP; ++grp) {
    const int L = (grp == 0) ? 2048 : 4096;
    const int nb = GT / L;
    const float* xg = (grp == 0) ? p.xp : (p.xs + (size_t)(grp - 1) * GT * 1024);
    float* dg = p.out + (size_t)grp * GT * 1024;
    const u16* hr = (grp == 0) ? hr_a : hr_b;

    REP(0) {
      Epi e; e.out = z; e.ldo = ZSE; e.rsp = nullptr; e.L = L; e.rinv = rinvb;
      gemm_phase<0>(bid, nblk, 64 * 73, 64, xbf, 1024, wt_e_in, 1024, e, smem);
    }
    xcd_barrier(xb);
    {
      const int n_hy = 256 * 8, n_gd = 256 * 8, n_x = 1024;
      REP(1) for (int it = bid; it < n_hy + n_gd + n_x; it += nblk) {
        int i = it;
        if (i < n_x) { xattn_item(L, nb, i, grp, z, ZSE, E_XQ, E_GX, mkv_e, cat, 2048, smem); continue; }
        i -= n_x;
        if (i < n_gd) { gdn_pre_item(p, L, i >> 3, i & 7, z, qkvn, gba, gateB); continue; }
        i -= n_gd;
        hy_pre_item(p, L, i >> 3, i & 7, z, gateA, ut);
      }
    }
    xcd_barrier(xb);
    REP(4) for (int it = bid; it < 4096; it += nblk) gdn_chunk_item(L, it, qkvn, gba, z, (float*)(ws + OFF_GL), smem);
    xcd_barrier(xb);
    {
      const int n_scan = nb * 32;
      REP(2) {
      if (bid < n_scan) {
        const int ci = bid >> 1, half = bid & 1;
        gdn_cscan_item(L, ci, half, z, (const float*)(ws + OFF_GL), (ci & 1) ? ob : of, smem);
      }
      unsigned* hctr = (unsigned*)(ws + OFF_BAR) + 3600 + grp + 8 * rep_;
      volatile unsigned* slot = (volatile unsigned*)(smem + (2 * L - 1) * 4);
      for (;;) {
        __syncthreads();
        if (__builtin_amdgcn_workitem_id_x() == 0) *slot = atomicAdd(hctr, 1u);
        __syncthreads();
        const unsigned chn = *slot;
        if (chn >= 1024u) break;
        hy_conv_item(L, nb, (int)chn, hr, ut, yt, smem);
      }
      }
    }
    xcd_barrier(xb);
    {
      const int n_hy = 256 * 8, n_gd = GT / 8;
      REP(6) for (int it = bid; it < n_hy + n_gd; it += nblk) {
        if (it < n_hy) hy_post_item(it >> 3, it & 7, yt, gateA, cat);
        else gdn_post_item(p, it - n_hy, of, ob, gateB, cat);
      }
    }
    xcd_barrier(xb);
    REP(0) {
      Epi e; e.out = outb; e.ldo = 1024; e.rsp = rsp; e.L = L; e.rinv = nullptr;
      gemm_phase<2>(bid, nblk, 64 * 8, 64, cat, CATW, wt_e_out, 2560, e, smem);
    }
    xcd_barrier(xb);
    for (int it = bid; it < GT / 4; it += nblk) resid_item<true>(it, xg, outb, rsp, p.e_post_g, dg, xbf, rinvb);
    xcd_barrier(xb);
    REP(0) {
      Epi e; e.out = z; e.ldo = ZSO; e.rsp = nullptr; e.L = L; e.rinv = rinvb;
      gemm_phase<1>(bid, nblk, 64 * 66, 64, xbf, 1024, wt_o_in, 1024, e, smem);
    }
    xcd_barrier(xb);
    {
      const int n_dil = 3072, n_swa = 512, n_x = 1024;
      REP(3) for (int it = bid; it < n_dil + n_swa + n_x; it += nblk) {
        int i = it;
        if (i < n_swa) {
          const int kvh = i & 1, rem = i >> 1;
          const int nqb = L / 64, qb = rem % nqb, bl = rem / nqb;
          const int qh = kvh * 8;
          AttnIO io;
          io.q = z + (size_t)(bl * L) * ZSO + O_DQ + qh * 64; io.qstep = ZSO;
          io.k = z + (size_t)(bl * L) * ZSO + O_DK + kvh * 64;
          io.v = z + (size_t)(bl * L) * ZSO + O_DV + kvh * 64; io.kstep = ZSO;
          io.o = cat + (size_t)(bl * L) * CATW + 512 + qh * 64; io.ostep = CATW;
          io.g = z + (size_t)(bl * L) * ZSO + O_GD + qh * 64; io.gstep = ZSO;
          io.lse = nullptr; io.lstep = 0;
          attn_block<64, 18, 1, 336, 336, true, 8>(io, L, qb * 64, 128, 0.125f, p.swa_sink + qh, 64, smem);
          continue;
        }
        i -= n_swa;
        if (i < n_dil) {
          const int gi = i >> 10, rem = i & 1023;
          const int h = rem & 3, rem2 = rem >> 2;
          const int d = (gi == 0) ? 1 : (gi == 1 ? 4 : 16);
          const int Lr = L / d, nqb = Lr / 64;
          const int qb = rem2 % nqb, rem3 = rem2 / nqb;
          const int r = rem3 % d, bl = rem3 / d;
          const size_t row0 = (size_t)bl * L + r;
          AttnIO io;
          io.q = z + row0 * ZSO + O_CQ + gi * 512 + h * 128; io.qstep = (long)d * ZSO;
          io.k = z + row0 * ZSO + O_CK + gi * 512 + h * 128;
          io.v = z + row0 * ZSO + O_CV + gi * 512 + h * 128; io.kstep = (long)d * ZSO;
          io.o = og + row0 * 1536 + gi * 512 + h * 128; io.ostep = (long)d * 1536;
          io.g = nullptr; io.gstep = 0;
          io.lse = lse + row0 * 12 + gi * 4 + h; io.lstep = (long)d * 12;
          attn_block<128, 10, 1, 208, 208, true>(io, Lr, qb * 64, 64, 0.08838834764831845f, nullptr, 0, smem);
          continue;
        }
        i -= n_dil;
        xattn_item(L, nb, i, grp, z, ZSO, O_XQ, O_GX, mkv_o, cat, 1536, smem);
      }
    }
    xcd_barrier(xb);
    for (int it = bid; it < GT / 4; it += nblk) {
      const int tid = tidx(), lane = tid & 63, w = tid >> 6;
      const int t = it * 4 + w;
      const int h = lane >> 4, d0 = (lane & 15) * 8;
      const float l0 = lse[(size_t)t * 12 + h], l1 = lse[(size_t)t * 12 + 4 + h], l2 = lse[(size_t)t * 12 + 8 + h];
      const float mx = fmaxf(l0, fmaxf(l1, l2));
      float w0 = __expf(l0 - mx), w1 = __expf(l1 - mx), w2 = __expf(l2 - mx);
      const float rs = 1.f / (w0 + w1 + w2);
      w0 *= rs; w1 *= rs; w2 *= rs;
      uint4 a = *(const uint4*)(og + (size_t)t * 1536 + h * 128 + d0);
      uint4 b = *(const uint4*)(og + (size_t)t * 1536 + 512 + h * 128 + d0);
      uint4 c = *(const uint4*)(og + (size_t)t * 1536 + 1024 + h * 128 + d0);
      uint4 g = *(const uint4*)(z + (size_t)t * ZSO + O_GC + h * 128 + d0);
      unsigned au[4] = {a.x, a.y, a.z, a.w}, bu[4] = {b.x, b.y, b.z, b.w}, cu[4] = {c.x, c.y, c.z, c.w}, gu[4] = {g.x, g.y, g.z, g.w};
      unsigned ru[4];
#pragma unroll
      for (int i = 0; i < 4; ++i) {
        const float ylo = (w0 * lo2f(au[i]) + w1 * lo2f(bu[i]) + w2 * lo2f(cu[i])) * silu(lo2f(gu[i]));
        const float yhi = (w0 * hi2f(au[i]) + w1 * hi2f(bu[i]) + w2 * hi2f(cu[i])) * silu(hi2f(gu[i]));
        ru[i] = pack2(ylo, yhi);
      }
      *(uint4*)(cat + (size_t)t * CATW + h * 128 + d0) = make_uint4(ru[0], ru[1], ru[2], ru[3]);
    }
    xcd_barrier(xb);
    REP(0) {
      Epi e; e.out = outb; e.ldo = 1024; e.rsp = rsp; e.L = L; e.rinv = nullptr;
      gemm_phase<2>(bid, nblk, 64 * 8, 64, cat, CATW, wt_o_out, 2048, e, smem);
    }
    if (grp + 1 < NGROUP) {
      const float* xn = p.xs + (size_t)grp * GT * 1024;
      for (int it = nblk - 1 - bid; it < GT / 4; it += nblk) rowprep_item(it, xn, xbf, rinvb);
    }
    xcd_barrier(xb);
    for (int it = bid; it < GT / 4; it += nblk) resid_item<false>(it, dg, outb, rsp, p.o_post_g, dg, nullptr, nullptr);
  }
}

extern "C" void kernel_launch(void* const* d_in, const int* in_sizes, int n_in, void* d_out, int out_size, void* d_ws,
                              size_t ws_size, hipStream_t stream) {
  static int grid_blocks = 0;
  if (!grid_blocks) {
    int dev = 0, cus = 0, per_cu = 0;
    hipGetDevice(&dev);
    hipDeviceGetAttribute(&cus, hipDeviceAttributeMultiprocessorCount, dev);
    hipOccupancyMaxActiveBlocksPerMultiprocessor(&per_cu, mega, 256, 0);
    if (per_cu > 2) per_cu = 2;
    if (per_cu < 1) per_cu = 1;
    grid_blocks = cus * per_cu;
  }
  P p{};
  const float** f = (const float**)&p;
  for (int i = 0; i < 30; ++i) f[i] = (const float*)d_in[i];
  p.out = (float*)d_out;
  p.ws = (char*)d_ws;
  hipMemsetAsync((char*)d_ws + OFF_BAR, 0, 16384, stream);
  void* args[] = {&p};
  hipError_t e = hipLaunchCooperativeKernel((void*)mega, dim3(grid_blocks), dim3(256), args, 0, stream);
  if (e != hipSuccess) fprintf(stderr, "cooperative launch failed: %s (grid %d)\n", hipGetErrorString(e), grid_blocks);
}
```

```cpp
#include <hip/hip_runtime.h>
#include <hip/hip_cooperative_groups.h>
#include <cstdio>
namespace cg = cooperative_groups;

typedef unsigned short u16;
typedef __attribute__((ext_vector_type(8))) short bf16x8;
typedef __attribute__((ext_vector_type(4))) float f32x4;

#define DEVI __device__ __forceinline__
#define EPSF 1e-6f

#ifndef DUPMASK
#define DUPMASK 0
#endif
#define REP(k) for (int rep_ = 0; rep_ < 1 + ((DUPMASK >> (k)) & 1); ++rep_)
constexpr int GT = 16384;
constexpr int NGROUP = 5;
constexpr int ZSE = 9344;
constexpr int ZSO = 8448;
constexpr int CATW = 2560;
constexpr int E_HY = 0, E_GHY = 3072, E_QKV = 4096, E_GG = 7168, E_XQ = 8192, E_GX = 8704, E_BETA = 9216, E_A = 9232;
constexpr int O_CQ = 0, O_CK = 1536, O_CV = 3072, O_GC = 4608, O_DQ = 5120, O_DK = 6144, O_DV = 6272, O_GD = 6400, O_XQ = 7424, O_GX = 7936;

constexpr size_t OFF_WT_E_IN  = 0;
constexpr size_t OFF_WT_O_IN  = OFF_WT_E_IN  + (size_t)ZSE * 1024 * 2;
constexpr size_t OFF_WT_E_OUT = OFF_WT_O_IN  + (size_t)ZSO * 1024 * 2;
constexpr size_t OFF_WT_O_OUT = OFF_WT_E_OUT + (size_t)1024 * 2560 * 2;
constexpr size_t OFF_WT_E_MKV = OFF_WT_O_OUT + (size_t)1024 * 2048 * 2;
constexpr size_t OFF_WT_O_MKV = OFF_WT_E_MKV + (size_t)1024 * 1024 * 2;
constexpr size_t OFF_MKV_E    = OFF_WT_O_MKV + (size_t)1024 * 1024 * 2;
constexpr size_t OFF_MKV_O    = OFF_MKV_E    + (size_t)6144 * 1024 * 2;
constexpr size_t OFF_HR_A     = OFF_MKV_O    + (size_t)6144 * 1024 * 2;
constexpr size_t OFF_HR_B     = OFF_HR_A     + (size_t)1024 * 4096 * 2;
constexpr size_t OFF_Z        = OFF_HR_B     + (size_t)1024 * 8192 * 2;
constexpr size_t OFF_CAT      = OFF_Z        + (size_t)GT * ZSE * 2;
constexpr size_t OFF_OUT      = OFF_CAT      + (size_t)GT * CATW * 2;
constexpr size_t OFF_RSP      = OFF_OUT      + (size_t)GT * 1024 * 4;
constexpr size_t OFF_UT       = OFF_RSP      + (size_t)GT * 16 * 4;
constexpr size_t OFF_YT       = OFF_UT       + (size_t)1024 * GT * 2;
constexpr size_t OFF_QKVN     = OFF_YT       + (size_t)1024 * GT * 2;
constexpr size_t OFF_GBA      = OFF_QKVN     + (size_t)GT * 3072 * 4;
constexpr size_t OFF_OF       = OFF_GBA      + (size_t)GT * 32 * 4;
constexpr size_t OFF_OB       = OFF_OF       + (size_t)GT * 1024 * 4;
constexpr size_t OFF_END      = OFF_OB       + (size_t)GT * 1024 * 4;
constexpr size_t OFF_OG       = OFF_QKVN;
constexpr size_t OFF_LSE      = OFF_OG + (size_t)GT * 1536 * 2;
constexpr size_t OFF_BAR      = OFF_END;
constexpr size_t OFF_XB       = OFF_BAR + 16384;
constexpr size_t OFF_RINVB    = OFF_XB + (size_t)GT * 1024 * 2;
constexpr size_t OFF_MEMB     = OFF_RINVB + (size_t)GT * 4;
constexpr size_t OFF_RINVM    = OFF_MEMB + (size_t)6144 * 1024 * 2;
static_assert(OFF_RINVM + 6144 * 4 <= (size_t)1 << 30, "workspace too large");

struct P {
  const float *xp, *xs, *memp, *mems;
  const float *e_pre_g, *e_post_g, *e_w_in, *e_w_out, *hy_conv_w, *hy_conv_b, *hy_w1, *hy_b1, *hy_w2, *hy_b2, *hy_w3,
      *hy_freq, *hy_skip, *gdn_conv_w, *gdn_A_log, *gdn_dt_bias, *gdn_norm_g, *e_mem_g, *e_w_mkv;
  const float *o_pre_g, *o_post_g, *o_w_in, *o_w_out, *swa_sink, *o_mem_g, *o_w_mkv;
  float* out;
  char* ws;
};

DEVI int tidx() { int t = __builtin_amdgcn_workitem_id_x(); asm volatile("" : "+v"(t)); return t; }
DEVI u16 f2bf(float f) {
  unsigned u = __float_as_uint(f);
  u += 0x7fffu + ((u >> 16) & 1u);
  return (u16)(u >> 16);
}
DEVI float bf2f(u16 h) { return __uint_as_float(((unsigned)h) << 16); }
DEVI unsigned pack2(float a, float b) { return (unsigned)f2bf(a) | ((unsigned)f2bf(b) << 16); }
DEVI float lo2f(unsigned u) { return __uint_as_float(u << 16); }
DEVI float hi2f(unsigned u) { return __uint_as_float(u & 0xffff0000u); }
DEVI float silu(float x) { return x / (1.f + __expf(-x)); }
DEVI void fsincos(float x, float* sn, float* cs) {
  const float k = rintf(x * 0.15915494309189535f);
  float r = fmaf(-k, 6.28125f, x);
  r = fmaf(-k, 0.0019353071795864769f, r);
  *sn = __sinf(r);
  *cs = __cosf(r);
}
#define DPP_ADD(v, ctrl) ((v) + __int_as_float(__builtin_amdgcn_mov_dpp(__float_as_int(v), (ctrl), 0xf, 0xf, true)))
DEVI float wave_sum(float v) {
  v = DPP_ADD(v, 0xB1);
  v = DPP_ADD(v, 0x4E);
  v = DPP_ADD(v, 0x141);
  v = DPP_ADD(v, 0x140);
  const float r0 = __int_as_float(__builtin_amdgcn_readlane(__float_as_int(v), 0));
  const float r1 = __int_as_float(__builtin_amdgcn_readlane(__float_as_int(v), 16));
  const float r2 = __int_as_float(__builtin_amdgcn_readlane(__float_as_int(v), 32));
  const float r3 = __int_as_float(__builtin_amdgcn_readlane(__float_as_int(v), 48));
  return (r0 + r1) + (r2 + r3);
}


DEVI float xmax16(float v) { auto r = __builtin_amdgcn_permlane16_swap(__float_as_uint(v), __float_as_uint(v), false, false); return fmaxf(__uint_as_float(r[0]), __uint_as_float(r[1])); }
DEVI float xmax32(float v) { auto r = __builtin_amdgcn_permlane32_swap(__float_as_uint(v), __float_as_uint(v), false, false); return fmaxf(__uint_as_float(r[0]), __uint_as_float(r[1])); }
DEVI float xsum16(float v) { auto r = __builtin_amdgcn_permlane16_swap(__float_as_uint(v), __float_as_uint(v), false, false); return __uint_as_float(r[0]) + __uint_as_float(r[1]); }
DEVI float xsum32(float v) { auto r = __builtin_amdgcn_permlane32_swap(__float_as_uint(v), __float_as_uint(v), false, false); return __uint_as_float(r[0]) + __uint_as_float(r[1]); }
DEVI float row_sum16(float v) {
  v = DPP_ADD(v, 0xB1); v = DPP_ADD(v, 0x4E); v = DPP_ADD(v, 0x141); v = DPP_ADD(v, 0x140);
  return v;
}

#define XB_TMO      128
#define XB_XCNT(j)  (256  + 64 * (j))
#define XB_XSUB(j)  (1280 + 64 * (j))
#define XB_XGEN(j)  (2304 + 64 * (j))
#define XB_TOP      3328
#define XB_TOPGEN   3392
#define XCD_BAR_WORDS 3456
#define XB_SPIN_CAP (1u << 22)
DEVI unsigned xb_ld(unsigned* p) { return __hip_atomic_load(p, __ATOMIC_RELAXED, __HIP_MEMORY_SCOPE_AGENT); }
DEVI unsigned xb_add(unsigned* p, unsigned v) { return __hip_atomic_fetch_add(p, v, __ATOMIC_RELAXED, __HIP_MEMORY_SCOPE_AGENT); }
DEVI unsigned xb_xcc_id() { return (unsigned)__builtin_amdgcn_s_getreg((3 << 11) | 20) & 0xFu; }
#define XB_SPIN(cond, bar) do { unsigned _sp = 0; while (cond) { __builtin_amdgcn_s_sleep(1); \
    if ((++_sp & 255u) == 0u) { if (xb_ld(&(bar)[XB_TMO])) break; if (_sp > XB_SPIN_CAP) { atomicAdd(&(bar)[XB_TMO], 1u); break; } } } } while (0)
struct XcdBarrier { unsigned* bar; unsigned x; unsigned nloc; unsigned nx; };
DEVI void xcd_barrier_complete(unsigned* bar, unsigned x, unsigned& nloc, unsigned& nx) {
  const unsigned G = gridDim.x;
  unsigned sum, cnt, mine, sp = 0u;
  for (;;) {
    sum = 0u; cnt = 0u; mine = 0u;
#pragma unroll
    for (unsigned j = 0; j < 16; ++j) { const unsigned c = xb_ld(&bar[XB_XCNT(j)]); sum += c; cnt += (c > 0u) ? 1u : 0u; mine = (j == x) ? c : mine; }
    if (sum == G) break;
    __builtin_amdgcn_s_sleep(1);
    if ((++sp & 255u) == 0u) { if (xb_ld(&bar[XB_TMO])) break; if (sp > XB_SPIN_CAP) { atomicAdd(&bar[XB_TMO], 1u); break; } }
  }
  nloc = mine > 0u ? mine : 1u; nx = cnt > 0u ? cnt : 1u;
}
DEVI void xcd_barrier(XcdBarrier& b) {
  asm volatile("s_waitcnt vmcnt(0)" ::: "memory");
  __syncthreads();
  if (__builtin_amdgcn_workitem_id_x() == 0) {
    unsigned* bar = b.bar;
    __builtin_amdgcn_s_waitcnt(0);
    if (b.nloc == 0u) xcd_barrier_complete(bar, b.x, b.nloc, b.nx);
    const unsigned nloc = b.nloc, nx = b.nx;
    const unsigned old = xb_add(&bar[XB_XSUB(b.x)], 1u);
    const unsigned gen = old / nloc;
    if (old + 1u == (gen + 1u) * nloc) {
      __builtin_amdgcn_fence(__ATOMIC_RELEASE, "agent");
      asm volatile("s_waitcnt vmcnt(0)" ::: "memory");
      const unsigned og = xb_add(&bar[XB_TOP], 1u);
      const unsigned tg = og / nx;
      if (og + 1u == (tg + 1u) * nx) xb_add(&bar[XB_TOPGEN], 1u);
      else XB_SPIN(xb_ld(&bar[XB_TOPGEN]) == tg, bar);
      __builtin_amdgcn_fence(__ATOMIC_ACQUIRE, "agent");
      xb_add(&bar[XB_XGEN(b.x)], 1u);
      asm volatile("s_waitcnt vmcnt(0)" ::: "memory");
    } else {
      XB_SPIN(xb_ld(&bar[XB_XGEN(b.x)]) == gen, bar);
      __builtin_amdgcn_fence(__ATOMIC_ACQUIRE, "agent");
      asm volatile("s_waitcnt vmcnt(0)" ::: "memory");
    }
  }
  __syncthreads();
}

struct Epi { void* out; int ldo; float* rsp; int L; const float* rinv; };

template <int EPI>
__device__ __forceinline__ void gemm_phase(int first, int stride, int ntiles, int tmc, const u16* Abase, int lda, const u16* Wbase, int K, const Epi& e, char* smem) {
  const int tid = tidx(), lane = tid & 63, w = tid >> 6, wr = w >> 1, wc = w & 1, fr = lane & 15, fq = lane >> 4;
  const int gr = tid >> 2, gp = tid & 3;
  int it = first;
  if (it >= ntiles) return;
  const u16* Ab = Abase + (size_t)((it % tmc) * 256 + gr) * lda + gp * 8;
  const u16* Wp = Wbase + (size_t)((it / tmc) * 128 + gr) * K + gp * 8;
  const size_t a64 = (size_t)64 * lda, w64 = (size_t)64 * K;
  char* stA = smem + gr * 64 + ((gp ^ (((gr >> 3) & 1) * 3)) * 16);
  char* stB = stA + 16384;
  const int cho = (fq ^ ((fr >> 3) * 3)) * 16;
  const char* rdA = smem + (wr * 128 + fr) * 64 + cho;
  const char* rdB = smem + 16384 + (wc * 64 + fr) * 64 + cho;
  uint4 ra0_0, ra0_1, ra0_2, ra0_3, rb0_0, rb0_1, ra1_0, ra1_1, ra1_2, ra1_3, rb1_0, rb1_1;
  const int nk = K / 32;
#define G_LOAD(u, k0) ra##u##_0 = *(const uint4*)(Ab + (k0)); ra##u##_1 = *(const uint4*)(Ab + a64 + (k0)); ra##u##_2 = *(const uint4*)(Ab + 2 * a64 + (k0)); ra##u##_3 = *(const uint4*)(Ab + 3 * a64 + (k0)); \
                      rb##u##_0 = *(const uint4*)(Wp + (k0)); rb##u##_1 = *(const uint4*)(Wp + w64 + (k0));
#define G_STORE(u, stg) { char* pa_ = stA + (stg) * 24576; char* pb_ = stB + (stg) * 24576; \
    *(uint4*)pa_ = ra##u##_0; *(uint4*)(pa_ + 4096) = ra##u##_1; *(uint4*)(pa_ + 8192) = ra##u##_2; *(uint4*)(pa_ + 12288) = ra##u##_3; \
    *(uint4*)pb_ = rb##u##_0; *(uint4*)(pb_ + 4096) = rb##u##_1; }
#define G_COMPUTE(stg) { const char* qa_ = rdA + (stg) * 24576; const char* qb_ = rdB + (stg) * 24576; bf16x8 fb_[4]; \
    _Pragma("unroll") for (int ni = 0; ni < 4; ++ni) fb_[ni] = *(const bf16x8*)(qb_ + ni * 1024); \
    _Pragma("unroll") for (int mh = 0; mh < 2; ++mh) { bf16x8 fa_[4]; \
      _Pragma("unroll") for (int mi = 0; mi < 4; ++mi) fa_[mi] = *(const bf16x8*)(qa_ + (mh * 4 + mi) * 1024); \
      __builtin_amdgcn_s_setprio(1); \
      _Pragma("unroll") for (int mi = 0; mi < 4; ++mi) _Pragma("unroll") for (int ni = 0; ni < 4; ++ni) \
        acc[mh * 4 + mi][ni] = __builtin_amdgcn_mfma_f32_16x16x32_bf16(fb_[ni], fa_[mi], acc[mh * 4 + mi][ni], 0, 0, 0); \
      __builtin_amdgcn_s_setprio(0); } }
  G_LOAD(0, 0) G_LOAD(1, 32)
#pragma unroll 1
  for (;;) {
  const int m0 = (it % tmc) * 256, n0 = (it / tmc) * 128;
  f32x4 acc[8][4];
#pragma unroll
  for (int i = 0; i < 8; ++i)
#pragma unroll
    for (int j = 0; j < 4; ++j) acc[i][j] = (f32x4){0.f, 0.f, 0.f, 0.f};
  G_STORE(0, 0)
  G_LOAD(0, 64)
  __syncthreads();
#pragma unroll 1
  for (int kt0 = 0; kt0 < nk; kt0 += 2) {
    G_STORE(1, 1)
    if (kt0 + 3 < nk) { const int k0 = (kt0 + 3) * 32; G_LOAD(1, k0) }
    G_COMPUTE(0)
    __syncthreads();
    if (kt0 + 2 < nk) G_STORE(0, 0)
    if (kt0 + 4 < nk) { const int k0 = (kt0 + 4) * 32; G_LOAD(0, k0) }
    G_COMPUTE(1)
    __syncthreads();
  }
  const int itn = it + stride;
  if (itn < ntiles) {
    Ab = Abase + (size_t)((itn % tmc) * 256 + gr) * lda + gp * 8;
    Wp = Wbase + (size_t)((itn / tmc) * 128 + gr) * K + gp * 8;
    G_LOAD(0, 0) G_LOAD(1, 32)
  }
  if (EPI == 0 || EPI == 1) {
    u16* out = (u16*)e.out;
    const int cb = n0 + wc * 64;
    int ropemode = 0;
    if (EPI == 1) {
      if (cb < 3072 && (cb & 127) == 0) ropemode = 1;
      else if (cb >= O_DQ && cb < O_DV) ropemode = 2;
    }
#pragma unroll
    for (int mi = 0; mi < 8; ++mi) {
      const int rl = wr * 128 + mi * 16 + fr;
      const int row = m0 + rl;
      const float rv = e.rinv[row];
      f32x4 v[4];
#pragma unroll
      for (int ni = 0; ni < 4; ++ni) v[ni] = acc[mi][ni] * rv;
      if (EPI == 1 && ropemode != 0) {
        const float pos = (float)(row % e.L);
        if (ropemode == 1) {
#pragma unroll
          for (int j = 0; j < 4; ++j) {
            const int i = fq * 4 + j;
            const float inv = __expf(-13.122363377404328f * (float)i * (1.f / 16.f));
            float sn, cs;
            fsincos(pos * inv, &sn, &cs);
            const float x1 = v[0][j], x2 = v[1][j];
            v[0][j] = x1 * cs - x2 * sn;
            v[1][j] = x2 * cs + x1 * sn;
          }
        } else {
#pragma unroll
          for (int j = 0; j < 4; ++j) {
            const int i = (fq & 1) * 4 + j;
            const float inv = __expf(-13.122363377404328f * (float)i * (1.f / 8.f));
            float sn, cs;
            fsincos(pos * inv, &sn, &cs);
            const float mine = v[0][j];
            const float other = __shfl_xor(mine, 32);
            v[0][j] = (fq < 2) ? (mine * cs - other * sn) : (mine * cs + other * sn);
          }
        }
      }
#pragma unroll
      for (int np = 0; np < 2; ++np) {
        uint2 a = make_uint2(pack2(v[2 * np][0], v[2 * np][1]), pack2(v[2 * np][2], v[2 * np][3]));
        uint2 b = make_uint2(pack2(v[2 * np + 1][0], v[2 * np + 1][1]), pack2(v[2 * np + 1][2], v[2 * np + 1][3]));
        auto r0 = __builtin_amdgcn_permlane16_swap(a.x, b.x, false, false);
        auto r1 = __builtin_amdgcn_permlane16_swap(a.y, b.y, false, false);
        const int col = cb + (2 * np + (fq & 1)) * 16 + (fq >> 1) * 8;
        *(uint4*)(out + (size_t)row * e.ldo + col) = make_uint4(r0[0], r1[0], r0[1], r1[1]);
      }
    }
  } else {
    float* out = (float*)e.out;
    const int slot = (n0 >> 7) * 2 + wc;
#pragma unroll
    for (int mi = 0; mi < 8; ++mi) {
      const int row = m0 + wr * 128 + mi * 16 + fr;
      float sq = 0.f;
#pragma unroll
      for (int ni = 0; ni < 4; ++ni) {
        const int col = n0 + wc * 64 + ni * 16 + fq * 4;
        f32x4 v = acc[mi][ni];
        sq += v[0] * v[0] + v[1] * v[1] + v[2] * v[2] + v[3] * v[3];
        *(float4*)(out + (size_t)row * e.ldo + col) = make_float4(v[0], v[1], v[2], v[3]);
      }
      sq = xsum16(sq);
      sq = xsum32(sq);
      if (fq == 0) e.rsp[(size_t)row * 16 + slot] = sq;
    }
  }
  if (itn >= ntiles) break;
  it = itn;
  }
#undef G_COMPUTE
#undef G_STORE
#undef G_LOAD
}

__device__ __forceinline__ void rowprep_item(int item, const float* src, u16* dst, float* rinv) {
  const int tid = tidx(), lane = tid & 63, w = tid >> 6;
  const int row = item * 4 + w;
  float sq = 0.f;
#pragma unroll
  for (int i = 0; i < 4; ++i) {
    const int col = i * 256 + lane * 4;
    const float4 x = *(const float4*)(src + (size_t)row * 1024 + col);
    sq += x.x * x.x + x.y * x.y + x.z * x.z + x.w * x.w;
    *(uint2*)(dst + (size_t)row * 1024 + col) = make_uint2(pack2(x.x, x.y), pack2(x.z, x.w));
  }
  sq = wave_sum(sq);
  if (lane == 0) rinv[row] = rsqrtf(sq * (1.f / 1024.f) + EPSF);
}

DEVI int srccol_even(int n) {
  if (n < 8192) return n;
  if (n < 9216) return n + 32;
  if (n < 9248) return n - 1024;
  return -1;
}
__device__ __forceinline__ void wt_tile(const float* src, int Nsrc, const float* gain, u16* dst, int K, int kt, int nt, int evenmap, char* smem) {
  float (*tile)[65] = (float (*)[65])smem;
  const int tid = tidx(), r = tid >> 6, c = tid & 63;
  const int n = nt * 64 + c;
  const int sc = evenmap ? srccol_even(n) : n;
#pragma unroll
  for (int rr = r; rr < 64; rr += 4) {
    const int k = kt * 64 + rr;
    float v = 0.f;
    if (sc >= 0) v = src[(size_t)k * Nsrc + sc] * (gain ? gain[k] : 1.f);
    tile[rr][c] = v;
  }
  __syncthreads();
  {
    const int nl = tid >> 2, kq = tid & 3;
    unsigned pk[8];
#pragma unroll
    for (int i = 0; i < 8; ++i) pk[i] = pack2(tile[kq * 16 + 2 * i][nl], tile[kq * 16 + 2 * i + 1][nl]);
    u16* d = dst + (size_t)(nt * 64 + nl) * K + kt * 64 + kq * 16;
    *(uint4*)d = make_uint4(pk[0], pk[1], pk[2], pk[3]);
    *(uint4*)(d + 8) = make_uint4(pk[4], pk[5], pk[6], pk[7]);
  }
  __syncthreads();
}

__device__ __forceinline__ void filt_item(const P& p, int L, int pc, int cc, u16* Hr, char* smem) {
  float (*semb)[33] = (float (*)[33])smem;
  float (*sh1)[65] = (float (*)[65])(smem + 64 * 33 * 4);
  float (*sh2)[65] = (float (*)[65])(smem + 64 * 33 * 4 + 64 * 65 * 4);
  const int tid = tidx();
  for (int idx = tid; idx < 64 * 17; idx += 256) {
    const int i = idx / 17, b = idx % 17;
    const int t = pc * 64 + i;
    if (b == 16) {
      semb[i][0] = (float)t / (float)(L - 1);
    } else {
      const float f = 1e-4f + (float)b * ((15.f - 1e-4f) / 15.f);
      const float wv = (6.283185307179586f / (float)L) * (float)t;
      float sn, cs;
      fsincos(f * wv, &sn, &cs);
      semb[i][1 + b] = cs;
      semb[i][17 + b] = -sn;
    }
  }
  __syncthreads();
  {
    const int hh = tid & 63, ig = tid >> 6;
    const float fr_ = p.hy_freq[hh], b1 = p.hy_b1[hh];
    float a16[16];
#pragma unroll
    for (int r = 0; r < 16; ++r) a16[r] = b1;
    const float* wp = p.hy_w1 + hh;
#pragma unroll 1
    for (int e0 = 0; e0 < 33; e0 += 11) {
      float wv[11];
#pragma unroll
      for (int q = 0; q < 11; ++q) wv[q] = wp[(e0 + q) * 64];
#pragma unroll
      for (int q = 0; q < 11; ++q)
#pragma unroll
        for (int r = 0; r < 16; ++r) a16[r] += semb[ig * 16 + r][e0 + q] * wv[q];
    }
#pragma unroll
    for (int r = 0; r < 16; ++r) { float sn_, cs_; fsincos(fr_ * a16[r], &sn_, &cs_); sh1[ig * 16 + r][hh] = sn_; }
  }
  __syncthreads();
  {
    const int hh = tid & 63, ig = tid >> 6;
    const float fr_ = p.hy_freq[hh], b2 = p.hy_b2[hh];
    float a16[16];
#pragma unroll
    for (int r = 0; r < 16; ++r) a16[r] = b2;
    const float* wp = p.hy_w2 + hh;
#pragma unroll 1
    for (int k0 = 0; k0 < 64; k0 += 8) {
      float wv[8];
#pragma unroll
      for (int q = 0; q < 8; ++q) wv[q] = wp[(k0 + q) * 64];
#pragma unroll
      for (int q = 0; q < 8; ++q)
#pragma unroll
        for (int r = 0; r < 16; ++r) a16[r] += sh1[ig * 16 + r][k0 + q] * wv[q];
    }
#pragma unroll
    for (int r = 0; r < 16; ++r) { float sn_, cs_; fsincos(fr_ * a16[r], &sn_, &cs_); sh2[ig * 16 + r][hh] = sn_; }
  }
  __syncthreads();
  {
    const int c = cc * 256 + tid;
    const int ch = c & 1023;
    const bool bwd = c >= 1024;
    const float delta = 3.0701134573253946f + (float)ch * ((15.350567286626973f - 3.0701134573253946f) / 1023.f);
    const float skip = p.hy_skip[ch];
    u16* hr = Hr + (size_t)ch * (2 * L);
#pragma unroll 1
    for (int i0 = 0; i0 < 64; i0 += 8) {
      float acc8[8];
#pragma unroll
      for (int ii = 0; ii < 8; ++ii) acc8[ii] = 0.f;
      const float* wp = p.hy_w3 + c;
#pragma unroll 1
      for (int k0 = 0; k0 < 64; k0 += 8) {
        float wv[8];
#pragma unroll
        for (int q = 0; q < 8; ++q) wv[q] = wp[(size_t)(k0 + q) * 2048];
#pragma unroll
        for (int q = 0; q < 8; ++q)
#pragma unroll
          for (int ii = 0; ii < 8; ++ii) acc8[ii] += sh2[i0 + ii][k0 + q] * wv[q];
      }
#pragma unroll
      for (int ii = 0; ii < 8; ++ii) {
        const int t = pc * 64 + i0 + ii;
        float s = acc8[ii];
        const float tt = (float)t / (float)(L - 1);
        s *= __expf(-tt * delta);
        if (!bwd) {
          if (t == 0) s += skip;
          hr[L - 1 - t] = f2bf(s);
        } else if (t > 0) {
          hr[L - 1 + t] = f2bf(s);
        }
      }
    }
    if (bwd && pc == 0) hr[2 * L - 1] = 0;
  }
  __syncthreads();
}

__device__ __forceinline__ void hy_pre_item(const P& p, int L, int tt, int cq, const u16* z, u16* cat, u16* ut) {
  const int tid = tidx(), cg = tid & 31, tr = tid >> 5;
  const int c0 = cq * 128 + cg * 4;
  const int t0 = tt * 64 + tr * 8;
  float w[3][3][4], b[3][4];
#pragma unroll
  for (int s = 0; s < 3; ++s) {
#pragma unroll
    for (int j = 0; j < 3; ++j) {
      const float4 a = *(const float4*)(p.hy_conv_w + j * 3072 + s * 1024 + c0);
      w[s][j][0] = a.x; w[s][j][1] = a.y; w[s][j][2] = a.z; w[s][j][3] = a.w;
    }
    const float4 a = *(const float4*)(p.hy_conv_b + s * 1024 + c0);
    b[s][0] = a.x; b[s][1] = a.y; b[s][2] = a.z; b[s][3] = a.w;
  }
  uint2 prev[3], cur[3], nxt[3];
#pragma unroll
  for (int s = 0; s < 3; ++s) {
    prev[s] = ((t0 % L) > 0) ? *(const uint2*)(z + (size_t)(t0 - 1) * ZSE + E_HY + s * 1024 + c0) : make_uint2(0, 0);
    cur[s] = *(const uint2*)(z + (size_t)t0 * ZSE + E_HY + s * 1024 + c0);
  }
  unsigned up[4][4];
#pragma unroll
  for (int r = 0; r < 8; ++r) {
    const int t = t0 + r;
    const bool hasn = (t % L) < L - 1;
    float uc[3][4];
#pragma unroll
    for (int s = 0; s < 3; ++s) {
      nxt[s] = hasn ? *(const uint2*)(z + (size_t)(t + 1) * ZSE + E_HY + s * 1024 + c0) : make_uint2(0, 0);
      uc[s][0] = w[s][0][0] * lo2f(prev[s].x) + w[s][1][0] * lo2f(cur[s].x) + w[s][2][0] * lo2f(nxt[s].x) + b[s][0];
      uc[s][1] = w[s][0][1] * hi2f(prev[s].x) + w[s][1][1] * hi2f(cur[s].x) + w[s][2][1] * hi2f(nxt[s].x) + b[s][1];
      uc[s][2] = w[s][0][2] * lo2f(prev[s].y) + w[s][1][2] * lo2f(cur[s].y) + w[s][2][2] * lo2f(nxt[s].y) + b[s][2];
      uc[s][3] = w[s][0][3] * hi2f(prev[s].y) + w[s][1][3] * hi2f(cur[s].y) + w[s][2][3] * hi2f(nxt[s].y) + b[s][3];
      prev[s] = cur[s];
      cur[s] = nxt[s];
    }
    const uint2 g2 = *(const uint2*)(z + (size_t)t * ZSE + E_GHY + c0);
    *(uint2*)(cat + (size_t)t * 1024 + c0) = make_uint2(pack2(uc[0][0] * silu(lo2f(g2.x)), uc[0][1] * silu(hi2f(g2.x))),
                                                        pack2(uc[0][2] * silu(lo2f(g2.y)), uc[0][3] * silu(hi2f(g2.y))));
#pragma unroll
    for (int e2 = 0; e2 < 4; ++e2) {
      const unsigned hb = (unsigned)f2bf(uc[2][e2] * uc[1][e2]);
      if (r & 1) up[e2][r >> 1] |= hb << 16; else up[e2][r >> 1] = hb;
    }
  }
#pragma unroll
  for (int e2 = 0; e2 < 4; ++e2)
    *(uint4*)(ut + (size_t)(c0 + e2) * GT + t0) = make_uint4(up[e2][0], up[e2][1], up[e2][2], up[e2][3]);
}

__device__ __forceinline__ void hy_post_item(int tt, int cq, const u16* yt, const u16* gateA, u16* cat) {
  const int tid = tidx(), cg = tid & 31, tr = tid >> 5;
  const int c0 = cq * 128 + cg * 4;
  const int t0 = tt * 64 + tr * 8;
  unsigned yw[4][4];
#pragma unroll
  for (int e2 = 0; e2 < 4; ++e2) {
    const uint4 v = *(const uint4*)(yt + (size_t)(c0 + e2) * GT + t0);
    yw[e2][0] = v.x; yw[e2][1] = v.y; yw[e2][2] = v.z; yw[e2][3] = v.w;
  }
#pragma unroll
  for (int r = 0; r < 8; ++r) {
    u16* q = cat + (size_t)(t0 + r) * CATW + c0;
    const uint2 g = *(const uint2*)(gateA + (size_t)(t0 + r) * 1024 + c0);
    float y[4];
#pragma unroll
    for (int e2 = 0; e2 < 4; ++e2) y[e2] = (r & 1) ? hi2f(yw[e2][r >> 1]) : lo2f(yw[e2][r >> 1]);
    *(uint2*)q = make_uint2(pack2(lo2f(g.x) * y[0], hi2f(g.x) * y[1]), pack2(lo2f(g.y) * y[2], hi2f(g.y) * y[3]));
  }
}

__device__ __forceinline__ void hy_conv_item(int L, int nb, int ch, const u16* Hr, const u16* ut, u16* yt, char* smem) {
  unsigned* w0 = (unsigned*)smem;
  unsigned* w1 = w0 + L;
  u16* sU = (u16*)(w1 + L);
  constexpr int DL = 1024;
  const int S = 16 / nb;
  const int tid = tidx(), lane = tid & 63, w = tid >> 6, fr = lane & 15, fq = lane >> 4;
  {
    const u16* hr = Hr + (size_t)ch * 2 * L;
    const unsigned* hw = (const unsigned*)hr;
#pragma unroll 8
    for (int i = tid; i < L; i += 256) {
      const unsigned a = hw[i];
      const unsigned nx = (i + 1 < L) ? hw[i + 1] : 0u;
      w0[i] = a;
      if (i + 1 < L) w1[i] = (a >> 16) | (nx << 16);
    }
    const uint4* src = (const uint4*)(ut + (size_t)ch * GT);
    const int cpr = L / 8;
#pragma unroll
    for (int idx = tid; idx < GT / 8; idx += 256) {
      const int b = idx / cpr, q = idx % cpr;
      const int key = (b * S + ((q * 8) >> 10)) & 15;
      ((uint4*)sU)[b * cpr + (q ^ key)] = src[idx];
    }
  }
  __syncthreads();
  const int cs = fr / nb, cb = fr % nb;
  const int xl = L - 1 - fr + 8 * fq;
  const unsigned* wb = (xl & 1) ? (w1 + ((xl - 1) >> 1)) : (w0 + (xl >> 1));
  const uint4* urow = (const uint4*)sU + cb * (L / 8);
  const int mstart = -(S - 1) * DL;
#pragma unroll 1
  for (int pass = 0; pass < 2; ++pass) {
    const int n0 = (pass * 4 + w) * 128;
    f32x4 acc[8];
#pragma unroll
    for (int i = 0; i < 8; ++i) acc[i] = (f32x4){0.f, 0.f, 0.f, 0.f};
    union AF { unsigned u[4]; bf16x8 v; };
    AF ring[8];
#pragma unroll
    for (int i = 0; i < 8; ++i) {
      const unsigned* src = wb - ((n0 - mstart + 16 * i) >> 1);
      ring[i].u[0] = src[0]; ring[i].u[1] = src[1]; ring[i].u[2] = src[2]; ring[i].u[3] = src[3];
    }
#pragma unroll 1
    for (int m0 = mstart; m0 < L; m0 += 128) {
#pragma unroll
      for (int j = 0; j < 4; ++j) {
        const int mm = m0 + 32 * j;
        const int mb = mm + cs * DL;
        bf16x8 bfrag = {0, 0, 0, 0, 0, 0, 0, 0};
        if (mb >= 0 && mb < L) {
          const int mp = mb + 8 * fq;
          const int q = mp >> 3;
          const int key = (cb * S + (mp >> 10)) & 15;
          union { uint4 q4; bf16x8 v; } t;
          t.q4 = urow[q ^ key];
          bfrag = t.v;
        }
#pragma unroll
        for (int i = 0; i < 8; ++i)
          acc[i] = __builtin_amdgcn_mfma_f32_16x16x32_bf16(ring[(i - 2 * j) & 7].v, bfrag, acc[i], 0, 0, 0);
        if (mm + 32 < L) {
          const unsigned* s0 = wb - ((n0 - mm - 32) >> 1);
          AF& r0 = ring[(0 - 2 * (j + 1)) & 7];
          AF& r1 = ring[(1 - 2 * (j + 1)) & 7];
          r0.u[0] = s0[0]; r0.u[1] = s0[1]; r0.u[2] = s0[2]; r0.u[3] = s0[3];
          r1.u[0] = s0[-8]; r1.u[1] = s0[-7]; r1.u[2] = s0[-6]; r1.u[3] = s0[-5];
        }
      }
    }
#pragma unroll
    for (int i = 0; i < 8; ++i) {
      const int n = cs * DL + n0 + 16 * i + fq * 4;
      *(uint2*)(yt + (size_t)ch * GT + cb * L + n) = make_uint2(pack2(acc[i][0], acc[i][1]), pack2(acc[i][2], acc[i][3]));
    }
  }
  __syncthreads();
}

__device__ __forceinline__ void gdn_pre_item(const P& p, int L, int tt, int h, const u16* z, u16* qkvn, float* gba, u16* cat) {
  const int tid = tidx(), lane = tid & 63, w = tid >> 6;
  float cw[3][5][2];
#pragma unroll
  for (int s = 0; s < 3; ++s)
#pragma unroll
    for (int j = 0; j < 5; ++j) {
      cw[s][j][0] = p.gdn_conv_w[j * 3072 + s * 1024 + h * 128 + 2 * lane];
      cw[s][j][1] = p.gdn_conv_w[j * 3072 + s * 1024 + h * 128 + 2 * lane + 1];
    }
  const int t0 = tt * 64 + w * 16;
  const int seq0 = (t0 / L) * L;
  auto ld = [&](int t, int s) -> unsigned {
    if (t < seq0 || t >= seq0 + L) return 0u;
    return *(const unsigned*)(z + (size_t)t * ZSE + E_QKV + s * 1024 + h * 128 + 2 * lane);
  };
  unsigned win[3][5];
#pragma unroll
  for (int s = 0; s < 3; ++s) {
    win[s][0] = ld(t0 - 2, s);
    win[s][1] = ld(t0 - 1, s);
    win[s][2] = ld(t0, s);
    win[s][3] = ld(t0 + 1, s);
    win[s][4] = 0;
  }
#pragma unroll
  for (int r = 0; r < 16; ++r) {
    const int t = t0 + r;
    float y[3][2];
#pragma unroll
    for (int s = 0; s < 3; ++s) {
      win[s][4] = ld(t + 2, s);
      float a0 = 0.f, a1 = 0.f;
#pragma unroll
      for (int j = 0; j < 5; ++j) {
        a0 += lo2f(win[s][j]) * cw[s][j][0];
        a1 += hi2f(win[s][j]) * cw[s][j][1];
      }
      y[s][0] = silu(a0);
      y[s][1] = silu(a1);
#pragma unroll
      for (int j = 0; j < 4; ++j) win[s][j] = win[s][j + 1];
    }
    const float ssq = wave_sum(y[0][0] * y[0][0] + y[0][1] * y[0][1]);
    const float ssk = wave_sum(y[1][0] * y[1][0] + y[1][1] * y[1][1]);
    const float rq = rsqrtf(ssq + EPSF) * 0.08838834764831845f;
    const float rk = rsqrtf(ssk + EPSF);
    u16* dst = qkvn + ((size_t)t * 8 + h) * 384 + 2 * lane;
    *(unsigned*)dst = pack2(y[0][0] * rq, y[0][1] * rq);
    *(unsigned*)(dst + 128) = pack2(y[1][0] * rk, y[1][1] * rk);
    *(unsigned*)(dst + 256) = pack2(y[2][0], y[2][1]);
    {
      const unsigned gg = *(const unsigned*)(z + (size_t)t * ZSE + E_GG + h * 128 + 2 * lane);
      *(unsigned*)(cat + (size_t)t * 1024 + h * 128 + 2 * lane) = pack2(silu(lo2f(gg)), silu(hi2f(gg)));
    }
  }
  if (tid < 128) {
    const int t = tt * 64 + (tid >> 1), dir = tid & 1;
    const float zb = bf2f(z[(size_t)t * ZSE + E_BETA + dir * 8 + h]);
    const float za = bf2f(z[(size_t)t * ZSE + E_A + dir * 8 + h]);
    const float beta = 1.f / (1.f + __expf(-zb));
    const float xx = za + p.gdn_dt_bias[dir * 8 + h];
    const float sp = (xx > 20.f) ? xx : log1pf(__expf(xx));
    const float gl = -__expf(p.gdn_A_log[dir * 8 + h]) * sp;
    float* d = gba + (((size_t)t * 8 + h) * 2 + dir) * 2;
    d[0] = beta;
    d[1] = gl;
  }
}

constexpr int REC_ELEMS = 36864;
constexpr size_t OFF_GL = OFF_Z + (size_t)4096 * REC_ELEMS * 2;
static_assert(OFF_GL + 4096 * 4 <= OFF_CAT, "chunk records overflow z region");

__device__ __forceinline__ void gdn_chunk_item(int L, int r, const u16* qkvn, const float* gba, u16* rec_base, float* GL, char* smem) {
  const int NC = L / 64;
  const int n = r % NC, ci = r / NC;
  const int dir = ci & 1, h = (ci >> 1) & 7, bl = ci >> 4;
  u16* rec = rec_base + (size_t)r * REC_ELEMS;
  u16* sKb = (u16*)smem;
  u16* sQb = sKb + 64 * 136;
  float* sA = (float*)(smem + 2 * 17408);
  float* sG = (float*)(smem + 3 * 17408);
  float* sBeta = sG + 64;
  float* sg = sBeta + 64;
  const int tid = tidx(), lane = tid & 63, w = tid >> 6, fr = lane & 15, fq = lane >> 4;
  auto tok = [&](int c) -> int { const int pos = n * 64 + c; return bl * L + (dir ? (L - 1 - pos) : pos); };
  if (tid < 64) {
    const size_t o = (((size_t)tok(tid) * 8 + h) * 2 + dir) * 2;
    sBeta[tid] = gba[o];
    sg[tid] = gba[o + 1];
  }
  __syncthreads();
  if (tid < 64) {
    float sacc = 0.f;
    for (int l = 0; l <= tid; ++l) sacc += sg[l];
    sG[tid] = sacc;
  }
  __syncthreads();
#pragma unroll
  for (int it = 0; it < 8; ++it) {
    const int idx = it * 256 + tid, c = idx >> 5, c4 = idx & 31;
    const u16* src = qkvn + ((size_t)tok(c) * 8 + h) * 384 + c4 * 4;
    const uint2 q = *(const uint2*)src;
    const uint2 k = *(const uint2*)(src + 128);
    *(uint2*)(sQb + c * 136 + c4 * 4) = q;
    *(uint2*)(sKb + c * 136 + c4 * 4) = k;
    const float eg = __expf(sG[c]);
    *(uint2*)(rec + 16384 + c * 128 + c4 * 4) = make_uint2(pack2(lo2f(q.x) * eg, hi2f(q.x) * eg), pack2(lo2f(q.y) * eg, hi2f(q.y) * eg));
  }
  __syncthreads();
  {
    const int i = 16 * w + fr;
    bf16x8 kif[4], qif[4];
#pragma unroll
    for (int kk = 0; kk < 4; ++kk) {
      kif[kk] = *(const bf16x8*)(sKb + i * 136 + kk * 32 + fq * 8);
      qif[kk] = *(const bf16x8*)(sQb + i * 136 + kk * 32 + fq * 8);
    }
    const float Gi = sG[i], bi = sBeta[i];
#pragma unroll
    for (int jt = 0; jt < 4; ++jt) {
      f32x4 akk = (f32x4){0.f, 0.f, 0.f, 0.f}, aqk = (f32x4){0.f, 0.f, 0.f, 0.f};
      if (jt <= w) {
#pragma unroll
        for (int kk = 0; kk < 4; ++kk) {
          const bf16x8 kj = *(const bf16x8*)(sKb + (16 * jt + fr) * 136 + kk * 32 + fq * 8);
          akk = __builtin_amdgcn_mfma_f32_16x16x32_bf16(kj, kif[kk], akk, 0, 0, 0);
          aqk = __builtin_amdgcn_mfma_f32_16x16x32_bf16(kj, qif[kk], aqk, 0, 0, 0);
        }
      }
      float av[4], qv[4];
#pragma unroll
      for (int jj = 0; jj < 4; ++jj) {
        const int j = 16 * jt + 4 * fq + jj;
        const float dec = (j <= i) ? __expf(Gi - sG[j]) : 0.f;
        av[jj] = (j < i) ? bi * akk[jj] * dec : 0.f;
        qv[jj] = aqk[jj] * dec;
      }
      *(float4*)(sA + i * 68 + 16 * jt + 4 * fq) = make_float4(av[0], av[1], av[2], av[3]);
      *(uint2*)(rec + 32768 + i * 64 + 16 * jt + 4 * fq) = make_uint2(pack2(qv[0], qv[1]), pack2(qv[2], qv[3]));
    }
  }
  __syncthreads();
  {
    const int c = tid;
    const bool isU = c < 128;
    const int col = isU ? (256 + c) : c;
    float x[64];
#pragma unroll
    for (int i = 0; i < 64; ++i) x[i] = bf2f(qkvn[((size_t)tok(i) * 8 + h) * 384 + col]);
#pragma unroll
    for (int i = 0; i < 64; ++i) {
      float acc = x[i] * sBeta[i] * (isU ? 1.f : __expf(sG[i]));
      float ac1 = 0.f, ac2 = 0.f, ac3 = 0.f;
#pragma unroll
      for (int j4 = 0; j4 < (i + 3) / 4; ++j4) {
        const float4 a = *(const float4*)(sA + i * 68 + 4 * j4);
        acc -= a.x * x[4 * j4];
        if (4 * j4 + 1 < i) ac1 -= a.y * x[4 * j4 + 1];
        if (4 * j4 + 2 < i) ac2 -= a.z * x[4 * j4 + 2];
        if (4 * j4 + 3 < i) ac3 -= a.w * x[4 * j4 + 3];
      }
      x[i] = (acc + ac1) + (ac2 + ac3);
    }
    if (isU) {
      u16* dst = rec + (size_t)c * 64;
#pragma unroll
      for (int q8 = 0; q8 < 8; ++q8)
        *(uint4*)(dst + q8 * 8) = make_uint4(pack2(x[q8 * 8], x[q8 * 8 + 1]), pack2(x[q8 * 8 + 2], x[q8 * 8 + 3]),
                                             pack2(x[q8 * 8 + 4], x[q8 * 8 + 5]), pack2(x[q8 * 8 + 6], x[q8 * 8 + 7]));
    } else {
#pragma unroll
      for (int i = 0; i < 64; ++i) sQb[i * 136 + (c - 128)] = f2bf(x[i]);
    }
  }
  __syncthreads();
#pragma unroll
  for (int it = 0; it < 4; ++it) {
    const int idx = it * 256 + tid, row = idx >> 4, ch = idx & 15;
    *(uint4*)(rec + 8192 + row * 128 + ch * 8) = *(const uint4*)(sQb + row * 136 + ch * 8);
  }
  if (tid < 128) {
    const float Gl = sG[63];
    u16* dst = rec + 24576 + (size_t)tid * 64;
#pragma unroll
    for (int q8 = 0; q8 < 8; ++q8) {
      float v[8];
#pragma unroll
      for (int e2 = 0; e2 < 8; ++e2) {
        const int i = q8 * 8 + e2;
        v[e2] = bf2f(sKb[i * 136 + tid]) * __expf(Gl - sG[i]);
      }
      *(uint4*)(dst + q8 * 8) = make_uint4(pack2(v[0], v[1]), pack2(v[2], v[3]), pack2(v[4], v[5]), pack2(v[6], v[7]));
    }
  }
  if (tid == 0) GL[r] = __expf(sG[63]);
  __syncthreads();
}

__device__ __forceinline__ void gdn_cscan_item(int L, int ci, int half, const u16* rec_base, const float* GL, float* odir, char* smem) {
  const int NC = L / 64;
  const int dir = ci & 1, h = (ci >> 1) & 7, bl = ci >> 4;
  u16* sST = (u16*)smem;
  u16* sVT = sST + 64 * 136;
  const int tid = tidx(), lane = tid & 63, w = tid >> 6, fr = lane & 15, fq = lane >> 4;
  f32x4 S[2][4];
#pragma unroll
  for (int u = 0; u < 2; ++u)
#pragma unroll
    for (int t = 0; t < 4; ++t) S[u][t] = (f32x4){0.f, 0.f, 0.f, 0.f};
  for (int idx = tid; idx < 64 * 136 / 2; idx += 256) ((unsigned*)sST)[idx] = 0u;
  __syncthreads();
  bf16x8 nwf[4], nqgf[4], nqkf[2], nkdf[2][2];
  uint2 nut[4];
  float ngl;
#define SCAN_LOAD(nn)                                                                                             \
  {                                                                                                               \
    const u16* rec = rec_base + (size_t)(ci * NC + (nn)) * REC_ELEMS;                                             \
    ngl = GL[ci * NC + (nn)];                                                                                     \
    _Pragma("unroll") for (int kk = 0; kk < 4; ++kk) {                                                            \
      nwf[kk] = *(const bf16x8*)(rec + 8192 + (16 * w + fr) * 128 + kk * 32 + fq * 8);                            \
      nqgf[kk] = *(const bf16x8*)(rec + 16384 + (16 * w + fr) * 128 + kk * 32 + fq * 8);                          \
    }                                                                                                             \
    _Pragma("unroll") for (int kk = 0; kk < 2; ++kk) {                                                            \
      nqkf[kk] = *(const bf16x8*)(rec + 32768 + (16 * w + fr) * 64 + kk * 32 + fq * 8);                           \
      _Pragma("unroll") for (int u = 0; u < 2; ++u)                                                               \
        nkdf[u][kk] = *(const bf16x8*)(rec + 24576 + (32 * w + 16 * u + fr) * 64 + kk * 32 + fq * 8);             \
    }                                                                                                             \
    _Pragma("unroll") for (int t = 0; t < 4; ++t) nut[t] = *(const uint2*)(rec + (half * 64 + 16 * t + fr) * 64 + 16 * w + 4 * fq); \
  }
  SCAN_LOAD(0)
#pragma unroll 1
  for (int n = 0; n < NC; ++n) {
    const float gl = ngl;
    bf16x8 wf[4], qgf[4], qkf[2], kdf[2][2];
    uint2 ut[4];
#pragma unroll
    for (int kk = 0; kk < 4; ++kk) { wf[kk] = nwf[kk]; qgf[kk] = nqgf[kk]; }
#pragma unroll
    for (int kk = 0; kk < 2; ++kk) { qkf[kk] = nqkf[kk]; kdf[0][kk] = nkdf[0][kk]; kdf[1][kk] = nkdf[1][kk]; }
#pragma unroll
    for (int t = 0; t < 4; ++t) ut[t] = nut[t];
    if (n + 1 < NC) SCAN_LOAD(n + 1)
#pragma unroll
    for (int t = 0; t < 4; ++t) {
      f32x4 acc = (f32x4){0.f, 0.f, 0.f, 0.f};
#pragma unroll
      for (int kk = 0; kk < 4; ++kk) {
        const bf16x8 b = *(const bf16x8*)(sST + (16 * t + fr) * 136 + kk * 32 + fq * 8);
        acc = __builtin_amdgcn_mfma_f32_16x16x32_bf16(wf[kk], b, acc, 0, 0, 0);
      }
      const float v0 = lo2f(ut[t].x) - acc[0], v1 = hi2f(ut[t].x) - acc[1], v2 = lo2f(ut[t].y) - acc[2], v3 = hi2f(ut[t].y) - acc[3];
      *(uint2*)(sVT + (16 * t + fr) * 72 + 16 * w + 4 * fq) = make_uint2(pack2(v0, v1), pack2(v2, v3));
    }
    __syncthreads();
#pragma unroll
    for (int t = 0; t < 4; ++t) {
      f32x4 acc = (f32x4){0.f, 0.f, 0.f, 0.f};
#pragma unroll
      for (int kk = 0; kk < 4; ++kk) {
        const bf16x8 b = *(const bf16x8*)(sST + (16 * t + fr) * 136 + kk * 32 + fq * 8);
        acc = __builtin_amdgcn_mfma_f32_16x16x32_bf16(b, qgf[kk], acc, 0, 0, 0);
      }
#pragma unroll
      for (int kk = 0; kk < 2; ++kk) {
        const bf16x8 b = *(const bf16x8*)(sVT + (16 * t + fr) * 72 + kk * 32 + fq * 8);
        acc = __builtin_amdgcn_mfma_f32_16x16x32_bf16(b, qkf[kk], acc, 0, 0, 0);
      }
      {
        const int pos = n * 64 + 16 * w + fr;
        const int tk = bl * L + (dir ? (L - 1 - pos) : pos);
        *(float4*)(odir + (size_t)tk * 1024 + h * 128 + half * 64 + 16 * t + 4 * fq) = make_float4(acc[0], acc[1], acc[2], acc[3]);
      }
    }
#pragma unroll
    for (int u = 0; u < 2; ++u)
#pragma unroll
      for (int t = 0; t < 4; ++t) {
        f32x4 acc = S[u][t] * gl;
#pragma unroll
        for (int kk = 0; kk < 2; ++kk) {
          const bf16x8 b = *(const bf16x8*)(sVT + (16 * t + fr) * 72 + kk * 32 + fq * 8);
          acc = __builtin_amdgcn_mfma_f32_16x16x32_bf16(kdf[u][kk], b, acc, 0, 0, 0);
        }
        S[u][t] = acc;
      }
    __syncthreads();
#pragma unroll
    for (int u = 0; u < 2; ++u)
#pragma unroll
      for (int t = 0; t < 4; ++t)
        *(uint2*)(sST + (16 * t + fr) * 136 + 32 * w + 16 * u + 4 * fq) = make_uint2(pack2(S[u][t][0], S[u][t][1]), pack2(S[u][t][2], S[u][t][3]));
    __syncthreads();
  }
}

#undef SCAN_LOAD
__device__ __forceinline__ void gdn_post_item(const P& p, int tt, const float* of, const float* ob, const u16* gateB, u16* cat) {
  const int tid = tidx(), lane = tid & 63, w = tid >> 6;
  const int p4 = lane >> 4, d8 = (lane & 15) * 8;
  const float4 g0 = *(const float4*)(p.gdn_norm_g + d8), g1 = *(const float4*)(p.gdn_norm_g + d8 + 4);
#pragma unroll
  for (int it = 0; it < 4; ++it) {
    const int pr = w * 16 + it * 4 + p4;
    const int t = tt * 8 + (pr >> 3), h = pr & 7;
    const size_t o = (size_t)t * 1024 + h * 128 + d8;
    const float4 a0 = *(const float4*)(of + o), a1 = *(const float4*)(of + o + 4);
    const float4 b0 = *(const float4*)(ob + o), b1 = *(const float4*)(ob + o + 4);
    u16* cp = cat + (size_t)t * CATW + 1024 + h * 128 + d8;
    const uint4 gg = *(const uint4*)(gateB + (size_t)t * 1024 + h * 128 + d8);
    float x[8] = {a0.x + b0.x, a0.y + b0.y, a0.z + b0.z, a0.w + b0.w, a1.x + b1.x, a1.y + b1.y, a1.z + b1.z, a1.w + b1.w};
    float ss = 0.f;
#pragma unroll
    for (int e2 = 0; e2 < 8; ++e2) ss += x[e2] * x[e2];
    ss = row_sum16(ss);
    const float rinv = rsqrtf(ss * (1.f / 128.f) + EPSF);
    const float gn[8] = {g0.x, g0.y, g0.z, g0.w, g1.x, g1.y, g1.z, g1.w};
    const unsigned gw[4] = {gg.x, gg.y, gg.z, gg.w};
    unsigned ow[4];
#pragma unroll
    for (int q = 0; q < 4; ++q)
      ow[q] = pack2(x[2 * q] * rinv * gn[2 * q] * lo2f(gw[q]), x[2 * q + 1] * rinv * gn[2 * q + 1] * hi2f(gw[q]));
    *(uint4*)cp = make_uint4(ow[0], ow[1], ow[2], ow[3]);
  }
}

template <bool COPY>
__device__ __forceinline__ void resid_item(int item, const float* xin, const float* outb, const float* rsp, const float* g, float* dst, u16* xb, float* rinvb) {
  const int tid = tidx(), lane = tid & 63, w = tid >> 6;
  const int row = item * 4 + w;
  float s = 0.f;
#pragma unroll
  for (int i = 0; i < 16; ++i) s += rsp[(size_t)row * 16 + i];
  const float rinv = rsqrtf(s * (1.f / 1024.f) + EPSF);
  float sq = 0.f;
#pragma unroll
  for (int i = 0; i < 4; ++i) {
    const int col = i * 256 + lane * 4;
    float4 x = *(const float4*)(xin + (size_t)row * 1024 + col);
    float4 o = *(const float4*)(outb + (size_t)row * 1024 + col);
    float4 gg = *(const float4*)(g + col);
    float4 y = make_float4(x.x + o.x * rinv * gg.x, x.y + o.y * rinv * gg.y, x.z + o.z * rinv * gg.z, x.w + o.w * rinv * gg.w);
    *(float4*)(dst + (size_t)row * 1024 + col) = y;
    if (COPY) {
      sq += y.x * y.x + y.y * y.y + y.z * y.z + y.w * y.w;
      *(uint2*)(xb + (size_t)row * 1024 + col) = make_uint2(pack2(y.x, y.y), pack2(y.z, y.w));
    }
  }
  if (COPY) {
    sq = wave_sum(sq);
    if (lane == 0) rinvb[row] = rsqrtf(sq * (1.f / 1024.f) + EPSF);
  }
}

struct AttnIO {
  const u16* q; long qstep;
  const u16* k; const u16* v; long kstep;
  u16* o; long ostep;
  const u16* g; long gstep;
  float* lse; long lstep;
};

template <int DH, int NTW, int NCHUNK, int CHCOLS, int VSTR, bool MASK, int NH = 1>
__device__ __forceinline__ void attn_block(const AttnIO& io, int Lr, int q0, int HW, float scale, const float* sinkp, long hstep, char* smem) {
  u16* sV = (u16*)smem;
  const int tid = tidx(), lane = tid & 63, w = tid >> 6, fr = lane & 15, fq = lane >> 4;
  constexpr int NKK = DH / 32;
  constexpr int NDD = DH / 16;
  constexpr int SPC = NTW / 2 / NCHUNK;
  const int qw0 = q0 + 16 * w;
  const int kw0 = MASK ? (qw0 - HW) : 0;
  const int qp = qw0 + fr;
  const bool has_sink = (sinkp != nullptr);
  auto stage = [&](int c) {
    __syncthreads();
    const int k0c = MASK ? (q0 - HW) : c * CHCOLS;
    {
      constexpr int NIDX = CHCOLS * (DH / 8);
      constexpr int NIT = (NIDX + 255) / 256;
      uint4 vv[NIT];
#pragma unroll
      for (int q = 0; q < NIT; ++q) {
        const int idx = q * 256 + tid;
        const int col = idx % CHCOLS, dch = idx / CHCOLS;
        const int kp = k0c + col;
        vv[q] = make_uint4(0, 0, 0, 0);
        if (idx < NIDX && kp >= 0 && kp < Lr) vv[q] = *(const uint4*)(io.v + (long)kp * io.kstep + dch * 8);
      }
#pragma unroll
      for (int q = 0; q < NIT; ++q) {
        const int idx = q * 256 + tid;
        if (idx < NIDX) {
          const int col = idx % CHCOLS, dch = idx / CHCOLS;
          u16* d = sV + (dch * 8) * VSTR + col;
          d[0] = (u16)(vv[q].x & 0xffff); d[VSTR] = (u16)(vv[q].x >> 16);
          d[2 * VSTR] = (u16)(vv[q].y & 0xffff); d[3 * VSTR] = (u16)(vv[q].y >> 16);
          d[4 * VSTR] = (u16)(vv[q].z & 0xffff); d[5 * VSTR] = (u16)(vv[q].z >> 16);
          d[6 * VSTR] = (u16)(vv[q].w & 0xffff); d[7 * VSTR] = (u16)(vv[q].w >> 16);
        }
      }
    }
    __syncthreads();
  };
  if (NCHUNK == 1) stage(0);
#pragma unroll 1
  for (int hd = 0; hd < NH; ++hd) {
  const float sink = has_sink ? sinkp[hd] : 0.f;
  bf16x8 qf[NKK];
  {
    const u16* qptr = io.q + hd * hstep + (long)qp * io.qstep + fq * 8;
#pragma unroll
    for (int kk = 0; kk < NKK; ++kk) qf[kk] = *(const bf16x8*)(qptr + kk * 32);
  }
  f32x4 oacc[NDD];
#pragma unroll
  for (int dd = 0; dd < NDD; ++dd) oacc[dd] = (f32x4){0.f, 0.f, 0.f, 0.f};
  float m = has_sink ? sink : -1e30f;
  float den = 0.f;
#pragma unroll
  for (int c = 0; c < NCHUNK; ++c) {
    if (NCHUNK > 1) stage(c);
    auto kload = [&](bf16x8 (&dst)[2][NKK], int ktbase) {
#pragma unroll
      for (int tt = 0; tt < 2; ++tt) {
        const int kp = kw0 + 16 * (ktbase + tt) + fr;
        const bool valid = (kp >= 0) && (kp < Lr);
        const u16* kptr = io.k + (long)(valid ? kp : 0) * io.kstep + fq * 8;
#pragma unroll
        for (int kk = 0; kk < NKK; ++kk) {
          bf16x8 kf = {0, 0, 0, 0, 0, 0, 0, 0};
          if (valid) kf = *(const bf16x8*)(kptr + kk * 32);
          dst[tt][kk] = kf;
        }
      }
    };
    auto qk = [&](bf16x8 (&kf)[2][NKK], f32x4 (&st)[2]) {
#pragma unroll
      for (int tt = 0; tt < 2; ++tt) {
        st[tt] = (f32x4){0.f, 0.f, 0.f, 0.f};
#pragma unroll
        for (int kk = 0; kk < NKK; ++kk)
          st[tt] = __builtin_amdgcn_mfma_f32_16x16x32_bf16(kf[tt][kk], qf[kk], st[tt], 0, 0, 0);
      }
    };
    auto tail = [&](f32x4 (&st)[2], int kt0) {
      bool ok[2][4];
      float mloc = -1e30f;
#pragma unroll
      for (int tt = 0; tt < 2; ++tt)
#pragma unroll
        for (int j = 0; j < 4; ++j) {
          bool okv = true;
          if (MASK) {
            const int kp = kw0 + 16 * (kt0 + tt) + 4 * fq + j;
            const int dlt = qp - kp;
            okv = (kp >= 0) && (kp < Lr) && (dlt <= HW) && (dlt >= -HW);
          }
          ok[tt][j] = okv;
          const float sv = st[tt][j] * scale;
          st[tt][j] = sv;
          if (okv) mloc = fmaxf(mloc, sv);
        }
      mloc = xmax16(mloc);
      mloc = xmax32(mloc);
      const float mnew = fmaxf(m, mloc);
      const float alpha = __expf(m - mnew);
      m = mnew;
      float psum = 0.f;
#pragma unroll
      for (int tt = 0; tt < 2; ++tt)
#pragma unroll
        for (int j = 0; j < 4; ++j) {
          const float pv = ok[tt][j] ? __expf(st[tt][j] - mnew) : 0.f;
          st[tt][j] = pv;
          psum += pv;
        }
      den = den * alpha + psum;
      union { unsigned u[4]; bf16x8 v; } pf;
      pf.u[0] = pack2(st[0][0], st[0][1]);
      pf.u[1] = pack2(st[0][2], st[0][3]);
      pf.u[2] = pack2(st[1][0], st[1][1]);
      pf.u[3] = pack2(st[1][2], st[1][3]);
      const int cb0 = MASK ? (16 * w + 16 * kt0) : (16 * kt0 - c * CHCOLS);
      const int cb1 = cb0 + 16;
#pragma unroll
      for (int dd = 0; dd < NDD; ++dd) {
        const u16* vr = sV + (dd * 16 + fr) * VSTR + 4 * fq;
        union { uint2 h[2]; bf16x8 v; } vf;
        vf.h[0] = *(const uint2*)(vr + cb0);
        vf.h[1] = *(const uint2*)(vr + cb1);
        oacc[dd] = oacc[dd] * alpha;
        oacc[dd] = __builtin_amdgcn_mfma_f32_16x16x32_bf16(vf.v, pf.v, oacc[dd], 0, 0, 0);
      }
    };
    bf16x8 kfa[2][NKK], kfb[2][NKK];
    kload(kfa, 2 * (c * SPC));
    if (SPC > 1) kload(kfb, 2 * (c * SPC) + 2);
#pragma unroll 1
    for (int s2l = 0; s2l < SPC; s2l += 2) {
      {
        const int kt0 = 2 * (c * SPC + s2l);
        f32x4 st[2];
        qk(kfa, st);
        if (s2l + 2 < SPC) kload(kfa, kt0 + 4);
        tail(st, kt0);
      }
      if (s2l + 1 >= SPC) break;
      {
        const int kt0 = 2 * (c * SPC + s2l + 1);
        f32x4 st[2];
        qk(kfb, st);
        if (s2l + 3 < SPC) kload(kfb, kt0 + 4);
        tail(st, kt0);
      }
    }
  }
  den = xsum16(den);
  den = xsum32(den);
  if (has_sink) den += __expf(sink - m);
  const float rden = 1.f / den;
  u16* op = io.o + hd * hstep + (long)qp * io.ostep;
  const u16* gp = io.g ? (io.g + hd * hstep + (long)qp * io.gstep) : nullptr;
#pragma unroll
  for (int dd = 0; dd < NDD; ++dd) {
    const int d0 = dd * 16 + 4 * fq;
    float y0 = oacc[dd][0] * rden, y1 = oacc[dd][1] * rden, y2 = oacc[dd][2] * rden, y3 = oacc[dd][3] * rden;
    if (gp) {
      uint2 gg = *(const uint2*)(gp + d0);
      y0 *= silu(lo2f(gg.x)); y1 *= silu(hi2f(gg.x)); y2 *= silu(lo2f(gg.y)); y3 *= silu(hi2f(gg.y));
    }
    *(uint2*)(op + d0) = make_uint2(pack2(y0, y1), pack2(y2, y3));
  }
  if (io.lse && fq == 0) io.lse[(long)qp * io.lstep] = m + __logf(den);
  }
  __syncthreads();
}

__device__ __forceinline__ void xattn_item(int L, int nb, int item, int grp, const u16* z, int zs, int xq_col, int gx_col, const u16* mkv, u16* cat, int cat_col, char* smem) {
  const int nqb = L / 64;
  const int qb = item % nqb;
  const int rest = item / nqb;
  const int h = rest & 3, bl = rest >> 2;
  const int sq = (grp == 0) ? bl : (8 + (grp - 1) * 4 + bl);
  AttnIO io;
  io.q = z + (size_t)(bl * L) * zs + xq_col + h * 128; io.qstep = zs;
  io.k = mkv + (size_t)(sq * 256) * 1024 + h * 128;
  io.v = mkv + (size_t)(sq * 256) * 1024 + 512 + h * 128; io.kstep = 1024;
  io.o = cat + (size_t)(bl * L) * CATW + cat_col + h * 128; io.ostep = CATW;
  io.g = z + (size_t)(bl * L) * zs + gx_col + h * 128; io.gstep = zs;
  io.lse = nullptr; io.lstep = 0;
  attn_block<128, 16, 2, 128, 144, false>(io, 256, qb * 64, 0, 0.08838834764831845f, nullptr, 0, smem);
}

__global__ void __launch_bounds__(256, 2) mega(P p) {
  cg::grid_group grid = cg::this_grid();
  __shared__ __attribute__((aligned(16))) char smem[65536];
  const int nblk = gridDim.x, bid = blockIdx.x;
  char* ws = p.ws;
  XcdBarrier xb;
  xb.bar = (unsigned*)(ws + OFF_BAR); xb.x = xb_xcc_id(); xb.nloc = 0u; xb.nx = 0u;
  if (__builtin_amdgcn_workitem_id_x() == 0) (void)xb_add(&xb.bar[XB_XCNT(xb.x)], 1u);
  u16* wt_e_in = (u16*)(ws + OFF_WT_E_IN);
  u16* wt_o_in = (u16*)(ws + OFF_WT_O_IN);
  u16* wt_e_out = (u16*)(ws + OFF_WT_E_OUT);
  u16* wt_o_out = (u16*)(ws + OFF_WT_O_OUT);
  u16* wt_e_mkv = (u16*)(ws + OFF_WT_E_MKV);
  u16* wt_o_mkv = (u16*)(ws + OFF_WT_O_MKV);
  u16* mkv_e = (u16*)(ws + OFF_MKV_E);
  u16* mkv_o = (u16*)(ws + OFF_MKV_O);
  u16* hr_a = (u16*)(ws + OFF_HR_A);
  u16* hr_b = (u16*)(ws + OFF_HR_B);
  u16* z = (u16*)(ws + OFF_Z);
  u16* cat = (u16*)(ws + OFF_CAT);
  float* outb = (float*)(ws + OFF_OUT);
  float* rsp = (float*)(ws + OFF_RSP);
  u16* gateA = (u16*)(ws + OFF_OUT);
  u16* gateB = gateA + (size_t)GT * 1024;
  u16* ut = (u16*)(ws + OFF_UT);
  u16* yt = (u16*)(ws + OFF_YT);
  u16* qkvn = (u16*)(ws + OFF_QKVN);
  float* gba = (float*)(ws + OFF_GBA);
  float* of = (float*)(ws + OFF_OF);
  float* ob = (float*)(ws + OFF_OB);
  u16* og = (u16*)(ws + OFF_OG);
  float* lse = (float*)(ws + OFF_LSE);
  u16* xbf = (u16*)(ws + OFF_XB);
  float* rinvb = (float*)(ws + OFF_RINVB);
  u16* memb = (u16*)(ws + OFF_MEMB);
  float* rinvm = (float*)(ws + OFF_RINVM);

  {
    const int n_e_in = 16 * (ZSE / 64), n_o_in = 16 * (ZSO / 64), n_e_out = 40 * 16, n_o_out = 32 * 16, n_mkv = 16 * 16;
    const int n_f = 256 + 512;
    const int n_rp = GT / 4 + 6144 / 4;
    const int total = n_rp + n_e_in + n_o_in + n_e_out + n_o_out + 2 * n_mkv + n_f;
    REP(5) for (int it = bid; it < total; it += nblk) {
      int i = it;
      if (i < GT / 4) { rowprep_item(i, p.xp, xbf, rinvb); continue; }
      i -= GT / 4;
      if (i < 6144 / 4) { if (i < 512) rowprep_item(i, p.memp, memb, rinvm); else rowprep_item(i - 512, p.mems, memb + (size_t)2048 * 1024, rinvm + 2048); continue; }
      i -= 6144 / 4;
      if (i < n_e_in) { wt_tile(p.e_w_in, 9248, p.e_pre_g, wt_e_in, 1024, i & 15, i >> 4, 1, smem); continue; }
      i -= n_e_in;
      if (i < n_o_in) { wt_tile(p.o_w_in, 8448, p.o_pre_g, wt_o_in, 1024, i & 15, i >> 4, 0, smem); continue; }
      i -= n_o_in;
      if (i < n_e_out) { wt_tile(p.e_w_out, 1024, nullptr, wt_e_out, 2560, i % 40, i / 40, 0, smem); continue; }
      i -= n_e_out;
      if (i < n_o_out) { wt_tile(p.o_w_out, 1024, nullptr, wt_o_out, 2048, i % 32, i / 32, 0, smem); continue; }
      i -= n_o_out;
      if (i < n_mkv) { wt_tile(p.e_w_mkv, 1024, p.e_mem_g, wt_e_mkv, 1024, i & 15, i >> 4, 0, smem); continue; }
      i -= n_mkv;
      if (i < n_mkv) { wt_tile(p.o_w_mkv, 1024, p.o_mem_g, wt_o_mkv, 1024, i & 15, i >> 4, 0, smem); continue; }
      i -= n_mkv;
      if (i < 256) { filt_item(p, 2048, i >> 3, i & 7, hr_a, smem); continue; }
      i -= 256;
      filt_item(p, 4096, i >> 3, i & 7, hr_b, smem);
    }
  }
  grid.sync();
  for (int layer = 0; layer < 2; ++layer) {
    Epi e; e.out = layer ? mkv_o : mkv_e; e.ldo = 1024; e.rsp = nullptr; e.L = 1; e.rinv = rinvm;
    gemm_phase<0>(bid, nblk, 24 * 8, 24, memb, 1024, layer ? wt_o_mkv : wt_e_mkv, 1024, e, smem);
  }
  xcd_barrier(xb);

  for (int grp = 0; grp < NGROUP; ++grp) {
    const int L = (grp == 0) ? 2048 : 4096;
    const int nb = GT / L;
    const float* xg = (grp == 0) ? p.xp : (p.xs + (size_t)(grp - 1) * GT * 1024);
    float* dg = p.out + (size_t)grp * GT * 1024;
    const u16* hr = (grp == 0) ? hr_a : hr_b;

    REP(0) {
      Epi e; e.out = z; e.ldo = ZSE; e.rsp = nullptr; e.L = L; e.rinv = rinvb;
      gemm_phase<0>(bid, nblk, 64 * 73, 64, xbf, 1024, wt_e_in, 1024, e, smem);
    }
    xcd_barrier(xb);
    {
      const int n_hy = 256 * 8, n_gd = 256 * 8, n_x = 1024;
      REP(1) for (int it = bid; it < n_hy + n_gd + n_x; it += nblk) {
        int i = it;
        if (i < n_x) { xattn_item(L, nb, i, grp, z, ZSE, E_XQ, E_GX, mkv_e, cat, 2048, smem); continue; }
        i -= n_x;
        if (i < n_gd) { gdn_pre_item(p, L, i >> 3, i & 7, z, qkvn, gba, gateB); continue; }
        i -= n_gd;
        hy_pre_item(p, L, i >> 3, i & 7, z, gateA, ut);
      }
    }
    xcd_barrier(xb);
    REP(4) for (int it = bid; it < 4096; it += nblk) gdn_chunk_item(L, it, qkvn, gba, z, (float*)(ws + OFF_GL), smem);
    xcd_barrier(xb);
    {
      const int n_scan = nb * 32;
      REP(2) {
      if (bid < n_scan) {
        const int ci = bid >> 1, half = bid & 1;
        gdn_cscan_item(L, ci, half, z, (const float*)(ws + OFF_GL), (ci & 1) ? ob : of, smem);
      }
      unsigned* hctr = (unsigned*)(ws + OFF_BAR) + 3600 + grp + 8 * rep_;
      volatile unsigned* slot = (volatile unsigned*)(smem + (2 * L - 1) * 4);
      for (;;) {
        __syncthreads();
        if (__builtin_amdgcn_workitem_id_x() == 0) *slot = atomicAdd(hctr, 1u);
        __syncthreads();
        const unsigned chn = *slot;
        if (chn >= 1024u) break;
        hy_conv_item(L, nb, (int)chn, hr, ut, yt, smem);
      }
      }
    }
    xcd_barrier(xb);
    {
      const int n_hy = 256 * 8, n_gd = GT / 8;
      REP(6) for (int it = bid; it < n_hy + n_gd; it += nblk) {
        if (it < n_hy) hy_post_item(it >> 3, it & 7, yt, gateA, cat);
        else gdn_post_item(p, it - n_hy, of, ob, gateB, cat);
      }
    }
    xcd_barrier(xb);
    REP(0) {
      Epi e; e.out = outb; e.ldo = 1024; e.rsp = rsp; e.L = L; e.rinv = nullptr;
      gemm_phase<2>(bid, nblk, 64 * 8, 64, cat, CATW, wt_e_out, 2560, e, smem);
    }
    xcd_barrier(xb);
    for (int it = bid; it < GT / 4; it += nblk) resid_item<true>(it, xg, outb, rsp, p.e_post_g, dg, xbf, rinvb);
    xcd_barrier(xb);
    REP(0) {
      Epi e; e.out = z; e.ldo = ZSO; e.rsp = nullptr; e.L = L; e.rinv = rinvb;
      gemm_phase<1>(bid, nblk, 64 * 66, 64, xbf, 1024, wt_o_in, 1024, e, smem);
    }
    xcd_barrier(xb);
    {
      const int n_dil = 3072, n_swa = 512, n_x = 1024;
      REP(3) for (int it = bid; it < n_dil + n_swa + n_x; it += nblk) {
        int i = it;
        if (i < n_swa) {
          const int kvh = i & 1, rem = i >> 1;
          const int nqb = L / 64, qb = rem % nqb, bl = rem / nqb;
          const int qh = kvh * 8;
          AttnIO io;
          io.q = z + (size_t)(bl * L) * ZSO + O_DQ + qh * 64; io.qstep = ZSO;
          io.k = z + (size_t)(bl * L) * ZSO + O_DK + kvh * 64;
          io.v = z + (size_t)(bl * L) * ZSO + O_DV + kvh * 64; io.kstep = ZSO;
          io.o = cat + (size_t)(bl * L) * CATW + 512 + qh * 64; io.ostep = CATW;
          io.g = z + (size_t)(bl * L) * ZSO + O_GD + qh * 64; io.gstep = ZSO;
          io.lse = nullptr; io.lstep = 0;
          attn_block<64, 18, 1, 336, 336, true, 8>(io, L, qb * 64, 128, 0.125f, p.swa_sink + qh, 64, smem);
          continue;
        }
        i -= n_swa;
        if (i < n_dil) {
          const int gi = i >> 10, rem = i & 1023;
          const int h = rem & 3, rem2 = rem >> 2;
          const int d = (gi == 0) ? 1 : (gi == 1 ? 4 : 16);
          const int Lr = L / d, nqb = Lr / 64;
          const int qb = rem2 % nqb, rem3 = rem2 / nqb;
          const int r = rem3 % d, bl = rem3 / d;
          const size_t row0 = (size_t)bl * L + r;
          AttnIO io;
          io.q = z + row0 * ZSO + O_CQ + gi * 512 + h * 128; io.qstep = (long)d * ZSO;
          io.k = z + row0 * ZSO + O_CK + gi * 512 + h * 128;
          io.v = z + row0 * ZSO + O_CV + gi * 512 + h * 128; io.kstep = (long)d * ZSO;
          io.o = og + row0 * 1536 + gi * 512 + h * 128; io.ostep = (long)d * 1536;
          io.g = nullptr; io.gstep = 0;
          io.lse = lse + row0 * 12 + gi * 4 + h; io.lstep = (long)d * 12;
          attn_block<128, 10, 1, 208, 208, true>(io, Lr, qb * 64, 64, 0.08838834764831845f, nullptr, 0, smem);
          continue;
        }
        i -= n_dil;
        xattn_item(L, nb, i, grp, z, ZSO, O_XQ, O_GX, mkv_o, cat, 1536, smem);
      }
    }
    xcd_barrier(xb);
    for (int it = bid; it < GT / 4; it += nblk) {
      const int tid = tidx(), lane = tid & 63, w = tid >> 6;
      const int t = it * 4 + w;
      const int h = lane >> 4, d0 = (lane & 15) * 8;
      const float l0 = lse[(size_t)t * 12 + h], l1 = lse[(size_t)t * 12 + 4 + h], l2 = lse[(size_t)t * 12 + 8 + h];
      const float mx = fmaxf(l0, fmaxf(l1, l2));
      float w0 = __expf(l0 - mx), w1 = __expf(l1 - mx), w2 = __expf(l2 - mx);
      const float rs = 1.f / (w0 + w1 + w2);
      w0 *= rs; w1 *= rs; w2 *= rs;
      uint4 a = *(const uint4*)(og + (size_t)t * 1536 + h * 128 + d0);
      uint4 b = *(const uint4*)(og + (size_t)t * 1536 + 512 + h * 128 + d0);
      uint4 c = *(const uint4*)(og + (size_t)t * 1536 + 1024 + h * 128 + d0);
      uint4 g = *(const uint4*)(z + (size_t)t * ZSO + O_GC + h * 128 + d0);
      unsigned au[4] = {a.x, a.y, a.z, a.w}, bu[4] = {b.x, b.y, b.z, b.w}, cu[4] = {c.x, c.y, c.z, c.w}, gu[4] = {g.x, g.y, g.z, g.w};
      unsigned ru[4];
#pragma unroll
      for (int i = 0; i < 4; ++i) {
        const float ylo = (w0 * lo2f(au[i]) + w1 * lo2f(bu[i]) + w2 * lo2f(cu[i])) * silu(lo2f(gu[i]));
        const float yhi = (w0 * hi2f(au[i]) + w1 * hi2f(bu[i]) + w2 * hi2f(cu[i])) * silu(hi2f(gu[i]));
        ru[i] = pack2(ylo, yhi);
      }
      *(uint4*)(cat + (size_t)t * CATW + h * 128 + d0) = make_uint4(ru[0], ru[1], ru[2], ru[3]);
    }
    xcd_barrier(xb);
    REP(0) {
      Epi e; e.out = outb; e.ldo = 1024; e.rsp = rsp; e.L = L; e.rinv = nullptr;
      gemm_phase<2>(bid, nblk, 64 * 8, 64, cat, CATW, wt_o_out, 2048, e, smem);
    }
    if (grp + 1 < NGROUP) {
      const float* xn = p.xs + (size_t)grp * GT * 1024;
      for (int it = nblk - 1 - bid; it < GT / 4; it += nblk) rowprep_item(it, xn, xbf, rinvb);
    }
    xcd_barrier(xb);
    for (int it = bid; it < GT / 4; it += nblk) resid_item<false>(it, dg, outb, rsp, p.o_post_g, dg, nullptr, nullptr);
  }
}

extern "C" void kernel_launch(void* const* d_in, const int* in_sizes, int n_in, void* d_out, int out_size, void* d_ws,
                              size_t ws_size, hipStream_t stream) {
  static int grid_blocks = 0;
  if (!grid_blocks) {
    int dev = 0, cus = 0, per_cu = 0;
    hipGetDevice(&dev);
    hipDeviceGetAttribute(&cus, hipDeviceAttributeMultiprocessorCount, dev);
    hipOccupancyMaxActiveBlocksPerMultiprocessor(&per_cu, mega, 256, 0);
    if (per_cu > 2) per_cu = 2;
    if (per_cu < 1) per_cu = 1;
    grid_blocks = cus * per_cu;
  }
  P p{};
  const float** f = (const float**)&p;
  for (int i = 0; i < 30; ++i) f[i] = (const float*)d_in[i];
  p.out = (float*)d_out;
  p.ws = (char*)d_ws;
  hipMemsetAsync((char*)d_ws + OFF_BAR, 0, 16384, stream);
  void* args[] = {&p};
  hipError_t e = hipLaunchCooperativeKernel((void*)mega, dim3(grid_blocks), dim3(256), args, 0, stream);
  if (e != hipSuccess) fprintf(stderr, "cooperative launch failed: %s (grid %d)\n", hipGetErrorString(e), grid_blocks);
}
```

```cpp
#include <hip/hip_runtime.h>
#include <hip/hip_cooperative_groups.h>
#include <cstdio>
namespace cg = cooperative_groups;

typedef unsigned short u16;
typedef __attribute__((ext_vector_type(8))) short bf16x8;
typedef __attribute__((ext_vector_type(4))) float f32x4;

#define DEVI __device__ __forceinline__
#define EPSF 1e-6f

#ifndef DUPMASK
#define DUPMASK 0
#endif
#define REP(k) for (int rep_ = 0; rep_ < 1 + ((DUPMASK >> (k)) & 1); ++rep_)
constexpr int GT = 16384;
constexpr int NGROUP = 5;
constexpr int ZSE = 9344;
constexpr int ZSO = 8448;
constexpr int CATW = 2560;
constexpr int E_HY = 0, E_GHY = 3072, E_QKV = 4096, E_GG = 7168, E_XQ = 8192, E_GX = 8704, E_BETA = 9216, E_A = 9232;
constexpr int O_CQ = 0, O_CK = 1536, O_CV = 3072, O_GC = 4608, O_DQ = 5120, O_DK = 6144, O_DV = 6272, O_GD = 6400, O_XQ = 7424, O_GX = 7936;

constexpr size_t OFF_WT_E_IN  = 0;
constexpr size_t OFF_WT_O_IN  = OFF_WT_E_IN  + (size_t)ZSE * 1024 * 2;
constexpr size_t OFF_WT_E_OUT = OFF_WT_O_IN  + (size_t)ZSO * 1024 * 2;
constexpr size_t OFF_WT_O_OUT = OFF_WT_E_OUT + (size_t)1024 * 2560 * 2;
constexpr size_t OFF_WT_E_MKV = OFF_WT_O_OUT + (size_t)1024 * 2048 * 2;
constexpr size_t OFF_WT_O_MKV = OFF_WT_E_MKV + (size_t)1024 * 1024 * 2;
constexpr size_t OFF_MKV_E    = OFF_WT_O_MKV + (size_t)1024 * 1024 * 2;
constexpr size_t OFF_MKV_O    = OFF_MKV_E    + (size_t)6144 * 1024 * 2;
constexpr size_t OFF_HR_A     = OFF_MKV_O    + (size_t)6144 * 1024 * 2;
constexpr size_t OFF_HR_B     = OFF_HR_A     + (size_t)1024 * 4096 * 2;
constexpr size_t OFF_Z        = OFF_HR_B     + (size_t)1024 * 8192 * 2;
constexpr size_t OFF_CAT      = OFF_Z        + (size_t)GT * ZSE * 2;
constexpr size_t OFF_OUT      = OFF_CAT      + (size_t)GT * CATW * 2;
constexpr size_t OFF_RSP      = OFF_OUT      + (size_t)GT * 1024 * 4;
constexpr size_t OFF_UT       = OFF_RSP      + (size_t)GT * 16 * 4;
constexpr size_t OFF_YT       = OFF_UT       + (size_t)1024 * GT * 2;
constexpr size_t OFF_QKVN     = OFF_YT       + (size_t)1024 * GT * 2;
constexpr size_t OFF_GBA      = OFF_QKVN     + (size_t)GT * 3072 * 4;
constexpr size_t OFF_OF       = OFF_GBA      + (size_t)GT * 32 * 4;
constexpr size_t OFF_OB       = OFF_OF       + (size_t)GT * 1024 * 4;
constexpr size_t OFF_END      = OFF_OB       + (size_t)GT * 1024 * 4;
constexpr size_t OFF_OG       = OFF_QKVN;
constexpr size_t OFF_LSE      = OFF_OG + (size_t)GT * 1536 * 2;
constexpr size_t OFF_BAR      = OFF_END;
constexpr size_t OFF_XB       = OFF_BAR + 16384;
constexpr size_t OFF_RINVB    = OFF_XB + (size_t)GT * 1024 * 2;
constexpr size_t OFF_MEMB     = OFF_RINVB + (size_t)GT * 4;
constexpr size_t OFF_RINVM    = OFF_MEMB + (size_t)6144 * 1024 * 2;
static_assert(OFF_RINVM + 6144 * 4 <= (size_t)1 << 30, "workspace too large");

struct P {
  const float *xp, *xs, *memp, *mems;
  const float *e_pre_g, *e_post_g, *e_w_in, *e_w_out, *hy_conv_w, *hy_conv_b, *hy_w1, *hy_b1, *hy_w2, *hy_b2, *hy_w3,
      *hy_freq, *hy_skip, *gdn_conv_w, *gdn_A_log, *gdn_dt_bias, *gdn_norm_g, *e_mem_g, *e_w_mkv;
  const float *o_pre_g, *o_post_g, *o_w_in, *o_w_out, *swa_sink, *o_mem_g, *o_w_mkv;
  float* out;
  char* ws;
};

DEVI int tidx() { int t = __builtin_amdgcn_workitem_id_x(); asm volatile("" : "+v"(t)); return t; }
DEVI u16 f2bf(float f) {
  unsigned u = __float_as_uint(f);
  u += 0x7fffu + ((u >> 16) & 1u);
  return (u16)(u >> 16);
}
DEVI float bf2f(u16 h) { return __uint_as_float(((unsigned)h) << 16); }
DEVI unsigned pack2(float a, float b) { return (unsigned)f2bf(a) | ((unsigned)f2bf(b) << 16); }
DEVI float lo2f(unsigned u) { return __uint_as_float(u << 16); }
DEVI float hi2f(unsigned u) { return __uint_as_float(u & 0xffff0000u); }
DEVI float silu(float x) { return x / (1.f + __expf(-x)); }
DEVI void fsincos(float x, float* sn, float* cs) {
  const float k = rintf(x * 0.15915494309189535f);
  float r = fmaf(-k, 6.28125f, x);
  r = fmaf(-k, 0.0019353071795864769f, r);
  *sn = __sinf(r);
  *cs = __cosf(r);
}
#define DPP_ADD(v, ctrl) ((v) + __int_as_float(__builtin_amdgcn_mov_dpp(__float_as_int(v), (ctrl), 0xf, 0xf, true)))
DEVI float wave_sum(float v) {
  v = DPP_ADD(v, 0xB1);
  v = DPP_ADD(v, 0x4E);
  v = DPP_ADD(v, 0x141);
  v = DPP_ADD(v, 0x140);
  const float r0 = __int_as_float(__builtin_amdgcn_readlane(__float_as_int(v), 0));
  const float r1 = __int_as_float(__builtin_amdgcn_readlane(__float_as_int(v), 16));
  const float r2 = __int_as_float(__builtin_amdgcn_readlane(__float_as_int(v), 32));
  const float r3 = __int_as_float(__builtin_amdgcn_readlane(__float_as_int(v), 48));
  return (r0 + r1) + (r2 + r3);
}


DEVI float xmax16(float v) { auto r = __builtin_amdgcn_permlane16_swap(__float_as_uint(v), __float_as_uint(v), false, false); return fmaxf(__uint_as_float(r[0]), __uint_as_float(r[1])); }
DEVI float xmax32(float v) { auto r = __builtin_amdgcn_permlane32_swap(__float_as_uint(v), __float_as_uint(v), false, false); return fmaxf(__uint_as_float(r[0]), __uint_as_float(r[1])); }
DEVI float xsum16(float v) { auto r = __builtin_amdgcn_permlane16_swap(__float_as_uint(v), __float_as_uint(v), false, false); return __uint_as_float(r[0]) + __uint_as_float(r[1]); }
DEVI float xsum32(float v) { auto r = __builtin_amdgcn_permlane32_swap(__float_as_uint(v), __float_as_uint(v), false, false); return __uint_as_float(r[0]) + __uint_as_float(r[1]); }
DEVI float row_sum16(float v) {
  v = DPP_ADD(v, 0xB1); v = DPP_ADD(v, 0x4E); v = DPP_ADD(v, 0x141); v = DPP_ADD(v, 0x140);
  return v;
}

#define XB_TMO      128
#define XB_XCNT(j)  (256  + 64 * (j))
#define XB_XSUB(j)  (1280 + 64 * (j))
#define XB_XGEN(j)  (2304 + 64 * (j))
#define XB_TOP      3328
#define XB_TOPGEN   3392
#define XCD_BAR_WORDS 3456
#define XB_SPIN_CAP (1u << 22)
DEVI unsigned xb_ld(unsigned* p) { return __hip_atomic_load(p, __ATOMIC_RELAXED, __HIP_MEMORY_SCOPE_AGENT); }
DEVI unsigned xb_add(unsigned* p, unsigned v) { return __hip_atomic_fetch_add(p, v, __ATOMIC_RELAXED, __HIP_MEMORY_SCOPE_AGENT); }
DEVI unsigned xb_xcc_id() { return (unsigned)__builtin_amdgcn_s_getreg((3 << 11) | 20) & 0xFu; }
#define XB_SPIN(cond, bar) do { unsigned _sp = 0; while (cond) { __builtin_amdgcn_s_sleep(1); \
    if ((++_sp & 255u) == 0u) { if (xb_ld(&(bar)[XB_TMO])) break; if (_sp > XB_SPIN_CAP) { atomicAdd(&(bar)[XB_TMO], 1u); break; } } } } while (0)
struct XcdBarrier { unsigned* bar; unsigned x; unsigned nloc; unsigned nx; };
DEVI void xcd_barrier_complete(unsigned* bar, unsigned x, unsigned& nloc, unsigned& nx) {
  const unsigned G = gridDim.x;
  unsigned sum, cnt, mine, sp = 0u;
  for (;;) {
    sum = 0u; cnt = 0u; mine = 0u;
#pragma unroll
    for (unsigned j = 0; j < 16; ++j) { const unsigned c = xb_ld(&bar[XB_XCNT(j)]); sum += c; cnt += (c > 0u) ? 1u : 0u; mine = (j == x) ? c : mine; }
    if (sum == G) break;
    __builtin_amdgcn_s_sleep(1);
    if ((++sp & 255u) == 0u) { if (xb_ld(&bar[XB_TMO])) break; if (sp > XB_SPIN_CAP) { atomicAdd(&bar[XB_TMO], 1u); break; } }
  }
  nloc = mine > 0u ? mine : 1u; nx = cnt > 0u ? cnt : 1u;
}
DEVI void xcd_barrier(XcdBarrier& b) {
  asm volatile("s_waitcnt vmcnt(0)" ::: "memory");
  __syncthreads();
  if (__builtin_amdgcn_workitem_id_x() == 0) {
    unsigned* bar = b.bar;
    __builtin_amdgcn_s_waitcnt(0);
    if (b.nloc == 0u) xcd_barrier_complete(bar, b.x, b.nloc, b.nx);
    const unsigned nloc = b.nloc, nx = b.nx;
    const unsigned old = xb_add(&bar[XB_XSUB(b.x)], 1u);
    const unsigned gen = old / nloc;
    if (old + 1u == (gen + 1u) * nloc) {
      __builtin_amdgcn_fence(__ATOMIC_RELEASE, "agent");
      asm volatile("s_waitcnt vmcnt(0)" ::: "memory");
      const unsigned og = xb_add(&bar[XB_TOP], 1u);
      const unsigned tg = og / nx;
      if (og + 1u == (tg + 1u) * nx) xb_add(&bar[XB_TOPGEN], 1u);
      else XB_SPIN(xb_ld(&bar[XB_TOPGEN]) == tg, bar);
      __builtin_amdgcn_fence(__ATOMIC_ACQUIRE, "agent");
      xb_add(&bar[XB_XGEN(b.x)], 1u);
      asm volatile("s_waitcnt vmcnt(0)" ::: "memory");
    } else {
      XB_SPIN(xb_ld(&bar[XB_XGEN(b.x)]) == gen, bar);
      __builtin_amdgcn_fence(__ATOMIC_ACQUIRE, "agent");
      asm volatile("s_waitcnt vmcnt(0)" ::: "memory");
    }
  }
  __syncthreads();
}

struct Epi { void* out; int ldo; float* rsp; int L; const float* rinv; };

template <int EPI>
__device__ __forceinline__ void gemm_phase(int first, int stride, int ntiles, int tmc, const u16* Abase, int lda, const u16* Wbase, int K, const Epi& e, char* smem) {
  const int tid = tidx(), lane = tid & 63, w = tid >> 6, wr = w >> 1, wc = w & 1, fr = lane & 15, fq = lane >> 4;
  const int gr = tid >> 2, gp = tid & 3;
  int it = first;
  if (it >= ntiles) return;
  const u16* Ab = Abase + (size_t)((it % tmc) * 256 + gr) * lda + gp * 8;
  const u16* Wp = Wbase + (size_t)((it / tmc) * 128 + gr) * K + gp * 8;
  const size_t a64 = (size_t)64 * lda, w64 = (size_t)64 * K;
  char* stA = smem + gr * 64 + ((gp ^ (((gr >> 3) & 1) * 3)) * 16);
  char* stB = stA + 16384;
  const int cho = (fq ^ ((fr >> 3) * 3)) * 16;
  const char* rdA = smem + (wr * 128 + fr) * 64 + cho;
  const char* rdB = smem + 16384 + (wc * 64 + fr) * 64 + cho;
  uint4 ra0_0, ra0_1, ra0_2, ra0_3, rb0_0, rb0_1, ra1_0, ra1_1, ra1_2, ra1_3, rb1_0, rb1_1;
  const int nk = K / 32;
#define G_LOAD(u, k0) ra##u##_0 = *(const uint4*)(Ab + (k0)); ra##u##_1 = *(const uint4*)(Ab + a64 + (k0)); ra##u##_2 = *(const uint4*)(Ab + 2 * a64 + (k0)); ra##u##_3 = *(const uint4*)(Ab + 3 * a64 + (k0)); \
                      rb##u##_0 = *(const uint4*)(Wp + (k0)); rb##u##_1 = *(const uint4*)(Wp + w64 + (k0));
#define G_STORE(u, stg) { char* pa_ = stA + (stg) * 24576; char* pb_ = stB + (stg) * 24576; \
    *(uint4*)pa_ = ra##u##_0; *(uint4*)(pa_ + 4096) = ra##u##_1; *(uint4*)(pa_ + 8192) = ra##u##_2; *(uint4*)(pa_ + 12288) = ra##u##_3; \
    *(uint4*)pb_ = rb##u##_0; *(uint4*)(pb_ + 4096) = rb##u##_1; }
#define G_COMPUTE(stg) { const char* qa_ = rdA + (stg) * 24576; const char* qb_ = rdB + (stg) * 24576; bf16x8 fb_[4]; \
    _Pragma("unroll") for (int ni = 0; ni < 4; ++ni) fb_[ni] = *(const bf16x8*)(qb_ + ni * 1024); \
    _Pragma("unroll") for (int mh = 0; mh < 2; ++mh) { bf16x8 fa_[4]; \
      _Pragma("unroll") for (int mi = 0; mi < 4; ++mi) fa_[mi] = *(const bf16x8*)(qa_ + (mh * 4 + mi) * 1024); \
      __builtin_amdgcn_s_setprio(1); \
      _Pragma("unroll") for (int mi = 0; mi < 4; ++mi) _Pragma("unroll") for (int ni = 0; ni < 4; ++ni) \
        acc[mh * 4 + mi][ni] = __builtin_amdgcn_mfma_f32_16x16x32_bf16(fb_[ni], fa_[mi], acc[mh * 4 + mi][ni], 0, 0, 0); \
      __builtin_amdgcn_s_setprio(0); } }
  G_LOAD(0, 0) G_LOAD(1, 32)
#pragma unroll 1
  for (;;) {
  const int m0 = (it % tmc) * 256, n0 = (it / tmc) * 128;
  f32x4 acc[8][4];
#pragma unroll
  for (int i = 0; i < 8; ++i)
#pragma unroll
    for (int j = 0; j < 4; ++j) acc[i][j] = (f32x4){0.f, 0.f, 0.f, 0.f};
  G_STORE(0, 0)
  G_LOAD(0, 64)
  __syncthreads();
#pragma unroll 1
  for (int kt0 = 0; kt0 < nk; kt0 += 2) {
    G_STORE(1, 1)
    if (kt0 + 3 < nk) { const int k0 = (kt0 + 3) * 32; G_LOAD(1, k0) }
    G_COMPUTE(0)
    __syncthreads();
    if (kt0 + 2 < nk) G_STORE(0, 0)
    if (kt0 + 4 < nk) { const int k0 = (kt0 + 4) * 32; G_LOAD(0, k0) }
    G_COMPUTE(1)
    __syncthreads();
  }
  const int itn = it + stride;
  if (itn < ntiles) {
    Ab = Abase + (size_t)((itn % tmc) * 256 + gr) * lda + gp * 8;
    Wp = Wbase + (size_t)((itn / tmc) * 128 + gr) * K + gp * 8;
    G_LOAD(0, 0) G_LOAD(1, 32)
  }
  if (EPI == 0 || EPI == 1) {
    u16* out = (u16*)e.out;
    const int cb = n0 + wc * 64;
    int ropemode = 0;
    float rinv16[4] = {0.f, 0.f, 0.f, 0.f}, rinv8[4] = {0.f, 0.f, 0.f, 0.f};
    if (EPI == 1) {
      if (cb < 3072 && (cb & 127) == 0) ropemode = 1;
      else if (cb >= O_DQ && cb < O_DV) ropemode = 2;
#pragma unroll
      for (int j = 0; j < 4; ++j) {
        rinv16[j] = __expf(-13.122363377404328f * (float)(fq * 4 + j) * (1.f / 16.f));
        rinv8[j] = __expf(-13.122363377404328f * (float)((fq & 1) * 4 + j) * (1.f / 8.f));
      }
    }
#pragma unroll
    for (int mi = 0; mi < 8; ++mi) {
      const int rl = wr * 128 + mi * 16 + fr;
      const int row = m0 + rl;
      const float rv = e.rinv[row];
      f32x4 v[4];
#pragma unroll
      for (int ni = 0; ni < 4; ++ni) v[ni] = acc[mi][ni] * rv;
      if (EPI == 1 && ropemode != 0) {
        const float pos = (float)(row % e.L);
        if (ropemode == 1) {
#pragma unroll
          for (int j = 0; j < 4; ++j) {
            float sn, cs;
            fsincos(pos * rinv16[j], &sn, &cs);
            const float x1 = v[0][j], x2 = v[1][j];
            v[0][j] = x1 * cs - x2 * sn;
            v[1][j] = x2 * cs + x1 * sn;
          }
        } else {
#pragma unroll
          for (int j = 0; j < 4; ++j) {
            float sn, cs;
            fsincos(pos * rinv8[j], &sn, &cs);
            const float mine = v[0][j];
            const float other = __shfl_xor(mine, 32);
            v[0][j] = (fq < 2) ? (mine * cs - other * sn) : (mine * cs + other * sn);
          }
        }
      }
#pragma unroll
      for (int np = 0; np < 2; ++np) {
        uint2 a = make_uint2(pack2(v[2 * np][0], v[2 * np][1]), pack2(v[2 * np][2], v[2 * np][3]));
        uint2 b = make_uint2(pack2(v[2 * np + 1][0], v[2 * np + 1][1]), pack2(v[2 * np + 1][2], v[2 * np + 1][3]));
        auto r0 = __builtin_amdgcn_permlane16_swap(a.x, b.x, false, false);
        auto r1 = __builtin_amdgcn_permlane16_swap(a.y, b.y, false, false);
        const int col = cb + (2 * np + (fq & 1)) * 16 + (fq >> 1) * 8;
        *(uint4*)(out + (size_t)row * e.ldo + col) = make_uint4(r0[0], r1[0], r0[1], r1[1]);
      }
    }
  } else {
    float* out = (float*)e.out;
    const int slot = (n0 >> 7) * 2 + wc;
#pragma unroll
    for (int mi = 0; mi < 8; ++mi) {
      const int row = m0 + wr * 128 + mi * 16 + fr;
      float sq = 0.f;
#pragma unroll
      for (int ni = 0; ni < 4; ++ni) {
        const int col = n0 + wc * 64 + ni * 16 + fq * 4;
        f32x4 v = acc[mi][ni];
        sq += v[0] * v[0] + v[1] * v[1] + v[2] * v[2] + v[3] * v[3];
        *(float4*)(out + (size_t)row * e.ldo + col) = make_float4(v[0], v[1], v[2], v[3]);
      }
      sq = xsum16(sq);
      sq = xsum32(sq);
      if (fq == 0) e.rsp[(size_t)row * 16 + slot] = sq;
    }
  }
  if (itn >= ntiles) break;
  it = itn;
  }
#undef G_COMPUTE
#undef G_STORE
#undef G_LOAD
}

__device__ __forceinline__ void rowprep_item(int item, const float* src, u16* dst, float* rinv) {
  const int tid = tidx(), lane = tid & 63, w = tid >> 6;
  const int row = item * 4 + w;
  float sq = 0.f;
#pragma unroll
  for (int i = 0; i < 4; ++i) {
    const int col = i * 256 + lane * 4;
    const float4 x = *(const float4*)(src + (size_t)row * 1024 + col);
    sq += x.x * x.x + x.y * x.y + x.z * x.z + x.w * x.w;
    *(uint2*)(dst + (size_t)row * 1024 + col) = make_uint2(pack2(x.x, x.y), pack2(x.z, x.w));
  }
  sq = wave_sum(sq);
  if (lane == 0) rinv[row] = rsqrtf(sq * (1.f / 1024.f) + EPSF);
}

DEVI int srccol_even(int n) {
  if (n < 8192) return n;
  if (n < 9216) return n + 32;
  if (n < 9248) return n - 1024;
  return -1;
}
__device__ __forceinline__ void wt_tile(const float* src, int Nsrc, const float* gain, u16* dst, int K, int kt, int nt, int evenmap, char* smem) {
  float (*tile)[65] = (float (*)[65])smem;
  const int tid = tidx(), r = tid >> 6, c = tid & 63;
  const int n = nt * 64 + c;
  const int sc = evenmap ? srccol_even(n) : n;
#pragma unroll
  for (int rr = r; rr < 64; rr += 4) {
    const int k = kt * 64 + rr;
    float v = 0.f;
    if (sc >= 0) v = src[(size_t)k * Nsrc + sc] * (gain ? gain[k] : 1.f);
    tile[rr][c] = v;
  }
  __syncthreads();
  {
    const int nl = tid >> 2, kq = tid & 3;
    unsigned pk[8];
#pragma unroll
    for (int i = 0; i < 8; ++i) pk[i] = pack2(tile[kq * 16 + 2 * i][nl], tile[kq * 16 + 2 * i + 1][nl]);
    u16* d = dst + (size_t)(nt * 64 + nl) * K + kt * 64 + kq * 16;
    *(uint4*)d = make_uint4(pk[0], pk[1], pk[2], pk[3]);
    *(uint4*)(d + 8) = make_uint4(pk[4], pk[5], pk[6], pk[7]);
  }
  __syncthreads();
}

__device__ __forceinline__ void filt_item(const P& p, int L, int pc, int cc, u16* Hr, char* smem) {
  float (*semb)[33] = (float (*)[33])smem;
  float (*sh1)[65] = (float (*)[65])(smem + 64 * 33 * 4);
  float (*sh2)[65] = (float (*)[65])(smem + 64 * 33 * 4 + 64 * 65 * 4);
  const int tid = tidx();
  for (int idx = tid; idx < 64 * 17; idx += 256) {
    const int i = idx / 17, b = idx % 17;
    const int t = pc * 64 + i;
    if (b == 16) {
      semb[i][0] = (float)t / (float)(L - 1);
    } else {
      const float f = 1e-4f + (float)b * ((15.f - 1e-4f) / 15.f);
      const float wv = (6.283185307179586f / (float)L) * (float)t;
      float sn, cs;
      fsincos(f * wv, &sn, &cs);
      semb[i][1 + b] = cs;
      semb[i][17 + b] = -sn;
    }
  }
  __syncthreads();
  {
    const int hh = tid & 63, ig = tid >> 6;
    const float fr_ = p.hy_freq[hh], b1 = p.hy_b1[hh];
    float a16[16];
#pragma unroll
    for (int r = 0; r < 16; ++r) a16[r] = b1;
    const float* wp = p.hy_w1 + hh;
#pragma unroll 1
    for (int e0 = 0; e0 < 33; e0 += 11) {
      float wv[11];
#pragma unroll
      for (int q = 0; q < 11; ++q) wv[q] = wp[(e0 + q) * 64];
#pragma unroll
      for (int q = 0; q < 11; ++q)
#pragma unroll
        for (int r = 0; r < 16; ++r) a16[r] += semb[ig * 16 + r][e0 + q] * wv[q];
    }
#pragma unroll
    for (int r = 0; r < 16; ++r) { float sn_, cs_; fsincos(fr_ * a16[r], &sn_, &cs_); sh1[ig * 16 + r][hh] = sn_; }
  }
  __syncthreads();
  {
    const int hh = tid & 63, ig = tid >> 6;
    const float fr_ = p.hy_freq[hh], b2 = p.hy_b2[hh];
    float a16[16];
#pragma unroll
    for (int r = 0; r < 16; ++r) a16[r] = b2;
    const float* wp = p.hy_w2 + hh;
#pragma unroll 1
    for (int k0 = 0; k0 < 64; k0 += 8) {
      float wv[8];
#pragma unroll
      for (int q = 0; q < 8; ++q) wv[q] = wp[(k0 + q) * 64];
#pragma unroll
      for (int q = 0; q < 8; ++q)
#pragma unroll
        for (int r = 0; r < 16; ++r) a16[r] += sh1[ig * 16 + r][k0 + q] * wv[q];
    }
#pragma unroll
    for (int r = 0; r < 16; ++r) { float sn_, cs_; fsincos(fr_ * a16[r], &sn_, &cs_); sh2[ig * 16 + r][hh] = sn_; }
  }
  __syncthreads();
  {
    const int c = cc * 256 + tid;
    const int ch = c & 1023;
    const bool bwd = c >= 1024;
    const float delta = 3.0701134573253946f + (float)ch * ((15.350567286626973f - 3.0701134573253946f) / 1023.f);
    const float skip = p.hy_skip[ch];
    u16* hr = Hr + (size_t)ch * (2 * L);
#pragma unroll 1
    for (int i0 = 0; i0 < 64; i0 += 8) {
      float acc8[8];
#pragma unroll
      for (int ii = 0; ii < 8; ++ii) acc8[ii] = 0.f;
      const float* wp = p.hy_w3 + c;
#pragma unroll 1
      for (int k0 = 0; k0 < 64; k0 += 8) {
        float wv[8];
#pragma unroll
        for (int q = 0; q < 8; ++q) wv[q] = wp[(size_t)(k0 + q) * 2048];
#pragma unroll
        for (int q = 0; q < 8; ++q)
#pragma unroll
          for (int ii = 0; ii < 8; ++ii) acc8[ii] += sh2[i0 + ii][k0 + q] * wv[q];
      }
#pragma unroll
      for (int ii = 0; ii < 8; ++ii) {
        const int t = pc * 64 + i0 + ii;
        float s = acc8[ii];
        const float tt = (float)t / (float)(L - 1);
        s *= __expf(-tt * delta);
        if (!bwd) {
          if (t == 0) s += skip;
          hr[L - 1 - t] = f2bf(s);
        } else if (t > 0) {
          hr[L - 1 + t] = f2bf(s);
        }
      }
    }
    if (bwd && pc == 0) hr[2 * L - 1] = 0;
  }
  __syncthreads();
}

__device__ __forceinline__ void hy_pre_item(const P& p, int L, int tt, int cq, const u16* z, u16* cat, u16* ut) {
  const int tid = tidx(), cg = tid & 31, tr = tid >> 5;
  const int c0 = cq * 128 + cg * 4;
  const int t0 = tt * 64 + tr * 8;
  float w[3][3][4], b[3][4];
#pragma unroll
  for (int s = 0; s < 3; ++s) {
#pragma unroll
    for (int j = 0; j < 3; ++j) {
      const float4 a = *(const float4*)(p.hy_conv_w + j * 3072 + s * 1024 + c0);
      w[s][j][0] = a.x; w[s][j][1] = a.y; w[s][j][2] = a.z; w[s][j][3] = a.w;
    }
    const float4 a = *(const float4*)(p.hy_conv_b + s * 1024 + c0);
    b[s][0] = a.x; b[s][1] = a.y; b[s][2] = a.z; b[s][3] = a.w;
  }
  uint2 prev[3], cur[3], nxt[3];
#pragma unroll
  for (int s = 0; s < 3; ++s) {
    prev[s] = ((t0 % L) > 0) ? *(const uint2*)(z + (size_t)(t0 - 1) * ZSE + E_HY + s * 1024 + c0) : make_uint2(0, 0);
    cur[s] = *(const uint2*)(z + (size_t)t0 * ZSE + E_HY + s * 1024 + c0);
  }
  unsigned up[4][4];
#pragma unroll
  for (int r = 0; r < 8; ++r) {
    const int t = t0 + r;
    const bool hasn = (t % L) < L - 1;
    float uc[3][4];
#pragma unroll
    for (int s = 0; s < 3; ++s) {
      nxt[s] = hasn ? *(const uint2*)(z + (size_t)(t + 1) * ZSE + E_HY + s * 1024 + c0) : make_uint2(0, 0);
      uc[s][0] = w[s][0][0] * lo2f(prev[s].x) + w[s][1][0] * lo2f(cur[s].x) + w[s][2][0] * lo2f(nxt[s].x) + b[s][0];
      uc[s][1] = w[s][0][1] * hi2f(prev[s].x) + w[s][1][1] * hi2f(cur[s].x) + w[s][2][1] * hi2f(nxt[s].x) + b[s][1];
      uc[s][2] = w[s][0][2] * lo2f(prev[s].y) + w[s][1][2] * lo2f(cur[s].y) + w[s][2][2] * lo2f(nxt[s].y) + b[s][2];
      uc[s][3] = w[s][0][3] * hi2f(prev[s].y) + w[s][1][3] * hi2f(cur[s].y) + w[s][2][3] * hi2f(nxt[s].y) + b[s][3];
      prev[s] = cur[s];
      cur[s] = nxt[s];
    }
    const uint2 g2 = *(const uint2*)(z + (size_t)t * ZSE + E_GHY + c0);
    *(uint2*)(cat + (size_t)t * 1024 + c0) = make_uint2(pack2(uc[0][0] * silu(lo2f(g2.x)), uc[0][1] * silu(hi2f(g2.x))),
                                                        pack2(uc[0][2] * silu(lo2f(g2.y)), uc[0][3] * silu(hi2f(g2.y))));
#pragma unroll
    for (int e2 = 0; e2 < 4; ++e2) {
      const unsigned hb = (unsigned)f2bf(uc[2][e2] * uc[1][e2]);
      if (r & 1) up[e2][r >> 1] |= hb << 16; else up[e2][r >> 1] = hb;
    }
  }
#pragma unroll
  for (int e2 = 0; e2 < 4; ++e2)
    *(uint4*)(ut + (size_t)(c0 + e2) * GT + t0) = make_uint4(up[e2][0], up[e2][1], up[e2][2], up[e2][3]);
}

__device__ __forceinline__ void hy_post_item(int tt, int cq, const u16* yt, const u16* gateA, u16* cat) {
  const int tid = tidx(), cg = tid & 31, tr = tid >> 5;
  const int c0 = cq * 128 + cg * 4;
  const int t0 = tt * 64 + tr * 8;
  unsigned yw[4][4];
#pragma unroll
  for (int e2 = 0; e2 < 4; ++e2) {
    const uint4 v = *(const uint4*)(yt + (size_t)(c0 + e2) * GT + t0);
    yw[e2][0] = v.x; yw[e2][1] = v.y; yw[e2][2] = v.z; yw[e2][3] = v.w;
  }
#pragma unroll
  for (int r = 0; r < 8; ++r) {
    u16* q = cat + (size_t)(t0 + r) * CATW + c0;
    const uint2 g = *(const uint2*)(gateA + (size_t)(t0 + r) * 1024 + c0);
    float y[4];
#pragma unroll
    for (int e2 = 0; e2 < 4; ++e2) y[e2] = (r & 1) ? hi2f(yw[e2][r >> 1]) : lo2f(yw[e2][r >> 1]);
    *(uint2*)q = make_uint2(pack2(lo2f(g.x) * y[0], hi2f(g.x) * y[1]), pack2(lo2f(g.y) * y[2], hi2f(g.y) * y[3]));
  }
}

__device__ __forceinline__ void hy_conv_item(int L, int nb, int ch, const u16* Hr, const u16* ut, u16* yt, char* smem) {
  unsigned* w0 = (unsigned*)smem;
  unsigned* w1 = w0 + L;
  u16* sU = (u16*)(w1 + L);
  constexpr int DL = 1024;
  const int S = 16 / nb;
  const int tid = tidx(), lane = tid & 63, w = tid >> 6, fr = lane & 15, fq = lane >> 4;
  {
    const u16* hr = Hr + (size_t)ch * 2 * L;
    const unsigned* hw = (const unsigned*)hr;
#pragma unroll 8
    for (int i = tid; i < L; i += 256) {
      const unsigned a = hw[i];
      const unsigned nx = (i + 1 < L) ? hw[i + 1] : 0u;
      w0[i] = a;
      if (i + 1 < L) w1[i] = (a >> 16) | (nx << 16);
    }
    const uint4* src = (const uint4*)(ut + (size_t)ch * GT);
    const int cpr = L / 8;
#pragma unroll
    for (int idx = tid; idx < GT / 8; idx += 256) {
      const int b = idx / cpr, q = idx % cpr;
      const int key = (b * S + ((q * 8) >> 10)) & 15;
      ((uint4*)sU)[b * cpr + (q ^ key)] = src[idx];
    }
  }
  __syncthreads();
  const int cs = fr / nb, cb = fr % nb;
  const int xl = L - 1 - fr + 8 * fq;
  const unsigned* wb = (xl & 1) ? (w1 + ((xl - 1) >> 1)) : (w0 + (xl >> 1));
  const uint4* urow = (const uint4*)sU + cb * (L / 8);
  const int mstart = -(S - 1) * DL;
#pragma unroll 1
  for (int pass = 0; pass < 2; ++pass) {
    const int n0 = (pass * 4 + w) * 128;
    f32x4 acc[8];
#pragma unroll
    for (int i = 0; i < 8; ++i) acc[i] = (f32x4){0.f, 0.f, 0.f, 0.f};
    union AF { unsigned u[4]; bf16x8 v; };
    AF ring[8];
#pragma unroll
    for (int i = 0; i < 8; ++i) {
      const unsigned* src = wb - ((n0 - mstart + 16 * i) >> 1);
      ring[i].u[0] = src[0]; ring[i].u[1] = src[1]; ring[i].u[2] = src[2]; ring[i].u[3] = src[3];
    }
#pragma unroll 1
    for (int m0 = mstart; m0 < L; m0 += 128) {
#pragma unroll
      for (int j = 0; j < 4; ++j) {
        const int mm = m0 + 32 * j;
        const int mb = mm + cs * DL;
        bf16x8 bfrag = {0, 0, 0, 0, 0, 0, 0, 0};
        if (mb >= 0 && mb < L) {
          const int mp = mb + 8 * fq;
          const int q = mp >> 3;
          const int key = (cb * S + (mp >> 10)) & 15;
          union { uint4 q4; bf16x8 v; } t;
          t.q4 = urow[q ^ key];
          bfrag = t.v;
        }
#pragma unroll
        for (int i = 0; i < 8; ++i)
          acc[i] = __builtin_amdgcn_mfma_f32_16x16x32_bf16(ring[(i - 2 * j) & 7].v, bfrag, acc[i], 0, 0, 0);
        if (mm + 32 < L) {
          const unsigned* s0 = wb - ((n0 - mm - 32) >> 1);
          AF& r0 = ring[(0 - 2 * (j + 1)) & 7];
          AF& r1 = ring[(1 - 2 * (j + 1)) & 7];
          r0.u[0] = s0[0]; r0.u[1] = s0[1]; r0.u[2] = s0[2]; r0.u[3] = s0[3];
          r1.u[0] = s0[-8]; r1.u[1] = s0[-7]; r1.u[2] = s0[-6]; r1.u[3] = s0[-5];
        }
      }
    }
#pragma unroll
    for (int i = 0; i < 8; ++i) {
      const int n = cs * DL + n0 + 16 * i + fq * 4;
      *(uint2*)(yt + (size_t)ch * GT + cb * L + n) = make_uint2(pack2(acc[i][0], acc[i][1]), pack2(acc[i][2], acc[i][3]));
    }
  }
  __syncthreads();
}

__device__ __forceinline__ void gdn_pre_item(const P& p, int L, int tt, int h, const u16* z, u16* qkvn, float* gba, u16* cat) {
  const int tid = tidx(), lane = tid & 63, w = tid >> 6;
  float cw[3][5][2];
#pragma unroll
  for (int s = 0; s < 3; ++s)
#pragma unroll
    for (int j = 0; j < 5; ++j) {
      cw[s][j][0] = p.gdn_conv_w[j * 3072 + s * 1024 + h * 128 + 2 * lane];
      cw[s][j][1] = p.gdn_conv_w[j * 3072 + s * 1024 + h * 128 + 2 * lane + 1];
    }
  const int t0 = tt * 64 + w * 16;
  const int seq0 = (t0 / L) * L;
  auto ld = [&](int t, int s) -> unsigned {
    if (t < seq0 || t >= seq0 + L) return 0u;
    return *(const unsigned*)(z + (size_t)t * ZSE + E_QKV + s * 1024 + h * 128 + 2 * lane);
  };
  unsigned win[3][5];
#pragma unroll
  for (int s = 0; s < 3; ++s) {
    win[s][0] = ld(t0 - 2, s);
    win[s][1] = ld(t0 - 1, s);
    win[s][2] = ld(t0, s);
    win[s][3] = ld(t0 + 1, s);
    win[s][4] = 0;
  }
#pragma unroll
  for (int r = 0; r < 16; ++r) {
    const int t = t0 + r;
    float y[3][2];
#pragma unroll
    for (int s = 0; s < 3; ++s) {
      win[s][4] = ld(t + 2, s);
      float a0 = 0.f, a1 = 0.f;
#pragma unroll
      for (int j = 0; j < 5; ++j) {
        a0 += lo2f(win[s][j]) * cw[s][j][0];
        a1 += hi2f(win[s][j]) * cw[s][j][1];
      }
      y[s][0] = silu(a0);
      y[s][1] = silu(a1);
#pragma unroll
      for (int j = 0; j < 4; ++j) win[s][j] = win[s][j + 1];
    }
    const float ssq = wave_sum(y[0][0] * y[0][0] + y[0][1] * y[0][1]);
    const float ssk = wave_sum(y[1][0] * y[1][0] + y[1][1] * y[1][1]);
    const float rq = rsqrtf(ssq + EPSF) * 0.08838834764831845f;
    const float rk = rsqrtf(ssk + EPSF);
    u16* dst = qkvn + ((size_t)t * 8 + h) * 384 + 2 * lane;
    *(unsigned*)dst = pack2(y[0][0] * rq, y[0][1] * rq);
    *(unsigned*)(dst + 128) = pack2(y[1][0] * rk, y[1][1] * rk);
    *(unsigned*)(dst + 256) = pack2(y[2][0], y[2][1]);
    {
      const unsigned gg = *(const unsigned*)(z + (size_t)t * ZSE + E_GG + h * 128 + 2 * lane);
      *(unsigned*)(cat + (size_t)t * 1024 + h * 128 + 2 * lane) = pack2(silu(lo2f(gg)), silu(hi2f(gg)));
    }
  }
  if (tid < 128) {
    const int t = tt * 64 + (tid >> 1), dir = tid & 1;
    const float zb = bf2f(z[(size_t)t * ZSE + E_BETA + dir * 8 + h]);
    const float za = bf2f(z[(size_t)t * ZSE + E_A + dir * 8 + h]);
    const float beta = 1.f / (1.f + __expf(-zb));
    const float xx = za + p.gdn_dt_bias[dir * 8 + h];
    const float sp = (xx > 20.f) ? xx : log1pf(__expf(xx));
    const float gl = -__expf(p.gdn_A_log[dir * 8 + h]) * sp;
    float* d = gba + (((size_t)t * 8 + h) * 2 + dir) * 2;
    d[0] = beta;
    d[1] = gl;
  }
}

constexpr int REC_ELEMS = 36864;
constexpr size_t OFF_GL = OFF_Z + (size_t)4096 * REC_ELEMS * 2;
static_assert(OFF_GL + 4096 * 4 <= OFF_CAT, "chunk records overflow z region");

__device__ __forceinline__ void gdn_chunk_item(int L, int r, const u16* qkvn, const float* gba, u16* rec_base, float* GL, char* smem) {
  const int NC = L / 64;
  const int n = r % NC, ci = r / NC;
  const int dir = ci & 1, h = (ci >> 1) & 7, bl = ci >> 4;
  u16* rec = rec_base + (size_t)r * REC_ELEMS;
  u16* sKb = (u16*)smem;
  u16* sQb = sKb + 64 * 136;
  float* sA = (float*)(smem + 2 * 17408);
  float* sG = (float*)(smem + 3 * 17408);
  float* sBeta = sG + 64;
  float* sg = sBeta + 64;
  const int tid = tidx(), lane = tid & 63, w = tid >> 6, fr = lane & 15, fq = lane >> 4;
  auto tok = [&](int c) -> int { const int pos = n * 64 + c; return bl * L + (dir ? (L - 1 - pos) : pos); };
  if (tid < 64) {
    const size_t o = (((size_t)tok(tid) * 8 + h) * 2 + dir) * 2;
    sBeta[tid] = gba[o];
    sg[tid] = gba[o + 1];
  }
  __syncthreads();
  if (tid < 64) {
    float sacc = 0.f;
    for (int l = 0; l <= tid; ++l) sacc += sg[l];
    sG[tid] = sacc;
  }
  __syncthreads();
#pragma unroll
  for (int it = 0; it < 8; ++it) {
    const int idx = it * 256 + tid, c = idx >> 5, c4 = idx & 31;
    const u16* src = qkvn + ((size_t)tok(c) * 8 + h) * 384 + c4 * 4;
    const uint2 q = *(const uint2*)src;
    const uint2 k = *(const uint2*)(src + 128);
    *(uint2*)(sQb + c * 136 + c4 * 4) = q;
    *(uint2*)(sKb + c * 136 + c4 * 4) = k;
    const float eg = __expf(sG[c]);
    *(uint2*)(rec + 16384 + c * 128 + c4 * 4) = make_uint2(pack2(lo2f(q.x) * eg, hi2f(q.x) * eg), pack2(lo2f(q.y) * eg, hi2f(q.y) * eg));
  }
  __syncthreads();
  {
    const int i = 16 * w + fr;
    bf16x8 kif[4], qif[4];
#pragma unroll
    for (int kk = 0; kk < 4; ++kk) {
      kif[kk] = *(const bf16x8*)(sKb + i * 136 + kk * 32 + fq * 8);
      qif[kk] = *(const bf16x8*)(sQb + i * 136 + kk * 32 + fq * 8);
    }
    const float Gi = sG[i], bi = sBeta[i];
#pragma unroll
    for (int jt = 0; jt < 4; ++jt) {
      f32x4 akk = (f32x4){0.f, 0.f, 0.f, 0.f}, aqk = (f32x4){0.f, 0.f, 0.f, 0.f};
      if (jt <= w) {
#pragma unroll
        for (int kk = 0; kk < 4; ++kk) {
          const bf16x8 kj = *(const bf16x8*)(sKb + (16 * jt + fr) * 136 + kk * 32 + fq * 8);
          akk = __builtin_amdgcn_mfma_f32_16x16x32_bf16(kj, kif[kk], akk, 0, 0, 0);
          aqk = __builtin_amdgcn_mfma_f32_16x16x32_bf16(kj, qif[kk], aqk, 0, 0, 0);
        }
      }
      float av[4], qv[4];
#pragma unroll
      for (int jj = 0; jj < 4; ++jj) {
        const int j = 16 * jt + 4 * fq + jj;
        const float dec = (j <= i) ? __expf(Gi - sG[j]) : 0.f;
        av[jj] = (j < i) ? bi * akk[jj] * dec : 0.f;
        qv[jj] = aqk[jj] * dec;
      }
      *(float4*)(sA + i * 68 + 16 * jt + 4 * fq) = make_float4(av[0], av[1], av[2], av[3]);
      *(uint2*)(rec + 32768 + i * 64 + 16 * jt + 4 * fq) = make_uint2(pack2(qv[0], qv[1]), pack2(qv[2], qv[3]));
    }
  }
  __syncthreads();
  {
    const int c = tid;
    const bool isU = c < 128;
    const int col = isU ? (256 + c) : c;
    float x[64];
#pragma unroll
    for (int i = 0; i < 64; ++i) x[i] = bf2f(qkvn[((size_t)tok(i) * 8 + h) * 384 + col]);
#pragma unroll
    for (int i = 0; i < 64; ++i) {
      float acc = x[i] * sBeta[i] * (isU ? 1.f : __expf(sG[i]));
      float ac1 = 0.f, ac2 = 0.f, ac3 = 0.f;
#pragma unroll
      for (int j4 = 0; j4 < (i + 3) / 4; ++j4) {
        const float4 a = *(const float4*)(sA + i * 68 + 4 * j4);
        acc -= a.x * x[4 * j4];
        if (4 * j4 + 1 < i) ac1 -= a.y * x[4 * j4 + 1];
        if (4 * j4 + 2 < i) ac2 -= a.z * x[4 * j4 + 2];
        if (4 * j4 + 3 < i) ac3 -= a.w * x[4 * j4 + 3];
      }
      x[i] = (acc + ac1) + (ac2 + ac3);
    }
    if (isU) {
      u16* dst = rec + (size_t)c * 64;
#pragma unroll
      for (int q8 = 0; q8 < 8; ++q8)
        *(uint4*)(dst + q8 * 8) = make_uint4(pack2(x[q8 * 8], x[q8 * 8 + 1]), pack2(x[q8 * 8 + 2], x[q8 * 8 + 3]),
                                             pack2(x[q8 * 8 + 4], x[q8 * 8 + 5]), pack2(x[q8 * 8 + 6], x[q8 * 8 + 7]));
    } else {
#pragma unroll
      for (int i = 0; i < 64; ++i) sQb[i * 136 + (c - 128)] = f2bf(x[i]);
    }
  }
  __syncthreads();
#pragma unroll
  for (int it = 0; it < 4; ++it) {
    const int idx = it * 256 + tid, row = idx >> 4, ch = idx & 15;
    *(uint4*)(rec + 8192 + row * 128 + ch * 8) = *(const uint4*)(sQb + row * 136 + ch * 8);
  }
  if (tid < 128) {
    const float Gl = sG[63];
    u16* dst = rec + 24576 + (size_t)tid * 64;
#pragma unroll
    for (int q8 = 0; q8 < 8; ++q8) {
      float v[8];
#pragma unroll
      for (int e2 = 0; e2 < 8; ++e2) {
        const int i = q8 * 8 + e2;
        v[e2] = bf2f(sKb[i * 136 + tid]) * __expf(Gl - sG[i]);
      }
      *(uint4*)(dst + q8 * 8) = make_uint4(pack2(v[0], v[1]), pack2(v[2], v[3]), pack2(v[4], v[5]), pack2(v[6], v[7]));
    }
  }
  if (tid == 0) GL[r] = __expf(sG[63]);
  __syncthreads();
}

__device__ __forceinline__ void gdn_cscan_item(int L, int ci, int half, const u16* rec_base, const float* GL, float* odir, char* smem) {
  const int NC = L / 64;
  const int dir = ci & 1, h = (ci >> 1) & 7, bl = ci >> 4;
  u16* sST = (u16*)smem;
  u16* sVT = sST + 64 * 136;
  const int tid = tidx(), lane = tid & 63, w = tid >> 6, fr = lane & 15, fq = lane >> 4;
  f32x4 S[2][4];
#pragma unroll
  for (int u = 0; u < 2; ++u)
#pragma unroll
    for (int t = 0; t < 4; ++t) S[u][t] = (f32x4){0.f, 0.f, 0.f, 0.f};
  for (int idx = tid; idx < 64 * 136 / 2; idx += 256) ((unsigned*)sST)[idx] = 0u;
  __syncthreads();
  bf16x8 nwf[4], nqgf[4], nqkf[2], nkdf[2][2];
  uint2 nut[4];
  float ngl;
#define SCAN_LOAD(nn)                                                                                             \
  {                                                                                                               \
    const u16* rec = rec_base + (size_t)(ci * NC + (nn)) * REC_ELEMS;                                             \
    ngl = GL[ci * NC + (nn)];                                                                                     \
    _Pragma("unroll") for (int kk = 0; kk < 4; ++kk) {                                                            \
      nwf[kk] = *(const bf16x8*)(rec + 8192 + (16 * w + fr) * 128 + kk * 32 + fq * 8);                            \
      nqgf[kk] = *(const bf16x8*)(rec + 16384 + (16 * w + fr) * 128 + kk * 32 + fq * 8);                          \
    }                                                                                                             \
    _Pragma("unroll") for (int kk = 0; kk < 2; ++kk) {                                                            \
      nqkf[kk] = *(const bf16x8*)(rec + 32768 + (16 * w + fr) * 64 + kk * 32 + fq * 8);                           \
      _Pragma("unroll") for (int u = 0; u < 2; ++u)                                                               \
        nkdf[u][kk] = *(const bf16x8*)(rec + 24576 + (32 * w + 16 * u + fr) * 64 + kk * 32 + fq * 8);             \
    }                                                                                                             \
    _Pragma("unroll") for (int t = 0; t < 4; ++t) nut[t] = *(const uint2*)(rec + (half * 64 + 16 * t + fr) * 64 + 16 * w + 4 * fq); \
  }
  SCAN_LOAD(0)
#pragma unroll 1
  for (int n = 0; n < NC; ++n) {
    const float gl = ngl;
    bf16x8 wf[4], qgf[4], qkf[2], kdf[2][2];
    uint2 ut[4];
#pragma unroll
    for (int kk = 0; kk < 4; ++kk) { wf[kk] = nwf[kk]; qgf[kk] = nqgf[kk]; }
#pragma unroll
    for (int kk = 0; kk < 2; ++kk) { qkf[kk] = nqkf[kk]; kdf[0][kk] = nkdf[0][kk]; kdf[1][kk] = nkdf[1][kk]; }
#pragma unroll
    for (int t = 0; t < 4; ++t) ut[t] = nut[t];
    if (n + 1 < NC) SCAN_LOAD(n + 1)
#pragma unroll
    for (int t = 0; t < 4; ++t) {
      f32x4 acc = (f32x4){0.f, 0.f, 0.f, 0.f};
#pragma unroll
      for (int kk = 0; kk < 4; ++kk) {
        const bf16x8 b = *(const bf16x8*)(sST + (16 * t + fr) * 136 + kk * 32 + fq * 8);
        acc = __builtin_amdgcn_mfma_f32_16x16x32_bf16(wf[kk], b, acc, 0, 0, 0);
      }
      const float v0 = lo2f(ut[t].x) - acc[0], v1 = hi2f(ut[t].x) - acc[1], v2 = lo2f(ut[t].y) - acc[2], v3 = hi2f(ut[t].y) - acc[3];
      *(uint2*)(sVT + (16 * t + fr) * 72 + 16 * w + 4 * fq) = make_uint2(pack2(v0, v1), pack2(v2, v3));
    }
    __syncthreads();
#pragma unroll
    for (int t = 0; t < 4; ++t) {
      f32x4 acc = (f32x4){0.f, 0.f, 0.f, 0.f};
#pragma unroll
      for (int kk = 0; kk < 4; ++kk) {
        const bf16x8 b = *(const bf16x8*)(sST + (16 * t + fr) * 136 + kk * 32 + fq * 8);
        acc = __builtin_amdgcn_mfma_f32_16x16x32_bf16(b, qgf[kk], acc, 0, 0, 0);
      }
#pragma unroll
      for (int kk = 0; kk < 2; ++kk) {
        const bf16x8 b = *(const bf16x8*)(sVT + (16 * t + fr) * 72 + kk * 32 + fq * 8);
        acc = __builtin_amdgcn_mfma_f32_16x16x32_bf16(b, qkf[kk], acc, 0, 0, 0);
      }
      {
        const int pos = n * 64 + 16 * w + fr;
        const int tk = bl * L + (dir ? (L - 1 - pos) : pos);
        *(float4*)(odir + (size_t)tk * 1024 + h * 128 + half * 64 + 16 * t + 4 * fq) = make_float4(acc[0], acc[1], acc[2], acc[3]);
      }
    }
#pragma unroll
    for (int u = 0; u < 2; ++u)
#pragma unroll
      for (int t = 0; t < 4; ++t) {
        f32x4 acc = S[u][t] * gl;
#pragma unroll
        for (int kk = 0; kk < 2; ++kk) {
          const bf16x8 b = *(const bf16x8*)(sVT + (16 * t + fr) * 72 + kk * 32 + fq * 8);
          acc = __builtin_amdgcn_mfma_f32_16x16x32_bf16(kdf[u][kk], b, acc, 0, 0, 0);
        }
        S[u][t] = acc;
      }
    __syncthreads();
#pragma unroll
    for (int u = 0; u < 2; ++u)
#pragma unroll
      for (int t = 0; t < 4; ++t)
        *(uint2*)(sST + (16 * t + fr) * 136 + 32 * w + 16 * u + 4 * fq) = make_uint2(pack2(S[u][t][0], S[u][t][1]), pack2(S[u][t][2], S[u][t][3]));
    __syncthreads();
  }
}

#undef SCAN_LOAD
__device__ __forceinline__ void gdn_post_item(const P& p, int tt, const float* of, const float* ob, const u16* gateB, u16* cat) {
  const int tid = tidx(), lane = tid & 63, w = tid >> 6;
  const int p4 = lane >> 4, d8 = (lane & 15) * 8;
  const float4 g0 = *(const float4*)(p.gdn_norm_g + d8), g1 = *(const float4*)(p.gdn_norm_g + d8 + 4);
#pragma unroll
  for (int it = 0; it < 4; ++it) {
    const int pr = w * 16 + it * 4 + p4;
    const int t = tt * 8 + (pr >> 3), h = pr & 7;
    const size_t o = (size_t)t * 1024 + h * 128 + d8;
    const float4 a0 = *(const float4*)(of + o), a1 = *(const float4*)(of + o + 4);
    const float4 b0 = *(const float4*)(ob + o), b1 = *(const float4*)(ob + o + 4);
    u16* cp = cat + (size_t)t * CATW + 1024 + h * 128 + d8;
    const uint4 gg = *(const uint4*)(gateB + (size_t)t * 1024 + h * 128 + d8);
    float x[8] = {a0.x + b0.x, a0.y + b0.y, a0.z + b0.z, a0.w + b0.w, a1.x + b1.x, a1.y + b1.y, a1.z + b1.z, a1.w + b1.w};
    float ss = 0.f;
#pragma unroll
    for (int e2 = 0; e2 < 8; ++e2) ss += x[e2] * x[e2];
    ss = row_sum16(ss);
    const float rinv = rsqrtf(ss * (1.f / 128.f) + EPSF);
    const float gn[8] = {g0.x, g0.y, g0.z, g0.w, g1.x, g1.y, g1.z, g1.w};
    const unsigned gw[4] = {gg.x, gg.y, gg.z, gg.w};
    unsigned ow[4];
#pragma unroll
    for (int q = 0; q < 4; ++q)
      ow[q] = pack2(x[2 * q] * rinv * gn[2 * q] * lo2f(gw[q]), x[2 * q + 1] * rinv * gn[2 * q + 1] * hi2f(gw[q]));
    *(uint4*)cp = make_uint4(ow[0], ow[1], ow[2], ow[3]);
  }
}

template <bool COPY>
__device__ __forceinline__ void resid_item(int item, const float* xin, const float* outb, const float* rsp, const float* g, float* dst, u16* xb, float* rinvb) {
  const int tid = tidx(), lane = tid & 63, w = tid >> 6;
  const int row = item * 4 + w;
  float s = 0.f;
#pragma unroll
  for (int i = 0; i < 16; ++i) s += rsp[(size_t)row * 16 + i];
  const float rinv = rsqrtf(s * (1.f / 1024.f) + EPSF);
  float sq = 0.f;
#pragma unroll
  for (int i = 0; i < 4; ++i) {
    const int col = i * 256 + lane * 4;
    float4 x = *(const float4*)(xin + (size_t)row * 1024 + col);
    float4 o = *(const float4*)(outb + (size_t)row * 1024 + col);
    float4 gg = *(const float4*)(g + col);
    float4 y = make_float4(x.x + o.x * rinv * gg.x, x.y + o.y * rinv * gg.y, x.z + o.z * rinv * gg.z, x.w + o.w * rinv * gg.w);
    *(float4*)(dst + (size_t)row * 1024 + col) = y;
    if (COPY) {
      sq += y.x * y.x + y.y * y.y + y.z * y.z + y.w * y.w;
      *(uint2*)(xb + (size_t)row * 1024 + col) = make_uint2(pack2(y.x, y.y), pack2(y.z, y.w));
    }
  }
  if (COPY) {
    sq = wave_sum(sq);
    if (lane == 0) rinvb[row] = rsqrtf(sq * (1.f / 1024.f) + EPSF);
  }
}

struct AttnIO {
  const u16* q; long qstep;
  const u16* k; const u16* v; long kstep;
  u16* o; long ostep;
  const u16* g; long gstep;
  float* lse; long lstep;
};

template <int DH, int NTW, int NCHUNK, int CHCOLS, int VSTR, bool MASK, int NH = 1>
__device__ __forceinline__ void attn_block(const AttnIO& io, int Lr, int q0, int HW, float scale, const float* sinkp, long hstep, char* smem) {
  u16* sV = (u16*)smem;
  const int tid = tidx(), lane = tid & 63, w = tid >> 6, fr = lane & 15, fq = lane >> 4;
  constexpr int NKK = DH / 32;
  constexpr int NDD = DH / 16;
  constexpr int SPC = NTW / 2 / NCHUNK;
  const int qw0 = q0 + 16 * w;
  const int kw0 = MASK ? (qw0 - HW) : 0;
  const int qp = qw0 + fr;
  const bool has_sink = (sinkp != nullptr);
  auto stage = [&](int c) {
    __syncthreads();
    const int k0c = MASK ? (q0 - HW) : c * CHCOLS;
    {
      constexpr int NIDX = CHCOLS * (DH / 8);
      constexpr int NIT = (NIDX + 255) / 256;
      uint4 vv[NIT];
#pragma unroll
      for (int q = 0; q < NIT; ++q) {
        const int idx = q * 256 + tid;
        const int col = idx % CHCOLS, dch = idx / CHCOLS;
        const int kp = k0c + col;
        vv[q] = make_uint4(0, 0, 0, 0);
        if (idx < NIDX && kp >= 0 && kp < Lr) vv[q] = *(const uint4*)(io.v + (long)kp * io.kstep + dch * 8);
      }
#pragma unroll
      for (int q = 0; q < NIT; ++q) {
        const int idx = q * 256 + tid;
        if (idx < NIDX) {
          const int col = idx % CHCOLS, dch = idx / CHCOLS;
          u16* d = sV + (dch * 8) * VSTR + col;
          d[0] = (u16)(vv[q].x & 0xffff); d[VSTR] = (u16)(vv[q].x >> 16);
          d[2 * VSTR] = (u16)(vv[q].y & 0xffff); d[3 * VSTR] = (u16)(vv[q].y >> 16);
          d[4 * VSTR] = (u16)(vv[q].z & 0xffff); d[5 * VSTR] = (u16)(vv[q].z >> 16);
          d[6 * VSTR] = (u16)(vv[q].w & 0xffff); d[7 * VSTR] = (u16)(vv[q].w >> 16);
        }
      }
    }
    __syncthreads();
  };
  if (NCHUNK == 1) stage(0);
#pragma unroll 1
  for (int hd = 0; hd < NH; ++hd) {
  const float sink = has_sink ? sinkp[hd] : 0.f;
  bf16x8 qf[NKK];
  {
    const u16* qptr = io.q + hd * hstep + (long)qp * io.qstep + fq * 8;
#pragma unroll
    for (int kk = 0; kk < NKK; ++kk) qf[kk] = *(const bf16x8*)(qptr + kk * 32);
  }
  f32x4 oacc[NDD];
#pragma unroll
  for (int dd = 0; dd < NDD; ++dd) oacc[dd] = (f32x4){0.f, 0.f, 0.f, 0.f};
  float m = has_sink ? sink : -1e30f;
  float den = 0.f;
#pragma unroll
  for (int c = 0; c < NCHUNK; ++c) {
    if (NCHUNK > 1) stage(c);
    auto kload = [&](bf16x8 (&dst)[2][NKK], int ktbase) {
#pragma unroll
      for (int tt = 0; tt < 2; ++tt) {
        const int kp = kw0 + 16 * (ktbase + tt) + fr;
        const bool valid = (kp >= 0) && (kp < Lr);
        const u16* kptr = io.k + (long)(valid ? kp : 0) * io.kstep + fq * 8;
#pragma unroll
        for (int kk = 0; kk < NKK; ++kk) {
          bf16x8 kf = {0, 0, 0, 0, 0, 0, 0, 0};
          if (valid) kf = *(const bf16x8*)(kptr + kk * 32);
          dst[tt][kk] = kf;
        }
      }
    };
    auto qk = [&](bf16x8 (&kf)[2][NKK], f32x4 (&st)[2]) {
#pragma unroll
      for (int tt = 0; tt < 2; ++tt) {
        st[tt] = (f32x4){0.f, 0.f, 0.f, 0.f};
#pragma unroll
        for (int kk = 0; kk < NKK; ++kk)
          st[tt] = __builtin_amdgcn_mfma_f32_16x16x32_bf16(kf[tt][kk], qf[kk], st[tt], 0, 0, 0);
      }
    };
    auto tail = [&](f32x4 (&st)[2], int kt0) {
      bool ok[2][4];
      float mloc = -1e30f;
#pragma unroll
      for (int tt = 0; tt < 2; ++tt)
#pragma unroll
        for (int j = 0; j < 4; ++j) {
          bool okv = true;
          if (MASK) {
            const int kp = kw0 + 16 * (kt0 + tt) + 4 * fq + j;
            const int dlt = qp - kp;
            okv = (kp >= 0) && (kp < Lr) && (dlt <= HW) && (dlt >= -HW);
          }
          ok[tt][j] = okv;
          const float sv = st[tt][j] * scale;
          st[tt][j] = sv;
          if (okv) mloc = fmaxf(mloc, sv);
        }
      mloc = xmax16(mloc);
      mloc = xmax32(mloc);
      const float mnew = fmaxf(m, mloc);
      const float alpha = __expf(m - mnew);
      m = mnew;
      float psum = 0.f;
#pragma unroll
      for (int tt = 0; tt < 2; ++tt)
#pragma unroll
        for (int j = 0; j < 4; ++j) {
          const float pv = ok[tt][j] ? __expf(st[tt][j] - mnew) : 0.f;
          st[tt][j] = pv;
          psum += pv;
        }
      den = den * alpha + psum;
      union { unsigned u[4]; bf16x8 v; } pf;
      pf.u[0] = pack2(st[0][0], st[0][1]);
      pf.u[1] = pack2(st[0][2], st[0][3]);
      pf.u[2] = pack2(st[1][0], st[1][1]);
      pf.u[3] = pack2(st[1][2], st[1][3]);
      const int cb0 = MASK ? (16 * w + 16 * kt0) : (16 * kt0 - c * CHCOLS);
      const int cb1 = cb0 + 16;
#pragma unroll
      for (int dd = 0; dd < NDD; ++dd) {
        const u16* vr = sV + (dd * 16 + fr) * VSTR + 4 * fq;
        union { uint2 h[2]; bf16x8 v; } vf;
        vf.h[0] = *(const uint2*)(vr + cb0);
        vf.h[1] = *(const uint2*)(vr + cb1);
        oacc[dd] = oacc[dd] * alpha;
        oacc[dd] = __builtin_amdgcn_mfma_f32_16x16x32_bf16(vf.v, pf.v, oacc[dd], 0, 0, 0);
      }
    };
    bf16x8 kfa[2][NKK], kfb[2][NKK];
    kload(kfa, 2 * (c * SPC));
    if (SPC > 1) kload(kfb, 2 * (c * SPC) + 2);
#pragma unroll 1
    for (int s2l = 0; s2l < SPC; s2l += 2) {
      {
        const int kt0 = 2 * (c * SPC + s2l);
        f32x4 st[2];
        qk(kfa, st);
        if (s2l + 2 < SPC) kload(kfa, kt0 + 4);
        tail(st, kt0);
      }
      if (s2l + 1 >= SPC) break;
      {
        const int kt0 = 2 * (c * SPC + s2l + 1);
        f32x4 st[2];
        qk(kfb, st);
        if (s2l + 3 < SPC) kload(kfb, kt0 + 4);
        tail(st, kt0);
      }
    }
  }
  den = xsum16(den);
  den = xsum32(den);
  if (has_sink) den += __expf(sink - m);
  const float rden = 1.f / den;
  u16* op = io.o + hd * hstep + (long)qp * io.ostep;
  const u16* gp = io.g ? (io.g + hd * hstep + (long)qp * io.gstep) : nullptr;
#pragma unroll
  for (int dd = 0; dd < NDD; ++dd) {
    const int d0 = dd * 16 + 4 * fq;
    float y0 = oacc[dd][0] * rden, y1 = oacc[dd][1] * rden, y2 = oacc[dd][2] * rden, y3 = oacc[dd][3] * rden;
    if (gp) {
      uint2 gg = *(const uint2*)(gp + d0);
      y0 *= silu(lo2f(gg.x)); y1 *= silu(hi2f(gg.x)); y2 *= silu(lo2f(gg.y)); y3 *= silu(hi2f(gg.y));
    }
    *(uint2*)(op + d0) = make_uint2(pack2(y0, y1), pack2(y2, y3));
  }
  if (io.lse && fq == 0) io.lse[(long)qp * io.lstep] = m + __logf(den);
  }
  __syncthreads();
}

__device__ __forceinline__ void xattn_item(int L, int nb, int item, int grp, const u16* z, int zs, int xq_col, int gx_col, const u16* mkv, u16* cat, int cat_col, char* smem) {
  const int nqb = L / 64;
  const int qb = item % nqb;
  const int rest = item / nqb;
  const int h = rest & 3, bl = rest >> 2;
  const int sq = (grp == 0) ? bl : (8 + (grp - 1) * 4 + bl);
  AttnIO io;
  io.q = z + (size_t)(bl * L) * zs + xq_col + h * 128; io.qstep = zs;
  io.k = mkv + (size_t)(sq * 256) * 1024 + h * 128;
  io.v = mkv + (size_t)(sq * 256) * 1024 + 512 + h * 128; io.kstep = 1024;
  io.o = cat + (size_t)(bl * L) * CATW + cat_col + h * 128; io.ostep = CATW;
  io.g = z + (size_t)(bl * L) * zs + gx_col + h * 128; io.gstep = zs;
  io.lse = nullptr; io.lstep = 0;
  attn_block<128, 16, 2, 128, 144, false>(io, 256, qb * 64, 0, 0.08838834764831845f, nullptr, 0, smem);
}

__global__ void __launch_bounds__(256, 2) mega(P p) {
  cg::grid_group grid = cg::this_grid();
  __shared__ __attribute__((aligned(16))) char smem[65536];
  const int nblk = gridDim.x, bid = blockIdx.x;
  char* ws = p.ws;
  XcdBarrier xb;
  xb.bar = (unsigned*)(ws + OFF_BAR); xb.x = xb_xcc_id(); xb.nloc = 0u; xb.nx = 0u;
  if (__builtin_amdgcn_workitem_id_x() == 0) (void)xb_add(&xb.bar[XB_XCNT(xb.x)], 1u);
  u16* wt_e_in = (u16*)(ws + OFF_WT_E_IN);
  u16* wt_o_in = (u16*)(ws + OFF_WT_O_IN);
  u16* wt_e_out = (u16*)(ws + OFF_WT_E_OUT);
  u16* wt_o_out = (u16*)(ws + OFF_WT_O_OUT);
  u16* wt_e_mkv = (u16*)(ws + OFF_WT_E_MKV);
  u16* wt_o_mkv = (u16*)(ws + OFF_WT_O_MKV);
  u16* mkv_e = (u16*)(ws + OFF_MKV_E);
  u16* mkv_o = (u16*)(ws + OFF_MKV_O);
  u16* hr_a = (u16*)(ws + OFF_HR_A);
  u16* hr_b = (u16*)(ws + OFF_HR_B);
  u16* z = (u16*)(ws + OFF_Z);
  u16* cat = (u16*)(ws + OFF_CAT);
  float* outb = (float*)(ws + OFF_OUT);
  float* rsp = (float*)(ws + OFF_RSP);
  u16* gateA = (u16*)(ws + OFF_OUT);
  u16* gateB = gateA + (size_t)GT * 1024;
  u16* ut = (u16*)(ws + OFF_UT);
  u16* yt = (u16*)(ws + OFF_YT);
  u16* qkvn = (u16*)(ws + OFF_QKVN);
  float* gba = (float*)(ws + OFF_GBA);
  float* of = (float*)(ws + OFF_OF);
  float* ob = (float*)(ws + OFF_OB);
  u16* og = (u16*)(ws + OFF_OG);
  float* lse = (float*)(ws + OFF_LSE);
  u16* xbf = (u16*)(ws + OFF_XB);
  float* rinvb = (float*)(ws + OFF_RINVB);
  u16* memb = (u16*)(ws + OFF_MEMB);
  float* rinvm = (float*)(ws + OFF_RINVM);

  {
    const int n_e_in = 16 * (ZSE / 64), n_o_in = 16 * (ZSO / 64), n_e_out = 40 * 16, n_o_out = 32 * 16, n_mkv = 16 * 16;
    const int n_f = 256 + 512;
    const int n_rp = GT / 4 + 6144 / 4;
    const int total = n_rp + n_e_in + n_o_in + n_e_out + n_o_out + 2 * n_mkv + n_f;
    REP(5) for (int it = bid; it < total; it += nblk) {
      int i = it;
      if (i < GT / 4) { rowprep_item(i, p.xp, xbf, rinvb); continue; }
      i -= GT / 4;
      if (i < 6144 / 4) { if (i < 512) rowprep_item(i, p.memp, memb, rinvm); else rowprep_item(i - 512, p.mems, memb + (size_t)2048 * 1024, rinvm + 2048); continue; }
      i -= 6144 / 4;
      if (i < n_e_in) { wt_tile(p.e_w_in, 9248, p.e_pre_g, wt_e_in, 1024, i & 15, i >> 4, 1, smem); continue; }
      i -= n_e_in;
      if (i < n_o_in) { wt_tile(p.o_w_in, 8448, p.o_pre_g, wt_o_in, 1024, i & 15, i >> 4, 0, smem); continue; }
      i -= n_o_in;
      if (i < n_e_out) { wt_tile(p.e_w_out, 1024, nullptr, wt_e_out, 2560, i % 40, i / 40, 0, smem); continue; }
      i -= n_e_out;
      if (i < n_o_out) { wt_tile(p.o_w_out, 1024, nullptr, wt_o_out, 2048, i % 32, i / 32, 0, smem); continue; }
      i -= n_o_out;
      if (i < n_mkv) { wt_tile(p.e_w_mkv, 1024, p.e_mem_g, wt_e_mkv, 1024, i & 15, i >> 4, 0, smem); continue; }
      i -= n_mkv;
      if (i < n_mkv) { wt_tile(p.o_w_mkv, 1024, p.o_mem_g, wt_o_mkv, 1024, i & 15, i >> 4, 0, smem); continue; }
      i -= n_mkv;
      if (i < 256) { filt_item(p, 2048, i >> 3, i & 7, hr_a, smem); continue; }
      i -= 256;
      filt_item(p, 4096, i >> 3, i & 7, hr_b, smem);
    }
  }
  grid.sync();
  for (int layer = 0; layer < 2; ++layer) {
    Epi e; e.out = layer ? mkv_o : mkv_e; e.ldo = 1024; e.rsp = nullptr; e.L = 1; e.rinv = rinvm;
    gemm_phase<0>(bid, nblk, 24 * 8, 24, memb, 1024, layer ? wt_o_mkv : wt_e_mkv, 1024, e, smem);
  }
  xcd_barrier(xb);

  for (int grp = 0; grp < NGROUP; ++grp) {
    const int L = (grp == 0) ? 2048 : 4096;
    const int nb = GT / L;
    const float* xg = (grp == 0) ? p.xp : (p.xs + (size_t)(grp - 1) * GT * 1024);
    float* dg = p.out + (size_t)grp * GT * 1024;
    const u16* hr = (grp == 0) ? hr_a : hr_b;

    REP(0) {
      Epi e; e.out = z; e.ldo = ZSE; e.rsp = nullptr; e.L = L; e.rinv = rinvb;
      gemm_phase<0>(bid, nblk, 64 * 73, 64, xbf, 1024, wt_e_in, 1024, e, smem);
    }
    xcd_barrier(xb);
    {
      const int n_hy = 256 * 8, n_gd = 256 * 8, n_x = 1024;
      REP(1) for (int it = bid; it < n_hy + n_gd + n_x; it += nblk) {
        int i = it;
        if (i < n_x) { xattn_item(L, nb, i, grp, z, ZSE, E_XQ, E_GX, mkv_e, cat, 2048, smem); continue; }
        i -= n_x;
        if (i < n_gd) { gdn_pre_item(p, L, i >> 3, i & 7, z, qkvn, gba, gateB); continue; }
        i -= n_gd;
        hy_pre_item(p, L, i >> 3, i & 7, z, gateA, ut);
      }
    }
    xcd_barrier(xb);
    REP(4) for (int it = bid; it < 4096; it += nblk) gdn_chunk_item(L, it, qkvn, gba, z, (float*)(ws + OFF_GL), smem);
    xcd_barrier(xb);
    {
      const int n_scan = nb * 32;
      REP(2) {
      if (bid < n_scan) {
        const int ci = bid >> 1, half = bid & 1;
        gdn_cscan_item(L, ci, half, z, (const float*)(ws + OFF_GL), (ci & 1) ? ob : of, smem);
      }
      unsigned* hctr = (unsigned*)(ws + OFF_BAR) + 3600 + grp + 8 * rep_;
      volatile unsigned* slot = (volatile unsigned*)(smem + (2 * L - 1) * 4);
      for (;;) {
        __syncthreads();
        if (__builtin_amdgcn_workitem_id_x() == 0) *slot = atomicAdd(hctr, 1u);
        __syncthreads();
        const unsigned chn = *slot;
        if (chn >= 1024u) break;
        hy_conv_item(L, nb, (int)chn, hr, ut, yt, smem);
      }
      }
    }
    xcd_barrier(xb);
    {
      const int n_hy = 256 * 8, n_gd = GT / 8;
      REP(6) for (int it = bid; it < n_hy + n_gd; it += nblk) {
        if (it < n_hy) hy_post_item(it >> 3, it & 7, yt, gateA, cat);
        else gdn_post_item(p, it - n_hy, of, ob, gateB, cat);
      }
    }
    xcd_barrier(xb);
    REP(0) {
      Epi e; e.out = outb; e.ldo = 1024; e.rsp = rsp; e.L = L; e.rinv = nullptr;
      gemm_phase<2>(bid, nblk, 64 * 8, 64, cat, CATW, wt_e_out, 2560, e, smem);
    }
    xcd_barrier(xb);
    for (int it = bid; it < GT / 4; it += nblk) resid_item<true>(it, xg, outb, rsp, p.e_post_g, dg, xbf, rinvb);
    xcd_barrier(xb);
    REP(0) {
      Epi e; e.out = z; e.ldo = ZSO; e.rsp = nullptr; e.L = L; e.rinv = rinvb;
      gemm_phase<1>(bid, nblk, 64 * 66, 64, xbf, 1024, wt_o_in, 1024, e, smem);
    }
    xcd_barrier(xb);
    {
      const int n_dil = 3072, n_swa = 512, n_x = 1024;
      REP(3) for (int it = bid; it < n_dil + n_swa + n_x; it += nblk) {
        int i = it;
        if (i < n_swa) {
          const int kvh = i & 1, rem = i >> 1;
          const int nqb = L / 64, qb = rem % nqb, bl = rem / nqb;
          const int qh = kvh * 8;
          AttnIO io;
          io.q = z + (size_t)(bl * L) * ZSO + O_DQ + qh * 64; io.qstep = ZSO;
          io.k = z + (size_t)(bl * L) * ZSO + O_DK + kvh * 64;
          io.v = z + (size_t)(bl * L) * ZSO + O_DV + kvh * 64; io.kstep = ZSO;
          io.o = cat + (size_t)(bl * L) * CATW + 512 + qh * 64; io.ostep = CATW;
          io.g = z + (size_t)(bl * L) * ZSO + O_GD + qh * 64; io.gstep = ZSO;
          io.lse = nullptr; io.lstep = 0;
          attn_block<64, 18, 1, 336, 336, true, 8>(io, L, qb * 64, 128, 0.125f, p.swa_sink + qh, 64, smem);
          continue;
        }
        i -= n_swa;
        if (i < n_dil) {
          const int gi = i >> 10, rem = i & 1023;
          const int h = rem & 3, rem2 = rem >> 2;
          const int d = (gi == 0) ? 1 : (gi == 1 ? 4 : 16);
          const int Lr = L / d, nqb = Lr / 64;
          const int qb = rem2 % nqb, rem3 = rem2 / nqb;
          const int r = rem3 % d, bl = rem3 / d;
          const size_t row0 = (size_t)bl * L + r;
          AttnIO io;
          io.q = z + row0 * ZSO + O_CQ + gi * 512 + h * 128; io.qstep = (long)d * ZSO;
          io.k = z + row0 * ZSO + O_CK + gi * 512 + h * 128;
          io.v = z + row0 * ZSO + O_CV + gi * 512 + h * 128; io.kstep = (long)d * ZSO;
          io.o = og + row0 * 1536 + gi * 512 + h * 128; io.ostep = (long)d * 1536;
          io.g = nullptr; io.gstep = 0;
          io.lse = lse + row0 * 12 + gi * 4 + h; io.lstep = (long)d * 12;
          attn_block<128, 10, 1, 208, 208, true>(io, Lr, qb * 64, 64, 0.08838834764831845f, nullptr, 0, smem);
          continue;
        }
        i -= n_dil;
        xattn_item(L, nb, i, grp, z, ZSO, O_XQ, O_GX, mkv_o, cat, 1536, smem);
      }
    }
    xcd_barrier(xb);
    for (int it = bid; it < GT / 4; it += nblk) {
      const int tid = tidx(), lane = tid & 63, w = tid >> 6;
      const int t = it * 4 + w;
      const int h = lane >> 4, d0 = (lane & 15) * 8;
      const float l0 = lse[(size_t)t * 12 + h], l1 = lse[(size_t)t * 12 + 4 + h], l2 = lse[(size_t)t * 12 + 8 + h];
      const float mx = fmaxf(l0, fmaxf(l1, l2));
      float w0 = __expf(l0 - mx), w1 = __expf(l1 - mx), w2 = __expf(l2 - mx);
      const float rs = 1.f / (w0 + w1 + w2);
      w0 *= rs; w1 *= rs; w2 *= rs;
      uint4 a = *(const uint4*)(og + (size_t)t * 1536 + h * 128 + d0);
      uint4 b = *(const uint4*)(og + (size_t)t * 1536 + 512 + h * 128 + d0);
      uint4 c = *(const uint4*)(og + (size_t)t * 1536 + 1024 + h * 128 + d0);
      uint4 g = *(const uint4*)(z + (size_t)t * ZSO + O_GC + h * 128 + d0);
      unsigned au[4] = {a.x, a.y, a.z, a.w}, bu[4] = {b.x, b.y, b.z, b.w}, cu[4] = {c.x, c.y, c.z, c.w}, gu[4] = {g.x, g.y, g.z, g.w};
      unsigned ru[4];
#pragma unroll
      for (int i = 0; i < 4; ++i) {
        const float ylo = (w0 * lo2f(au[i]) + w1 * lo2f(bu[i]) + w2 * lo2f(cu[i])) * silu(lo2f(gu[i]));
        const float yhi = (w0 * hi2f(au[i]) + w1 * hi2f(bu[i]) + w2 * hi2f(cu[i])) * silu(hi2f(gu[i]));
        ru[i] = pack2(ylo, yhi);
      }
      *(uint4*)(cat + (size_t)t * CATW + h * 128 + d0) = make_uint4(ru[0], ru[1], ru[2], ru[3]);
    }
    xcd_barrier(xb);
    REP(0) {
      Epi e; e.out = outb; e.ldo = 1024; e.rsp = rsp; e.L = L; e.rinv = nullptr;
      gemm_phase<2>(bid, nblk, 64 * 8, 64, cat, CATW, wt_o_out, 2048, e, smem);
    }
    if (grp + 1 < NGROUP) {
      const float* xn = p.xs + (size_t)grp * GT * 1024;
      for (int it = nblk - 1 - bid; it < GT / 4; it += nblk) rowprep_item(it, xn, xbf, rinvb);
    }
    xcd_barrier(xb);
    for (int it = bid; it < GT / 4; it += nblk) resid_item<false>(it, dg, outb, rsp, p.o_post_g, dg, nullptr, nullptr);
  }
}

extern "C" void kernel_launch(void* const* d_in, const int* in_sizes, int n_in, void* d_out, int out_size, void* d_ws,
                              size_t ws_size, hipStream_t stream) {
  static int grid_blocks = 0;
  if (!grid_blocks) {
    int dev = 0, cus = 0, per_cu = 0;
    hipGetDevice(&dev);
    hipDeviceGetAttribute(&cus, hipDeviceAttributeMultiprocessorCount, dev);
    hipOccupancyMaxActiveBlocksPerMultiprocessor(&per_cu, mega, 256, 0);
    if (per_cu > 2) per_cu = 2;
    if (per_cu < 1) per_cu = 1;
    grid_blocks = cus * per_cu;
  }
  P p{};
  const float** f = (const float**)&p;
  for (int i = 0; i < 30; ++i) f[i] = (const float*)d_in[i];
  p.out = (float*)d_out;
  p.ws = (char*)d_ws;
  hipMemsetAsync((char*)d_ws + OFF_BAR, 0, 16384, stream);
  void* args[] = {&p};
  hipError_t e = hipLaunchCooperativeKernel((void*)mega, dim3(grid_blocks), dim3(256), args, 0, stream);
  if (e != hipSuccess) fprintf(stderr, "cooperative launch failed: %s (grid %d)\n", hipGetErrorString(e), grid_blocks);
}
```
